# Optimizing an MI355X kernel written in HIP

```python
import math
import jax, jax.numpy as jnp
from jax import lax
import numpy as np

D_MODEL = 2048
BATCH = 8
SEQ = 2048
DEPTH = 1
DEC_BATCH = 2
DEC_SEQ = 8192
PAST_LEN = 128

SSM_WIDTH = D_MODEL // 2
SSM_GROUP = 16
SSM_GROUPS = SSM_WIDTH // SSM_GROUP
SSM_STATE = 64
ATTN_WIDTH = D_MODEL // 2
HEAD_DIM = 64
N_HEADS = ATTN_WIDTH // HEAD_DIM
GRID_W = 64
WIN_ROWS = 8
WIN_COLS = 16
NORM_EPS = 1e-6
IN_WIDTH = 2 * SSM_WIDTH + 4 * ATTN_WIDTH + 2 * D_MODEL
MASK_VALUE = -1e30
LOG_DT_MIN = math.log(1e-3)
LOG_DT_MAX = math.log(1e-1)

kernel_name = "hybrid_s5_natten_encoder"


def _rmsnorm(x, g):
    x32 = x.astype(jnp.float32)
    y = x32 * lax.rsqrt(jnp.mean(x32 * x32, axis=-1, keepdims=True) + NORM_EPS)
    return (y * g.astype(jnp.float32)).astype(x.dtype)


def _complex_affine_combine(e1, e2):
    a1r, a1i, b1r, b1i = e1
    a2r, a2i, b2r, b2i = e2
    return (a2r * a1r - a2i * a1i,
            a2r * a1i + a2i * a1r,
            a2r * b1r - a2i * b1i + b2r,
            a2r * b1i + a2i * b1r + b2i)


def _s5_bidirectional(u, a_re, a_im, log_dt, b_re, b_im, c_re, c_im, d_skip):
    f32 = jnp.float32
    bsz, seq_len, _ = u.shape
    ug = u.reshape(bsz, seq_len, SSM_GROUPS, SSM_GROUP)
    lam_re = jnp.minimum(a_re.astype(f32), -1e-4)
    lam_im = a_im.astype(f32)
    dt = jnp.exp(log_dt.astype(f32))[..., None]
    mag = jnp.exp(lam_re * dt)
    abar_re = mag * jnp.cos(lam_im * dt)
    abar_im = mag * jnp.sin(lam_im * dt)
    den = lam_re * lam_re + lam_im * lam_im
    f_re = ((abar_re - 1.0) * lam_re + abar_im * lam_im) / den
    f_im = (abar_im * lam_re - (abar_re - 1.0) * lam_im) / den
    b_re = b_re.astype(f32); b_im = b_im.astype(f32)
    bb_re = f_re[..., None] * b_re - f_im[..., None] * b_im
    bb_im = f_re[..., None] * b_im + f_im[..., None] * b_re
    c_re = c_re.astype(f32); c_im = c_im.astype(f32)
    y_dirs = []
    for direction in range(2):
        bu_re = jnp.einsum('blgh,gph->blgp', ug, bb_re[direction])
        bu_im = jnp.einsum('blgh,gph->blgp', ug, bb_im[direction])
        a_r = jnp.broadcast_to(abar_re[direction][None, None], (1, seq_len, SSM_GROUPS, SSM_STATE))
        a_i = jnp.broadcast_to(abar_im[direction][None, None], (1, seq_len, SSM_GROUPS, SSM_STATE))
        _, _, s_re, s_im = lax.associative_scan(
            _complex_affine_combine, (a_r, a_i, bu_re, bu_im), reverse=(direction == 1), axis=1)
        y_dirs.append(jnp.einsum('blgp,ghp->blgh', s_re, c_re[direction])
                      - jnp.einsum('blgp,ghp->blgh', s_im, c_im[direction]))
    y = (y_dirs[0] + y_dirs[1]).reshape(bsz, seq_len, SSM_WIDTH)
    return y + d_skip.astype(f32) * u


def _neighbourhood_attention(q, k, v, rel_bias):
    bsz, seq_len, n_heads, hd = q.shape
    rows = seq_len // GRID_W
    kh = min(WIN_ROWS, rows)
    r = jnp.arange(rows)
    rstart = jnp.clip(r - kh // 2, 0, rows - kh)
    krow = rstart[:, None] + jnp.arange(kh)[None, :]
    qg = q.reshape(bsz, rows, GRID_W, n_heads, hd)
    kg = k.reshape(bsz, rows, GRID_W, n_heads, hd)[:, krow]
    vg = v.reshape(bsz, rows, GRID_W, n_heads, hd)[:, krow]
    scores = jnp.einsum('brqhd,brkchd->brhqkc', qg, kg).astype(jnp.float32) * (hd ** -0.5)
    c = jnp.arange(GRID_W)
    cstart = jnp.clip(c - WIN_COLS // 2, 0, GRID_W - WIN_COLS)
    valid = (c[None, :] >= cstart[:, None]) & (c[None, :] < cstart[:, None] + WIN_COLS)
    dr_idx = krow - r[:, None] + (WIN_ROWS - 1)
    dc_idx = jnp.clip(c[None, :] - c[:, None] + (WIN_COLS - 1), 0, 2 * WIN_COLS - 2)
    rb = rel_bias.astype(jnp.float32)[:, dr_idx][..., dc_idx]
    rb = rb.transpose(1, 0, 3, 2, 4)
    scores = jnp.where(valid[None, None, None, :, None, :], scores + rb[None], MASK_VALUE)
    probs = jax.nn.softmax(scores.reshape(bsz, rows, n_heads, GRID_W, kh * GRID_W), axis=-1)
    probs = probs.reshape(bsz, rows, n_heads, GRID_W, kh, GRID_W).astype(v.dtype)
    out = jnp.einsum('brhqkc,brkchd->brqhd', probs, vg)
    return out.reshape(bsz, seq_len, n_heads * hd)


def _hybrid_layer(x, norm_g, w_in, ssm_a_re, ssm_a_im, ssm_log_dt, ssm_b_re, ssm_b_im,
                  ssm_c_re, ssm_c_im, ssm_d, w_glu, b_glu, q_norm_g, k_norm_g, rel_bias,
                  w_branch_ssm, w_branch_attn, w_out):
    bsz, seq_len, _ = x.shape
    h = _rmsnorm(x, norm_g)
    proj = h @ w_in
    cuts = np.cumsum([SSM_WIDTH, SSM_WIDTH, ATTN_WIDTH, ATTN_WIDTH, ATTN_WIDTH, ATTN_WIDTH, D_MODEL]).tolist()
    u_s, z_s, q, k, v, z_a, g_s, g_a = jnp.split(proj, cuts, axis=-1)
    y_s = _s5_bidirectional(u_s.astype(jnp.float32), ssm_a_re, ssm_a_im, ssm_log_dt,
                            ssm_b_re, ssm_b_im, ssm_c_re, ssm_c_im, ssm_d)
    y_s = jax.nn.gelu(y_s)
    y_s = y_s * jax.nn.sigmoid(y_s @ w_glu + b_glu)
    o_s = (y_s * jax.nn.silu(z_s.astype(jnp.float32))).astype(x.dtype)
    q = _rmsnorm(q.reshape(bsz, seq_len, N_HEADS, HEAD_DIM), q_norm_g)
    k = _rmsnorm(k.reshape(bsz, seq_len, N_HEADS, HEAD_DIM), k_norm_g)
    v = v.reshape(bsz, seq_len, N_HEADS, HEAD_DIM)
    o_a = _neighbourhood_attention(q, k, v, rel_bias) * jax.nn.silu(z_a)
    m = jax.nn.sigmoid(g_s) * (o_s @ w_branch_ssm) + jax.nn.sigmoid(g_a) * (o_a @ w_branch_attn)
    return (x + m @ w_out).astype(x.dtype)


def _trunk(x, norm_g, w_in, ssm_a_re, ssm_a_im, ssm_log_dt, ssm_b_re, ssm_b_im,
           ssm_c_re, ssm_c_im, ssm_d, w_glu, b_glu, q_norm_g, k_norm_g, rel_bias,
           w_branch_ssm, w_branch_attn, w_out):
    for layer in range(DEPTH):
        x = _hybrid_layer(x, norm_g[layer], w_in[layer], ssm_a_re[layer], ssm_a_im[layer],
                          ssm_log_dt[layer], ssm_b_re[layer], ssm_b_im[layer], ssm_c_re[layer],
                          ssm_c_im[layer], ssm_d[layer], w_glu[layer], b_glu[layer],
                          q_norm_g[layer], k_norm_g[layer], rel_bias[layer],
                          w_branch_ssm[layer], w_branch_attn[layer], w_out[layer])
    return x


def setup_inputs(seed: int = 0) -> dict:
    key = jax.random.key(seed)
    ks = jax.random.split(key, 24)
    f32 = jnp.float32
    G, P, H = SSM_GROUPS, SSM_STATE, SSM_GROUP
    nrm = lambda k_, shape, scale: jax.random.normal(k_, shape, f32) * scale
    a_im_init = jnp.pi * jnp.arange(P, dtype=f32)
    return {
        "x_prompt": nrm(ks[0], (BATCH, SEQ, D_MODEL), 1.0),
        "x_sample": nrm(ks[1], (DEC_BATCH, DEC_SEQ, D_MODEL), 1.0),
        "norm_g": 1.0 + nrm(ks[2], (DEPTH, D_MODEL), 0.02),
        "w_in": nrm(ks[3], (DEPTH, D_MODEL, IN_WIDTH), D_MODEL ** -0.5),
        "ssm_a_re": -0.5 + nrm(ks[4], (DEPTH, 2, G, P), 0.01),
        "ssm_a_im": a_im_init + nrm(ks[5], (DEPTH, 2, G, P), 0.01),
        "ssm_log_dt": jax.random.uniform(ks[6], (DEPTH, 2, G), f32, LOG_DT_MIN, LOG_DT_MAX),
        "ssm_b_re": nrm(ks[7], (DEPTH, 2, G, P, H), (2 * H) ** -0.5),
        "ssm_b_im": nrm(ks[8], (DEPTH, 2, G, P, H), (2 * H) ** -0.5),
        "ssm_c_re": nrm(ks[9], (DEPTH, 2, G, H, P), P ** -0.5),
        "ssm_c_im": nrm(ks[10], (DEPTH, 2, G, H, P), P ** -0.5),
        "ssm_d": nrm(ks[11], (DEPTH, SSM_WIDTH), 1.0),
        "w_glu": nrm(ks[12], (DEPTH, SSM_WIDTH, SSM_WIDTH), SSM_WIDTH ** -0.5),
        "b_glu": nrm(ks[13], (DEPTH, SSM_WIDTH), 0.01),
        "q_norm_g": 1.0 + nrm(ks[14], (DEPTH, HEAD_DIM), 0.02),
        "k_norm_g": 1.0 + nrm(ks[15], (DEPTH, HEAD_DIM), 0.02),
        "rel_bias": nrm(ks[16], (DEPTH, N_HEADS, 2 * WIN_ROWS - 1, 2 * WIN_COLS - 1), 0.02),
        "w_branch_ssm": nrm(ks[17], (DEPTH, SSM_WIDTH, D_MODEL), SSM_WIDTH ** -0.5),
        "w_branch_attn": nrm(ks[18], (DEPTH, ATTN_WIDTH, D_MODEL), ATTN_WIDTH ** -0.5),
        "w_out": nrm(ks[19], (DEPTH, D_MODEL, D_MODEL), D_MODEL ** -0.5),
    }


def reference(x_prompt, x_sample, norm_g, w_in, ssm_a_re, ssm_a_im, ssm_log_dt, ssm_b_re,
              ssm_b_im, ssm_c_re, ssm_c_im, ssm_d, w_glu, b_glu, q_norm_g, k_norm_g, rel_bias,
              w_branch_ssm, w_branch_attn, w_out):
    y_prompt = _trunk(x_prompt, norm_g, w_in, ssm_a_re, ssm_a_im, ssm_log_dt, ssm_b_re, ssm_b_im,
                      ssm_c_re, ssm_c_im, ssm_d, w_glu, b_glu, q_norm_g, k_norm_g, rel_bias,
                      w_branch_ssm, w_branch_attn, w_out)
    y_sample = _trunk(x_sample, norm_g, w_in, ssm_a_re, ssm_a_im, ssm_log_dt, ssm_b_re, ssm_b_im,
                      ssm_c_re, ssm_c_im, ssm_d, w_glu, b_glu, q_norm_g, k_norm_g, rel_bias,
                      w_branch_ssm, w_branch_attn, w_out)
    return (y_prompt, y_sample)
```

```cpp
#define MK_MULTI 0
#include <hip/hip_runtime.h>
#include <cstdio>
#include <cstdint>
#include <cmath>
namespace pg8 {
#define PG8_LAS __attribute__((address_space(3)))
typedef unsigned short bf16_t;
typedef short bf16x8 __attribute__((ext_vector_type(8)));
typedef float f32x4 __attribute__((ext_vector_type(4)));
typedef float f32x2 __attribute__((ext_vector_type(2)));
typedef unsigned u32x4 __attribute__((ext_vector_type(4)));
typedef unsigned u32x2 __attribute__((ext_vector_type(2)));
constexpr int BM = 256, BK = 64, HALF = 128, HTB = HALF * BK * 2  , STAGE_BYTES = 8 * HTB, NXCD = 8, WGM = 8;

__host__ __device__ __forceinline__ int lds_byte(int r, int c) { const int st = (r >> 4) * 2 + (c >> 5), rr = r & 15, cc = c & 31, ob = rr * 64 + cc * 2; return st * 1024 + (ob ^ (((ob >> 9) & 1) << 5)); }
__host__ __device__ __forceinline__ void stage_rc(int b, int& R, int& C) { const int st = b / 1024, sb = b % 1024, swz = sb ^ (((sb >> 9) & 1) << 5); R = (st >> 1) * 16 + swz / 64; C = (st & 1) * 32 + (swz % 64) / 2; }
__host__ __device__ __forceinline__ int perm32(int rho) { const int n = rho >> 4, i = rho & 15; return 8 * (i >> 2) + 4 * n + (i & 3); }

struct Unit { int pm, pn; };
struct Gemm { const bf16_t* A; const bf16_t* Bt; int lda, ldb, K; };

struct StaticOrder {
    int nM, nN, nwg, G, c, wgm;
    __host__ __device__ void init(int M, int N, int G_, int c_, int wgm_ = WGM) { nM = M / BM; nN = N / BM; nwg = nM * nN; G = G_; c = c_; wgm = wgm_; }
    __host__ __device__ bool next(int i, Unit& u) const {
        const long L = (long)i * G + c; if (L >= nwg) return false;
        int wgid = (int)L; { const int q = nwg / NXCD, r = nwg % NXCD, xcd = wgid % NXCD, off = wgid / NXCD; wgid = (xcd < r ? xcd * (q + 1) : r * (q + 1) + (xcd - r) * q) + off; }
        const int nig = wgm * nN, gid = wgid / nig, fm = gid * wgm, gsz = (nM - fm) < wgm ? (nM - fm) : wgm;
        u.pm = fm + ((wgid % nig) % gsz); u.pn = (wgid % nig) / gsz; return true;
    }
};
struct RangeOrder {
    StaticOrder S; int i0, n;
    __host__ __device__ bool next(int i, Unit& u) const { if (i >= n) return false; return S.next(i0 + i, u); }
};
struct GroupOrder {
    int rt, ct, total, G, c;
    __host__ __device__ void init(int nG, int rt_, int ct_, int G_, int c_) { rt = rt_; ct = ct_; total = nG * rt_ * ct_; G = G_; c = c_; }
    __host__ __device__ bool next(int i, Unit& u) const {
        const int L = i * G + c; if (L >= total) return false;
        const int per = rt * ct, g = L / per, r = L % per; u.pm = g * rt + r % rt; u.pn = g * ct + r / rt; return true;
    }
};

typedef __bf16 bf16x2_t __attribute__((ext_vector_type(2)));
__device__ __forceinline__ unsigned cvt_pk_bf16(float lo, float hi) { const f32x2 v = {lo, hi}; const bf16x2_t b = __builtin_convertvector(v, bf16x2_t); return __builtin_bit_cast(unsigned, b); }
__device__ __forceinline__ float bf_lo(unsigned w) { return __uint_as_float(w << 16); }
__device__ __forceinline__ float bf_hi(unsigned w) { return __uint_as_float(w & 0xffff0000u); }

template <class Epi, class Sched, bool ALIGN_EPI = false, bool SP2 = false>
__device__ __forceinline__ void gemm_phase(PG8_LAS unsigned char* lds, const Gemm g, const Sched& S, const Epi& E, const int tid) {
    const int wid = __builtin_amdgcn_readfirstlane(tid >> 6), lane = tid & 63, wr = wid >> 2, wc = wid & 3, fr = lane & 15, fq = lane >> 4;
    const int K = g.K, nt = K / BK;
    unsigned voffA[2], voffB[2];
#pragma unroll
    for (int i = 0; i < 2; ++i) { int R, C; stage_rc(tid * 16 + i * 8192, R, C); const int Rb = Epi::PERM ? ((R & ~31) + perm32(R & 31)) : R;
        voffA[i] = (unsigned)(R * g.lda + C) * 2u; voffB[i] = (unsigned)(Rb * g.ldb + C) * 2u; }
    const size_t kstep = (size_t)(BK * 2);
    const size_t hstepA = (size_t)HALF * g.lda * 2, hstepB = (size_t)HALF * g.ldb * 2;
    const size_t tstepA = 2 * hstepA, tstepB = 2 * hstepB;
    const unsigned ldsw = (unsigned)wid * 1024u;
    const int aoff = lds_byte(wr * 64 + fr, fq * 8), boff = lds_byte(wc * 32 + fr, fq * 8);
#define PG8_SA(b, h) (((b) * 2 + (h)) * HTB)
#define PG8_SB(b, h) ((4 + (b) * 2 + (h)) * HTB)
#define PG8_STAGE(bufoff, gbase, voff) do { _Pragma("unroll") for (int _i = 0; _i < 2; ++_i) \
        __builtin_amdgcn_global_load_lds((const unsigned*)((const char*)(gbase) + (voff)[_i]), (PG8_LAS unsigned*)(lds + (bufoff) + ldsw + _i * 8192), 16, 0, 0); } while (0)
#define PG8_LDA(dst, b, h) do { _Pragma("unroll") for (int m = 0; m < 4; ++m) _Pragma("unroll") for (int k = 0; k < 2; ++k) dst[m][k] = *(const PG8_LAS bf16x8*)(lds + PG8_SA(b, h) + aoff + m * 2048 + k * 1024); } while (0)
#define PG8_LDB(dst, b, h) do { _Pragma("unroll") for (int n = 0; n < 2; ++n) _Pragma("unroll") for (int k = 0; k < 2; ++k) dst[n][k] = *(const PG8_LAS bf16x8*)(lds + PG8_SB(b, h) + boff + n * 2048 + k * 1024); } while (0)
#define PG8_MMA(ai, bj, At, Bt) do { __builtin_amdgcn_s_setprio(1); _Pragma("unroll") for (int m = 0; m < 4; ++m) _Pragma("unroll") for (int n = 0; n < 2; ++n) _Pragma("unroll") for (int k = 0; k < 2; ++k) \
        acc[ai][bj][m][n] = __builtin_amdgcn_mfma_f32_16x16x32_bf16(Bt[n][k], At[m][k], acc[ai][bj][m][n], 0, 0, 0); __builtin_amdgcn_s_setprio(0); } while (0)
#define PG8_WAIT_V(n) asm volatile("s_waitcnt vmcnt(" #n ")" ::: "memory")
#define PG8_WAIT_L(n) asm volatile("s_waitcnt lgkmcnt(" #n ")" ::: "memory")
#define PG8_BAR __builtin_amdgcn_s_barrier()
#define PG8_SCHED __builtin_amdgcn_sched_barrier(0)
    Unit cur, nxt; int ui = 0;
    if (!S.next(0, cur)) return;
    f32x4 acc[2][2][4][2];
#pragma unroll
    for (int a = 0; a < 2; ++a)
#pragma unroll
        for (int b = 0; b < 2; ++b)
#pragma unroll
            for (int m = 0; m < 4; ++m)
#pragma unroll
                for (int n = 0; n < 2; ++n) acc[a][b][m][n] = (f32x4){0.f, 0.f, 0.f, 0.f};
    bf16x8 At[4][2], B0[2][2], B1[2][2];
    const char* cA = (const char*)g.A + (size_t)cur.pm * tstepA; const char* cB = (const char*)g.Bt + (size_t)cur.pn * tstepB;
    if constexpr (SP2) {
        PG8_STAGE(PG8_SB(0, 0), cB, voffB); PG8_STAGE(PG8_SB(0, 1), cB + hstepB, voffB); PG8_STAGE(PG8_SA(0, 0), cA, voffA); PG8_STAGE(PG8_SA(0, 1), cA + hstepA, voffA);
        if (wr == 1) PG8_BAR;
        PG8_WAIT_V(2); PG8_BAR;
        PG8_STAGE(PG8_SB(1, 0), cB + kstep, voffB); PG8_STAGE(PG8_SA(1, 0), cA + kstep, voffA); PG8_STAGE(PG8_SB(1, 1), cB + hstepB + kstep, voffB);
        PG8_WAIT_V(6); PG8_BAR;
    } else {
        PG8_STAGE(PG8_SB(0, 0), cB, voffB); PG8_STAGE(PG8_SA(0, 0), cA, voffA); PG8_STAGE(PG8_SB(0, 1), cB + hstepB, voffB); PG8_STAGE(PG8_SA(0, 1), cA + hstepA, voffA);
        if (wr == 1) PG8_BAR;
        PG8_WAIT_V(4); PG8_BAR;
        PG8_STAGE(PG8_SB(1, 0), cB + kstep, voffB); PG8_STAGE(PG8_SA(1, 0), cA + kstep, voffA); PG8_STAGE(PG8_SB(1, 1), cB + hstepB + kstep, voffB);
        PG8_WAIT_V(6); PG8_BAR;
    }
    for (;;) {
        const bool has_next = S.next(ui + 1, nxt);
        const char* nA = has_next ? (const char*)g.A + (size_t)nxt.pm * tstepA : cA; const char* nB = has_next ? (const char*)g.Bt + (size_t)nxt.pn * tstepB : cB;
        for (int t = 0; t < nt; t += 2) {
            const bool last = (t == nt - 2);
            const char* a1 = cA + (size_t)(t + 1) * kstep;
            const char* a2 = last ? nA : cA + (size_t)(t + 2) * kstep; const char* b2 = last ? nB : cB + (size_t)(t + 2) * kstep;
            const char* a3 = a2 + kstep; const char* b3 = b2 + kstep;
            if constexpr (Epi::MIDK) { if (t == (nt >> 1)) E.mid(acc, cur, wr, wc, fr, fq); }
            if constexpr (SP2) {
            PG8_LDB(B0, 0, 0); PG8_LDB(B1, 0, 1); PG8_SCHED; PG8_LDA(At, 0, 0); PG8_STAGE(PG8_SA(1, 1), a1 + hstepA, voffA);
            PG8_WAIT_V(8); PG8_WAIT_L(0); PG8_BAR; PG8_MMA(0, 0, At, B0); PG8_MMA(0, 1, At, B1); PG8_BAR; PG8_SCHED;
            PG8_LDA(At, 0, 1); PG8_STAGE(PG8_SB(0, 0), b2, voffB); PG8_STAGE(PG8_SB(0, 1), b2 + hstepB, voffB); PG8_STAGE(PG8_SA(0, 0), a2, voffA);
            PG8_WAIT_V(8); PG8_WAIT_L(0); PG8_BAR; PG8_MMA(1, 0, At, B0); PG8_MMA(1, 1, At, B1); PG8_BAR; PG8_SCHED;
            PG8_LDB(B0, 1, 0); PG8_LDB(B1, 1, 1); PG8_SCHED; PG8_LDA(At, 1, 0); PG8_STAGE(PG8_SA(0, 1), a2 + hstepA, voffA);
            PG8_WAIT_V(8); PG8_WAIT_L(0); PG8_BAR; PG8_MMA(0, 0, At, B0); PG8_MMA(0, 1, At, B1); PG8_BAR; PG8_SCHED;
            PG8_LDA(At, 1, 1); PG8_STAGE(PG8_SB(1, 0), b3, voffB); PG8_STAGE(PG8_SB(1, 1), b3 + hstepB, voffB); PG8_STAGE(PG8_SA(1, 0), a3, voffA);
            PG8_WAIT_V(8); PG8_WAIT_L(0); PG8_BAR; PG8_MMA(1, 0, At, B0); PG8_MMA(1, 1, At, B1); PG8_BAR; PG8_SCHED;
            } else {
            PG8_LDB(B0, 0, 0); PG8_SCHED; PG8_LDA(At, 0, 0); PG8_STAGE(PG8_SA(1, 1), a1 + hstepA, voffA);
            PG8_WAIT_L(8); PG8_BAR; PG8_WAIT_L(0); PG8_MMA(0, 0, At, B0); PG8_BAR; PG8_SCHED;
            PG8_LDB(B1, 0, 1); PG8_STAGE(PG8_SB(0, 0), b2, voffB);
            PG8_BAR; PG8_WAIT_L(0); PG8_MMA(0, 1, At, B1); PG8_BAR;
            PG8_LDA(At, 0, 1); PG8_STAGE(PG8_SA(0, 0), a2, voffA);
            PG8_BAR; PG8_WAIT_L(0); PG8_MMA(1, 0, At, B0); PG8_BAR; PG8_SCHED;
            PG8_STAGE(PG8_SB(0, 1), b2 + hstepB, voffB);
            PG8_WAIT_V(6); PG8_BAR; PG8_MMA(1, 1, At, B1); PG8_BAR;
            PG8_LDB(B0, 1, 0); PG8_SCHED; PG8_LDA(At, 1, 0); PG8_STAGE(PG8_SA(0, 1), a2 + hstepA, voffA);
            PG8_WAIT_L(8); PG8_BAR; PG8_WAIT_L(0); PG8_MMA(0, 0, At, B0); PG8_BAR; PG8_SCHED;
            PG8_LDB(B1, 1, 1); PG8_STAGE(PG8_SB(1, 0), b3, voffB);
            PG8_BAR; PG8_WAIT_L(0); PG8_MMA(0, 1, At, B1); PG8_BAR;
            PG8_LDA(At, 1, 1); PG8_STAGE(PG8_SA(1, 0), a3, voffA);
            PG8_BAR; PG8_WAIT_L(0); PG8_MMA(1, 0, At, B0); PG8_BAR; PG8_SCHED;
            PG8_STAGE(PG8_SB(1, 1), b3 + hstepB, voffB);
            PG8_WAIT_V(6); PG8_BAR; PG8_MMA(1, 1, At, B1); PG8_BAR;
            }
        }
        if constexpr (ALIGN_EPI) { if (wr == 0) PG8_BAR; }
        E(acc, cur, wr, wc, fr, fq);
        if (!has_next) break;
#pragma unroll
        for (int a = 0; a < 2; ++a)
#pragma unroll
            for (int b = 0; b < 2; ++b)
#pragma unroll
                for (int m = 0; m < 4; ++m)
#pragma unroll
                    for (int n = 0; n < 2; ++n) acc[a][b][m][n] = (f32x4){0.f, 0.f, 0.f, 0.f};
        cur = nxt; cA = nA; cB = nB; ++ui;
        if constexpr (ALIGN_EPI) { if (wr == 1) PG8_BAR; }
    }
    PG8_WAIT_V(0);
    if constexpr (!ALIGN_EPI) { if (wr == 0) PG8_BAR; }
    PG8_BAR;
#undef PG8_SA
#undef PG8_SB
#undef PG8_STAGE
#undef PG8_LDA
#undef PG8_LDB
#undef PG8_MMA
#undef PG8_WAIT_V
#undef PG8_WAIT_L
#undef PG8_BAR
#undef PG8_SCHED
}
}
namespace pg8 {
constexpr float LOG2E = 1.4426950408889634f;
__device__ __forceinline__ float sigm(float x) { return __builtin_amdgcn_rcpf(1.f + __expf(-x)); }
__device__ __forceinline__ float gelu_tanh(float x) { const float in = 0.7978845608028654f * (x + 0.044715f * x * x * x); return x * sigm(2.f * in); }
__device__ __forceinline__ u32x4 pack8(const f32x4 a, const f32x4 b) { u32x4 w; w.x = cvt_pk_bf16(a[0], a[1]); w.y = cvt_pk_bf16(a[2], a[3]); w.z = cvt_pk_bf16(b[0], b[1]); w.w = cvt_pk_bf16(b[2], b[3]); return w; }
__device__ __forceinline__ void unpack8(const u32x4 w, f32x4& a, f32x4& b) { a = (f32x4){bf_lo(w.x), bf_hi(w.x), bf_lo(w.y), bf_hi(w.y)}; b = (f32x4){bf_lo(w.z), bf_hi(w.z), bf_lo(w.w), bf_hi(w.w)}; }

struct EpiProj {
    static constexpr bool PERM = true, MIDK = false;
    bf16_t *UEXT, *ZS, *Q, *Kb, *V, *ZA; unsigned char *GS, *GA; const float *qg, *kg;
    __device__ __forceinline__ static void gate8(const f32x4 (&acc)[2][2][4][2], unsigned char* dst, const int colt, const int row0, const int wc, const int fq) {
        const int col0 = colt + wc * 32 + 8 * fq;
#pragma unroll
        for (int ai = 0; ai < 2; ++ai)
#pragma unroll
            for (int m = 0; m < 4; ++m) { unsigned char* rowp = dst + (size_t)(row0 + ai * HALF + m * 16) * 2048 + col0;
#pragma unroll
                for (int bj = 0; bj < 2; ++bj) { u32x2 w = {0u, 0u};
#pragma unroll
                    for (int e = 0; e < 4; ++e) { w.x = __builtin_amdgcn_cvt_pk_u8_f32(fmaxf(sigm(acc[ai][bj][m][0][e]) * 255.f, 1.f), e, w.x);
                                                  w.y = __builtin_amdgcn_cvt_pk_u8_f32(fmaxf(sigm(acc[ai][bj][m][1][e]) * 255.f, 1.f), e, w.y); }
                    *(u32x2*)(rowp + bj * HALF) = w; } }
    }
    template <int KIND  > __device__ __forceinline__ static void plain(const f32x4 (&acc)[2][2][4][2], bf16_t* dst, const int ld, const int colt, const int row0, const int wc, const int fq) {
        const int col0 = colt + wc * 32 + 8 * fq;
#pragma unroll
        for (int ai = 0; ai < 2; ++ai)
#pragma unroll
            for (int m = 0; m < 4; ++m) { bf16_t* rowp = dst + (size_t)(row0 + ai * HALF + m * 16) * ld + col0;
#pragma unroll
                for (int bj = 0; bj < 2; ++bj) { f32x4 v0 = acc[ai][bj][m][0], v1 = acc[ai][bj][m][1];
                    if (KIND != 0) {
#pragma unroll
                        for (int e = 0; e < 4; ++e) { const float s0 = sigm(v0[e]), s1 = sigm(v1[e]); v0[e] = KIND == 1 ? v0[e] * s0 : s0; v1[e] = KIND == 1 ? v1[e] * s1 : s1; } }
                    *(u32x4*)(rowp + bj * HALF) = pack8(v0, v1); } }
    }
    __device__ __forceinline__ void operator()(const f32x4 (&acc)[2][2][4][2], const Unit& u, int wr, int wc, int fr, int fq) const {
        const int pn = u.pn; int row0 = u.pm * BM + wr * 64 + fr; asm volatile("" : "+v"(row0));
        if (pn >= 8 && pn < 16) {
            const bool isq = pn < 12; const float* gg = isq ? qg : kg; bf16_t* dst = isq ? Q : Kb; const float sc = isq ? 0.125f * LOG2E : 1.f;
            const int head = (pn - (isq ? 8 : 12)) * 4 + wc;
            f32x4 gv[2][2];
#pragma unroll
            for (int bj = 0; bj < 2; ++bj)
#pragma unroll
                for (int n = 0; n < 2; ++n) gv[bj][n] = *(const f32x4*)(gg + 32 * bj + 8 * fq + 4 * n) * sc;
#pragma unroll
            for (int ai = 0; ai < 2; ++ai)
#pragma unroll
                for (int m = 0; m < 4; ++m) {
                    float ss = 0.f;
#pragma unroll
                    for (int bj = 0; bj < 2; ++bj)
#pragma unroll
                        for (int n = 0; n < 2; ++n) { const f32x4 x = acc[ai][bj][m][n]; ss += (x[0] * x[0] + x[1] * x[1]) + (x[2] * x[2] + x[3] * x[3]); }
                    ss += __shfl_xor(ss, 16); ss += __shfl_xor(ss, 32);
                    const float rinv = __builtin_amdgcn_rsqf(ss * (1.f / 64.f) + 1e-6f);
                    bf16_t* rowp = dst + (size_t)(row0 + ai * HALF + m * 16) * 1024 + head * 64 + 8 * fq;
#pragma unroll
                    for (int bj = 0; bj < 2; ++bj) *(u32x4*)(rowp + 32 * bj) = pack8(acc[ai][bj][m][0] * rinv * gv[bj][0], acc[ai][bj][m][1] * rinv * gv[bj][1]);
                }
        } else if (pn < 4) {
#pragma unroll
            for (int ai = 0; ai < 2; ++ai)
#pragma unroll
                for (int m = 0; m < 4; ++m) { const int r = row0 + ai * HALF + m * 16;
#pragma unroll
                    for (int bj = 0; bj < 2; ++bj) { const int c = pn * BM + bj * HALF + wc * 32 + 8 * fq, gidx = c >> 4, h0 = c & 15;
                        *(u32x4*)(UEXT + ((size_t)(gidx * 512 + (r >> 5)) * 768 + (r & 31) * 16 + h0)) = pack8(acc[ai][bj][m][0], acc[ai][bj][m][1]); } }
        } else if (pn < 8) { plain<1>(acc, ZS, 1024, (pn - 4) * BM, row0, wc, fq); }
        else if (pn < 20) { plain<0>(acc, V, 1024, (pn - 16) * BM, row0, wc, fq); }
        else if (pn < 24) { plain<1>(acc, ZA, 1024, (pn - 20) * BM, row0, wc, fq); }
        else if (pn < 32) { gate8(acc, GS, (pn - 24) * BM, row0, wc, fq); }
        else { gate8(acc, GA, (pn - 32) * BM, row0, wc, fq); }
    }
};
struct EpiE {
    static constexpr bool PERM = false, MIDK = false;
    float* E;
    __device__ __forceinline__ void operator()(const f32x4 (&acc)[2][2][4][2], const Unit& u, int wr, int wc, int fr, int fq) const {
        int row0 = u.pm * BM + wr * 64 + fr; asm volatile("" : "+v"(row0)); const int col0 = wc * 32 + 4 * fq;
#pragma unroll
        for (int ai = 0; ai < 2; ++ai)
#pragma unroll
            for (int m = 0; m < 4; ++m) { float* rowp = E + (size_t)(row0 + ai * HALF + m * 16) * 256 + col0;
#pragma unroll
                for (int bj = 0; bj < 2; ++bj)
#pragma unroll
                    for (int n = 0; n < 2; ++n) *(f32x4*)(rowp + bj * HALF + n * 16) = acc[ai][bj][m][n]; }
    }
};
struct EpiY {
    static constexpr bool PERM = true, MIDK = false;
    bf16_t* Y;
    __device__ __forceinline__ void operator()(const f32x4 (&acc)[2][2][4][2], const Unit& u, int wr, int wc, int fr, int fq) const {
        const int gidx = u.pm >> 1; int chunk0 = (u.pm & 1) * BM + wr * 64 + fr; asm volatile("" : "+v"(chunk0));
#pragma unroll
        for (int ai = 0; ai < 2; ++ai)
#pragma unroll
            for (int m = 0; m < 4; ++m) { const int chunk = chunk0 + ai * HALF + m * 16;
#pragma unroll
                for (int bj = 0; bj < 2; ++bj) { const int nc = (u.pn & 1) * BM + bj * HALF + wc * 32 + 8 * fq, i = nc >> 4, h0 = nc & 15;
                    f32x4 v0 = acc[ai][bj][m][0], v1 = acc[ai][bj][m][1];
#pragma unroll
                    for (int e = 0; e < 4; ++e) { v0[e] = gelu_tanh(v0[e]); v1[e] = gelu_tanh(v1[e]); }
                    *(u32x4*)(Y + (size_t)(chunk * 32 + i) * 1024 + gidx * 16 + h0) = pack8(v0, v1); } }
    }
};
struct EpiGlu {
    static constexpr bool PERM = true, MIDK = false;
    const bf16_t *Y, *ZS; const float* bias; bf16_t* ACAT;
    __device__ __forceinline__ void operator()(const f32x4 (&acc)[2][2][4][2], const Unit& u, int wr, int wc, int fr, int fq) const {
        int row0 = u.pm * BM + wr * 64 + fr; asm volatile("" : "+v"(row0)); const int col0 = u.pn * BM + wc * 32 + 8 * fq;
#pragma unroll
        for (int ai = 0; ai < 2; ++ai) {
#pragma unroll
            for (int m = 0; m < 4; ++m) { const size_t r = (size_t)(row0 + ai * HALF + m * 16);
#pragma unroll
                for (int bj = 0; bj < 2; ++bj) { const f32x4 b0 = *(const f32x4*)(bias + col0 + bj * HALF), b1 = *(const f32x4*)(bias + col0 + bj * HALF + 4);
                    const u32x4 yw = *(const u32x4*)(Y + r * 1024 + col0 + bj * HALF), zw = *(const u32x4*)(ZS + r * 1024 + col0 + bj * HALF);
                    f32x4 y0, y1, z0, z1; unpack8(yw, y0, y1); unpack8(zw, z0, z1);
                    f32x4 v0 = acc[ai][bj][m][0] + b0, v1 = acc[ai][bj][m][1] + b1;
#pragma unroll
                    for (int e = 0; e < 4; ++e) { v0[e] = y0[e] * sigm(v0[e]) * z0[e]; v1[e] = y1[e] * sigm(v1[e]) * z1[e]; }
                    *(u32x4*)(ACAT + r * 2048 + col0 + bj * HALF) = pack8(v0, v1); } }
            asm volatile("" ::: "memory"); }
    }
};
struct EpiMerge {
    static constexpr bool PERM = true, MIDK = true;
    const unsigned char *GS, *GA; bf16_t* MB;
    __device__ __forceinline__ static void ub8(const u32x2 w, f32x4& a, f32x4& b) {
        a = (f32x4){(float)(w.x & 0xffu), (float)((w.x >> 8) & 0xffu), (float)((w.x >> 16) & 0xffu), (float)(w.x >> 24)};
        b = (f32x4){(float)(w.y & 0xffu), (float)((w.y >> 8) & 0xffu), (float)((w.y >> 16) & 0xffu), (float)(w.y >> 24)}; }
    __device__ __forceinline__ void mid(f32x4 (&acc)[2][2][4][2], const Unit& u, int wr, int wc, int fr, int fq) const {
        int row0 = u.pm * BM + wr * 64 + fr; asm volatile("" : "+v"(row0)); const int col0 = u.pn * BM + wc * 32 + 8 * fq;
#pragma unroll
        for (int ai = 0; ai < 2; ++ai)
#pragma unroll
            for (int m = 0; m < 4; ++m) { const size_t r = (size_t)(row0 + ai * HALF + m * 16);
#pragma unroll
                for (int bj = 0; bj < 2; ++bj) { const u32x2 sw = *(const u32x2*)(GS + r * 2048 + col0 + bj * HALF), aw = *(const u32x2*)(GA + r * 2048 + col0 + bj * HALF);
                    f32x4 s0, s1, a0, a1; ub8(sw, s0, s1); ub8(aw, a0, a1);
#pragma unroll
                    for (int e = 0; e < 4; ++e) { acc[ai][bj][m][0][e] *= s0[e] * __builtin_amdgcn_rcpf(a0[e]); acc[ai][bj][m][1][e] *= s1[e] * __builtin_amdgcn_rcpf(a1[e]); } }
                if (m == 3) asm volatile("" ::: "memory"); }
    }
    __device__ __forceinline__ void operator()(const f32x4 (&acc)[2][2][4][2], const Unit& u, int wr, int wc, int fr, int fq) const {
        int row0 = u.pm * BM + wr * 64 + fr; asm volatile("" : "+v"(row0)); const int col0 = u.pn * BM + wc * 32 + 8 * fq;
#pragma unroll
        for (int ai = 0; ai < 2; ++ai)
#pragma unroll
            for (int m = 0; m < 4; ++m) { const size_t r = (size_t)(row0 + ai * HALF + m * 16);
#pragma unroll
                for (int bj = 0; bj < 2; ++bj) { const u32x2 aw = *(const u32x2*)(GA + r * 2048 + col0 + bj * HALF);
                    f32x4 a0, a1; ub8(aw, a0, a1);
                    *(u32x4*)(MB + r * 2048 + col0 + bj * HALF) = pack8(acc[ai][bj][m][0] * a0 * (1.f / 255.f), acc[ai][bj][m][1] * a1 * (1.f / 255.f)); }
                if (m == 3) asm volatile("" ::: "memory"); }
    }
};
struct EpiOut {
    static constexpr bool PERM = false, MIDK = false;
    const float* X; float* O;
    __device__ __forceinline__ void operator()(const f32x4 (&acc)[2][2][4][2], const Unit& u, int wr, int wc, int fr, int fq) const {
        int row0 = u.pm * BM + wr * 64 + fr; asm volatile("" : "+v"(row0)); const int col0 = u.pn * BM + wc * 32 + 4 * fq;
#pragma unroll
        for (int ai = 0; ai < 2; ++ai)
#pragma unroll
            for (int m = 0; m < 4; ++m) { const size_t off = (size_t)(row0 + ai * HALF + m * 16) * 2048 + col0;
#pragma unroll
                for (int bj = 0; bj < 2; ++bj)
#pragma unroll
                    for (int n = 0; n < 2; ++n) *(f32x4*)(O + off + bj * HALF + n * 16) = *(const f32x4*)(X + off + bj * HALF + n * 16) + acc[ai][bj][m][n];
                if (m == 3) asm volatile("" ::: "memory"); }
    }
};
}
namespace nat {
typedef unsigned short bf16_t;
typedef short bf16x8 __attribute__((ext_vector_type(8)));
typedef short s16x4 __attribute__((ext_vector_type(4)));
typedef float f32x4 __attribute__((ext_vector_type(4)));
typedef unsigned u32x4 __attribute__((ext_vector_type(4)));
typedef unsigned u32x2 __attribute__((ext_vector_type(2)));
#define NAT_LAS __attribute__((address_space(3)))
constexpr int SLOTB = 8192, KIMG = 0, VIMG = 9 * SLOTB, BIAS_OFF = 18 * SLOTB;
__device__ __forceinline__ s16x4 vtr(unsigned addr) { return __builtin_bit_cast(s16x4, __builtin_amdgcn_ds_read_tr16_b64_v4i16((NAT_LAS s16x4*)addr)); }
__device__ __forceinline__ void glds16(const void* gsrc, unsigned lds_dst) { unsigned keep;
    asm volatile("s_mov_b32 %0, m0\n\ts_mov_b32 m0, %2\n\ts_nop 0\n\tglobal_load_lds_dwordx4 %1, off\n\ts_mov_b32 m0, %0" : "=&s"(keep) : "v"(gsrc), "s"(lds_dst) : "memory"); }
#define NAT_BAR() asm volatile("s_barrier" ::: "memory")
#define NAT_WAITV_BAR(N) asm volatile("s_waitcnt vmcnt(" #N ")\n\ts_barrier" ::: "memory")
__device__ __forceinline__ int clampi(int v, int lo, int hi) { return v < lo ? lo : (v > hi ? hi : v); }

__device__ __forceinline__ void attn_phase(NAT_LAS unsigned char* lds, const bf16_t* Q, const bf16_t* K, const bf16_t* V, const bf16_t* ZA, bf16_t* ACAT,
                                           const float* rel_bias, int rps  , int vcu, int G, const int tid) {
    const int lane = tid & 63, wid = __builtin_amdgcn_readfirstlane(tid >> 6), fr = lane & 15, fq = lane >> 4;
    const int rsel = wid >> 2, qb = wid & 3;
    const int c0 = 16 * qb, w0 = (qb == 0) ? 0 : (qb == 1) ? 8 : (qb == 2) ? 24 : 32;
    NAT_LAS float* biasL = (NAT_LAS float*)(lds + BIAS_OFF);
    const unsigned ldsbase = (unsigned)(size_t)lds;
    const int dcol = lane >> 3, dpos = lane & 7;
    int koff[2][2];
#pragma unroll
    for (int hf = 0; hf < 2; ++hf)
#pragma unroll
        for (int ks = 0; ks < 2; ++ks) { const int col = w0 + 16 * hf + fr; koff[hf][ks] = col * 128 + 16 * ((ks * 4 + fq) ^ ((col >> 1) & 7)); }
    const int vcol = w0 + 4 * fq + (fr >> 2), vx = (vcol >> 1) & 3, vlane = vcol * 128 + 16 * ((fr & 3) >> 1) + 8 * (fr & 1);
    bool selhi[4]; int dcs[4]; unsigned mlo[2], mhi[2];
    { const int cq = c0 + fr; int cs = cq - 8; cs = cs < 0 ? 0 : (cs > 48 ? 48 : cs);
#pragma unroll
      for (int j = 0; j < 4; ++j) { const int clo = w0 + 4 * fq + j; selhi[j] = clo < cs; const int ck = selhi[j] ? clo + 16 : clo; int dc = ck - cq + 15; dc = dc < 0 ? 0 : (dc > 30 ? 30 : dc); dcs[j] = dc; }
#pragma unroll
      for (int q = 0; q < 2; ++q) { mlo[q] = (selhi[2 * q] ? 0u : 0xffffu) | (selhi[2 * q + 1] ? 0u : 0xffff0000u); mhi[q] = ~mlo[q]; } }
    for (int bt = vcu; bt < 256; bt += G) {
        const int h = bt >> 4, rp0 = (bt & 15) * 8;
        const int seq = (2 * rp0) / rps, rl0 = 2 * rp0 - seq * rps, srow = seq * rps;
        const bf16_t* Kh = K + (size_t)srow * 64 * 1024 + h * 64; const bf16_t* Vh = V + (size_t)srow * 64 * 1024 + h * 64;
        {
            const int kr0 = clampi(rl0 - 4, 0, rps - 8), hi = clampi(rl0 - 3, 0, rps - 8) + 8, nr = hi - kr0;
            for (int j = wid; j < nr * 16; j += 8) { const int row = kr0 + (j >> 4), isv = (j >> 3) & 1, c8 = j & 7, col = c8 * 8 + dcol, slot = row % 9;
                const int gch = isv ? (dpos ^ (((col >> 1) & 3) << 1)) : (dpos ^ ((col >> 1) & 7));
                const bf16_t* src = (isv ? Vh : Kh) + (size_t)(row * 64 + col) * 1024 + gch * 8;
                glds16(src, (unsigned)__builtin_amdgcn_readfirstlane((int)(ldsbase + (isv ? VIMG : KIMG) + slot * SLOTB + c8 * 1024))); }
            if (tid < 465) biasL[tid] = rel_bias[h * 465 + tid] * 1.4426950408889634f;
        }
        bf16x8 qn[2];
        { const int qtok = (srow + rl0 + rsel) * 64 + c0 + fr;
#pragma unroll
          for (int ks = 0; ks < 2; ++ks) qn[ks] = *(const bf16x8*)(Q + (size_t)qtok * 1024 + h * 64 + ks * 32 + fq * 8); }
        asm volatile("" :: "v"(qn[0]), "v"(qn[1]));
        asm volatile("s_waitcnt vmcnt(0) lgkmcnt(0)\n\ts_barrier" ::: "memory");
#pragma nounroll
        for (int i = 0; i < 8; ++i) {
            const int rl = rl0 + 2 * i;
            const int kr0 = clampi(rl - 4, 0, rps - 8), kr1 = clampi(rl - 3, 0, rps - 8), hi = kr1 + 8;
            const int hin = clampi(rl - 1, 0, rps - 8) + 8;
            const int r = rl + rsel, krow0 = rsel ? kr1 : kr0;
            const int qtok = (srow + r) * 64 + c0 + fr;
            bf16x8 qf[2]; qf[0] = qn[0]; qf[1] = qn[1];
            u32x2 zw[4];
            { const bf16_t* zp = ZA + (size_t)qtok * 1024 + h * 64 + 4 * fq;
#pragma unroll
              for (int nt = 0; nt < 4; ++nt) zw[nt] = *(const u32x2*)(zp + 16 * nt);
              const int qtn = i < 7 ? qtok + 128 : qtok;
#pragma unroll
              for (int ks = 0; ks < 2; ++ks) qn[ks] = *(const bf16x8*)(Q + (size_t)qtn * 1024 + h * 64 + ks * 32 + fq * 8); }
            f32x4 acc[16];
            { int slot = krow0 % 9;
#pragma unroll
              for (int n2 = 0; n2 < 8; ++n2) { const NAT_LAS unsigned char* kp = lds + KIMG + slot * SLOTB;
#pragma unroll
                  for (int hf = 0; hf < 2; ++hf) { const int n = 2 * n2 + hf;
                      const bf16x8 k0 = *(const NAT_LAS bf16x8*)(kp + koff[hf][0]), k1 = *(const NAT_LAS bf16x8*)(kp + koff[hf][1]);
                      acc[n] = __builtin_amdgcn_mfma_f32_16x16x32_bf16(k0, qf[0], (f32x4){0.f, 0.f, 0.f, 0.f}, 0, 0, 0);
                      acc[n] = __builtin_amdgcn_mfma_f32_16x16x32_bf16(k1, qf[1], acc[n], 0, 0, 0); }
                  slot = slot == 8 ? 0 : slot + 1; } }
            asm volatile("s_waitcnt lgkmcnt(0)\n\ts_barrier" ::: "memory");
            if (i < 7) { int row = hi + rsel; row = row > hin - 1 ? hin - 1 : row; const int slot = row % 9;
#pragma unroll
                for (int e = 0; e < 2; ++e) { const int c8 = qb * 2 + e, col = c8 * 8 + dcol, gch = dpos ^ ((col >> 1) & 7);
                    glds16(Kh + (size_t)(row * 64 + col) * 1024 + gch * 8, (unsigned)__builtin_amdgcn_readfirstlane((int)(ldsbase + KIMG + slot * SLOTB + c8 * 1024))); } }
            float sc[8][4];
            { float bvv[8][4];
#pragma unroll
              for (int n2 = 0; n2 < 8; ++n2) { const NAT_LAS float* brow = biasL + (krow0 + n2 - r + 7) * 31;
#pragma unroll
                  for (int j = 0; j < 4; ++j) bvv[n2][j] = brow[dcs[j]]; }
              asm volatile("s_waitcnt lgkmcnt(0)" ::: "memory");
#pragma unroll
              for (int n2 = 0; n2 < 8; ++n2)
#pragma unroll
                  for (int j = 0; j < 4; ++j) sc[n2][j] = (selhi[j] ? acc[2 * n2 + 1][j] : acc[2 * n2][j]) + bvv[n2][j]; }
            float mx = sc[0][0];
#pragma unroll
            for (int n2 = 0; n2 < 8; ++n2)
#pragma unroll
                for (int j = 0; j < 4; ++j) mx = fmaxf(mx, sc[n2][j]);
            mx = fmaxf(mx, __shfl_xor(mx, 16)); mx = fmaxf(mx, __shfl_xor(mx, 32));
            float l0 = 0.f, l1 = 0.f;
#pragma unroll
            for (int n2 = 0; n2 < 8; ++n2) {
#pragma unroll
                for (int j = 0; j < 4; ++j) sc[n2][j] = __builtin_amdgcn_exp2f(sc[n2][j] - mx);
                l0 += sc[n2][0] + sc[n2][1]; l1 += sc[n2][2] + sc[n2][3]; }
            float l = l0 + l1;
            l += __shfl_xor(l, 16); l += __shfl_xor(l, 32);
            const float linv = __builtin_amdgcn_rcpf(l);
            bf16x8 pf[8];
#pragma unroll
            for (int s8 = 0; s8 < 8; ++s8) { const unsigned w0p = pg8::cvt_pk_bf16(sc[s8][0], sc[s8][1]), w1p = pg8::cvt_pk_bf16(sc[s8][2], sc[s8][3]);
                u32x4 w; w.x = w0p & mlo[0]; w.y = w1p & mlo[1]; w.z = w0p & mhi[0]; w.w = w1p & mhi[1]; pf[s8] = __builtin_bit_cast(bf16x8, w); }
            asm volatile("s_waitcnt vmcnt(2) lgkmcnt(0)\n\ts_barrier" ::: "memory");
            f32x4 o[4];
#pragma unroll
            for (int nt = 0; nt < 4; ++nt) o[nt] = (f32x4){0.f, 0.f, 0.f, 0.f};
            { int slot = krow0 % 9;
#pragma unroll
              for (int s8 = 0; s8 < 8; ++s8) { const unsigned vb = ldsbase + VIMG + slot * SLOTB + vlane;
#pragma unroll
                  for (int nt = 0; nt < 4; ++nt) {
                      const s16x4 lo = vtr(vb + (unsigned)(32 * (nt ^ vx)));
                      const s16x4 hi2 = vtr(vb + (unsigned)(2048 + 32 * (nt ^ vx)));
                      const bf16x8 vf = (bf16x8){lo[0], lo[1], lo[2], lo[3], hi2[0], hi2[1], hi2[2], hi2[3]};
                      o[nt] = __builtin_amdgcn_mfma_f32_16x16x32_bf16(vf, pf[s8], o[nt], 0, 0, 0); }
                  slot = slot == 8 ? 0 : slot + 1; } }
            asm volatile("" :: "v"(zw[0]), "v"(zw[1]), "v"(zw[2]), "v"(zw[3]), "v"(qn[0]), "v"(qn[1]));
            asm volatile("s_waitcnt vmcnt(0) lgkmcnt(0)\n\ts_barrier" ::: "memory");
            if (i < 7) { int row = hi + rsel; row = row > hin - 1 ? hin - 1 : row; const int slot = row % 9;
#pragma unroll
                for (int e = 0; e < 2; ++e) { const int c8 = qb * 2 + e, col = c8 * 8 + dcol, gch = dpos ^ (((col >> 1) & 3) << 1);
                    glds16(Vh + (size_t)(row * 64 + col) * 1024 + gch * 8, (unsigned)__builtin_amdgcn_readfirstlane((int)(ldsbase + VIMG + slot * SLOTB + c8 * 1024))); } }
            { bf16_t* op = ACAT + (size_t)qtok * 2048 + 1024 + h * 64 + 4 * fq;
#pragma unroll
              for (int nt = 0; nt < 4; ++nt) { u32x2 w; w.x = pg8::cvt_pk_bf16(o[nt][0] * linv * pg8::bf_lo(zw[nt].x), o[nt][1] * linv * pg8::bf_hi(zw[nt].x));
                  w.y = pg8::cvt_pk_bf16(o[nt][2] * linv * pg8::bf_lo(zw[nt].y), o[nt][3] * linv * pg8::bf_hi(zw[nt].y));
                  *(u32x2*)(op + 16 * nt) = w; } }
        }
        asm volatile("s_waitcnt vmcnt(0) lgkmcnt(0)\n\ts_barrier" ::: "memory");
    }
}
}
namespace misc {
typedef unsigned short bf16_t;
typedef float f32x4 __attribute__((ext_vector_type(4)));
typedef float f32x2 __attribute__((ext_vector_type(2)));
typedef unsigned u32x4 __attribute__((ext_vector_type(4)));
typedef unsigned u32x2 __attribute__((ext_vector_type(2)));
#define MISC_LAS __attribute__((address_space(3)))
#define LDS_WAIT() asm volatile("s_waitcnt lgkmcnt(0)" ::: "memory")
__device__ __forceinline__ unsigned f2bf(float f) { unsigned u = __builtin_bit_cast(unsigned, f); return (u + 0x7fffu + ((u >> 16) & 1u)) >> 16; }
__device__ __forceinline__ unsigned pk2(float lo, float hi) { return f2bf(lo) | (f2bf(hi) << 16); }
__device__ __forceinline__ float wave_sum(float v) {
#pragma unroll
    for (int o = 1; o < 64; o <<= 1) v += __shfl_xor(v, o);
    return v;
}
__device__ __forceinline__ void transpose_item(const float* W, int N, bf16_t* WT, int ldt, int koff, int drow, MISC_LAS float* scr, int k0, int n0, int lane) {
    float v[32];
#pragma unroll
    for (int i = 0; i < 32; ++i) { const int kk = 2 * i + (lane >> 5); v[i] = W[(size_t)(k0 + kk) * N + n0 + (lane & 31)]; }
#pragma unroll
    for (int i = 0; i < 32; ++i) { const int kk = 2 * i + (lane >> 5); scr[kk * 33 + (lane & 31)] = v[i]; }
    LDS_WAIT(); asm volatile("" ::: "memory");
    const int c = lane & 7;
#pragma unroll
    for (int j = 0; j < 4; ++j) { const int n = (lane >> 3) + 8 * j; const MISC_LAS float* s = scr + (8 * c) * 33 + n;
        u32x4 o; o.x = pk2(s[0 * 33], s[1 * 33]); o.y = pk2(s[2 * 33], s[3 * 33]); o.z = pk2(s[4 * 33], s[5 * 33]); o.w = pk2(s[6 * 33], s[7 * 33]);
        *(u32x4*)(WT + (size_t)(drow + n) * ldt + koff + k0 + 8 * c) = o; }
    LDS_WAIT(); asm volatile("" ::: "memory");
}
__device__ __forceinline__ void rms_row(const float* xrow, const float* gam, bf16_t* orow, int lane) {
    const f32x4* xr = (const f32x4*)xrow + lane; const f32x4* gr = (const f32x4*)gam + lane;
    f32x4 v[8]; float s = 0.f;
#pragma unroll
    for (int j = 0; j < 8; ++j) { v[j] = xr[64 * j]; s += (v[j].x * v[j].x + v[j].y * v[j].y) + (v[j].z * v[j].z + v[j].w * v[j].w); }
    const float rs = __builtin_amdgcn_rsqf(wave_sum(s) * (1.f / 2048.f) + 1e-6f);
    u32x2* o8 = (u32x2*)orow + lane;
#pragma unroll
    for (int j = 0; j < 8; ++j) { const f32x4 gg = gr[64 * j]; u32x2 w; w.x = pk2(v[j].x * rs * gg.x, v[j].y * rs * gg.y); w.y = pk2(v[j].z * rs * gg.z, v[j].w * rs * gg.w); o8[64 * j] = w; }
}
__device__ __forceinline__ float exp_small(float x) {
    float t = 1.f, s = 1.f;
#pragma nounroll
    for (int k = 1; k <= 11; ++k) { t *= x * __builtin_amdgcn_rcpf((float)k); s += t; }
    return s;
}
__device__ __forceinline__ float exp_f(float x) {
    float r = exp_small(x * 0.0625f);
    r *= r; r *= r; r *= r; r *= r; return r;
}
__device__ __forceinline__ void sincos_f(float a, float& s, float& c) {
    const float k = __builtin_rintf(a * 0.15915494309189535f);
    float r = __builtin_fmaf(-k, 6.28318548202514648f, a); r = __builtin_fmaf(-k, -1.7484556000744883e-07f, r); r *= 0.25f;
    const float r2 = r * r; float ts = r, tc = 1.f, ss = r, cc = 1.f;
#pragma nounroll
    for (int i = 1; i <= 7; ++i) { const float e = (float)(2 * i); tc *= -r2 * __builtin_amdgcn_rcpf((e - 1.f) * e); ts *= -r2 * __builtin_amdgcn_rcpf(e * (e + 1.f)); cc += tc; ss += ts; }
#pragma nounroll
    for (int i = 0; i < 2; ++i) { const float c2 = cc * cc - ss * ss, s2 = 2.f * ss * cc; cc = c2; ss = s2; }
    s = ss; c = cc;
}
constexpr int SM_POW = 0;
constexpr int SM_FC = SM_POW + 2 * 33 * 65 * 2;
constexpr int SM_BRE = SM_FC + 256;
constexpr int SM_BIM = SM_BRE + 2048;
constexpr int SM_CC = SM_BIM + 2048;
constexpr int SM_TB = SM_CC + 2 * 16 * 65 * 2;
constexpr int TBS = 264;
constexpr int SM_END = SM_TB + 63 * TBS / 2;
static_assert(SM_END * 4 <= 140 * 1024, "SSM builder LDS");

__device__ __forceinline__ void ssm_build(MISC_LAS float* L, int g, const float* a_re, const float* a_im, const float* log_dt, const float* b_re, const float* b_im,
                                          const float* c_re, const float* c_im, const float* dsk, bf16_t* SSMY, bf16_t* SSME, float* AT, int tid, const int stop_at = 9) {
    MISC_LAS f32x2* POW = (MISC_LAS f32x2*)(L + SM_POW); MISC_LAS f32x2* FC = (MISC_LAS f32x2*)(L + SM_FC);
    MISC_LAS float* BRE = L + SM_BRE; MISC_LAS float* BIM = L + SM_BIM; MISC_LAS f32x2* CC = (MISC_LAS f32x2*)(L + SM_CC); MISC_LAS bf16_t* TB = (MISC_LAS bf16_t*)(L + SM_TB);
    if (tid < 128) { const int d = tid >> 6, p = tid & 63;
        float lre = a_re[(d * 64 + g) * 64 + p]; lre = lre < -1e-4f ? lre : -1e-4f; const float lim = a_im[(d * 64 + g) * 64 + p];
        const float dt = exp_f(log_dt[d * 64 + g]);
        const float mag = exp_f(lre * dt); float sn, cs; sincos_f(lim * dt, sn, cs);
        const float zr = mag * cs, zi = mag * sn, rden = 1.f / (lre * lre + lim * lim);
        FC[d * 64 + p] = (f32x2){((zr - 1.f) * lre + zi * lim) * rden, (zi * lre - (zr - 1.f) * lim) * rden};
        float pr = 1.f, pi = 0.f;
#pragma nounroll
        for (int j = 0; j <= 32; ++j) { POW[(d * 33 + j) * 65 + p] = (f32x2){pr, pi}; const float nr = pr * zr - pi * zi, ni = pr * zi + pi * zr; pr = nr; pi = ni; }
        const f32x2 a32 = POW[(d * 33 + 32) * 65 + p]; *(f32x2*)(AT + ((g * 2 + d) * 64 + p) * 2) = a32;
    }
    __syncthreads();
    if (stop_at == 1) return;
    for (int idx = tid; idx < 2048; idx += 512) {
        { const int d = idx >> 10, p = (idx >> 4) & 63, h = idx & 15; const size_t gi = ((size_t)(d * 64 + g) * 64 + p) * 16 + h; const float br = b_re[gi], bi = b_im[gi]; const f32x2 f = FC[d * 64 + p];
          BRE[idx] = f.x * br - f.y * bi; BIM[idx] = f.x * bi + f.y * br; }
        { const int d = idx >> 10, hp = (idx >> 6) & 15, p = idx & 63; const size_t gi = ((size_t)(d * 64 + g) * 16 + hp) * 64 + p; CC[(d * 16 + hp) * 65 + p] = (f32x2){c_re[gi], c_im[gi]}; }
    }
    __syncthreads();
    { const int j = (tid >> 4) & 31, hp = tid & 15; float a[2][16];
#pragma unroll
      for (int d = 0; d < 2; ++d) {
#pragma unroll
        for (int h = 0; h < 16; ++h) a[d][h] = 0.f;
        for (int p = 0; p < 64; ++p) { const f32x2 c = CC[(d * 16 + hp) * 65 + p], w = POW[(d * 33 + j) * 65 + p]; const float cpr = c.x * w.x - c.y * w.y, cpi = c.x * w.y + c.y * w.x;
            const MISC_LAS f32x4* br = (const MISC_LAS f32x4*)(BRE + (d * 64 + p) * 16); const MISC_LAS f32x4* bi = (const MISC_LAS f32x4*)(BIM + (d * 64 + p) * 16);
#pragma unroll
            for (int q = 0; q < 4; ++q) { const f32x4 r4 = br[q], i4 = bi[q];
#pragma unroll
                for (int e = 0; e < 4; ++e) a[d][4 * q + e] += cpr * r4[e] - cpi * i4[e]; } } }
      if (j == 0) { const float dd = dsk[g * 16 + hp];
#pragma unroll
          for (int h = 0; h < 16; h += 2) *(MISC_LAS unsigned*)(TB + 31 * TBS + hp * 16 + h) = pk2(a[0][h] + a[1][h] + (h == hp ? dd : 0.f), a[0][h + 1] + a[1][h + 1] + (h + 1 == hp ? dd : 0.f));
      } else {
#pragma unroll
          for (int h = 0; h < 16; h += 2) { *(MISC_LAS unsigned*)(TB + (31 + j) * TBS + hp * 16 + h) = pk2(a[0][h], a[0][h + 1]); *(MISC_LAS unsigned*)(TB + (31 - j) * TBS + hp * 16 + h) = pk2(a[1][h], a[1][h + 1]); } }
    }
    __syncthreads();
    if (stop_at == 2) return;
    bf16_t* Yg = SSMY + (size_t)g * 512 * 768;
    for (int idx = tid; idx < 512 * 96; idx += 512) { const int n = idx / 96, kc = idx - n * 96, i = n >> 4, hp = n & 15; float v[8];
        if (kc < 64) { const int j = kc >> 1, h0 = (kc & 1) * 8;
            *(u32x4*)(Yg + (size_t)n * 768 + kc * 8) = *(const MISC_LAS u32x4*)(TB + (31 + i - j) * TBS + hp * 16 + h0); continue;
        } else { const int kk = (kc - 64) * 8, d = kk >> 7, ri = (kk >> 6) & 1, p0 = kk & 63, jj = d == 0 ? i + 1 : 32 - i;
#pragma unroll
            for (int e = 0; e < 8; ++e) { const f32x2 c = CC[(d * 16 + hp) * 65 + p0 + e], w = POW[(d * 33 + jj) * 65 + p0 + e]; v[e] = ri ? -(c.x * w.y + c.y * w.x) : (c.x * w.x - c.y * w.y); } }
        u32x4 o; o.x = pk2(v[0], v[1]); o.y = pk2(v[2], v[3]); o.z = pk2(v[4], v[5]); o.w = pk2(v[6], v[7]);
        *(u32x4*)(Yg + (size_t)n * 768 + kc * 8) = o; }
    bf16_t* Eg = SSME + (size_t)g * 256 * 512;
    for (int idx = tid; idx < 256 * 64; idx += 512) { const int n = idx >> 6, kc = idx & 63, d = n >> 7, ri = (n >> 6) & 1, p = n & 63, j = kc >> 1, h0 = (kc & 1) * 8, jj = d == 0 ? 31 - j : j;
        const f32x2 w = POW[(d * 33 + jj) * 65 + p]; float v[8];
#pragma unroll
        for (int e = 0; e < 8; ++e) { const float br = BRE[(d * 64 + p) * 16 + h0 + e], bi = BIM[(d * 64 + p) * 16 + h0 + e]; v[e] = ri ? (w.x * bi + w.y * br) : (w.x * br - w.y * bi); }
        u32x4 o; o.x = pk2(v[0], v[1]); o.y = pk2(v[2], v[3]); o.z = pk2(v[4], v[5]); o.w = pk2(v[6], v[7]);
        *(u32x4*)(Eg + (size_t)n * 512 + kc * 8) = o; }
    __syncthreads();
}
__device__ __forceinline__ void rec_one(const float* __restrict__ E, bf16_t* __restrict__ UEXT, const float* __restrict__ AT, int seq, int g, int d, int nc, int lane) {
    const f32x2 at = *(const f32x2*)(AT + ((g * 2 + d) * 64 + lane) * 2);
    float sr = 0.f, si = 0.f;
    const int cb = seq * nc;
#pragma unroll 8
    for (int q = 0; q < nc; ++q) { const int c = cb + (d == 0 ? q : nc - 1 - q);
        const float er = E[((size_t)(g * 512 + c)) * 256 + d * 128 + lane], ei = E[((size_t)(g * 512 + c)) * 256 + d * 128 + 64 + lane];
        bf16_t* up = UEXT + ((size_t)(g * 512 + c)) * 768 + 512 + d * 128 + lane;
        up[0] = (bf16_t)f2bf(sr); up[64] = (bf16_t)f2bf(si);
        const float nr = at.x * sr - at.y * si + er, ni = at.x * si + at.y * sr + ei; sr = nr; si = ni; }
}
__device__ __forceinline__ void rec_phase(const float* __restrict__ E, bf16_t* __restrict__ UEXT, const float* __restrict__ AT, int nseq, int nc, int gw, int NGW, int lane) {
    for (int task = gw; task < nseq * 128; task += NGW) rec_one(E, UEXT, AT, task >> 7, (task >> 1) & 63, task & 1, nc, lane);
}
}
#define XB_TMO      128
#define XB_XCNT(j)  (256  + 64 * (j))
#define XB_XSUB(j)  (1280 + 64 * (j))
#define XB_XGEN(j)  (2304 + 64 * (j))
#define XB_TOP      3328
#define XB_TOPGEN   3392
#define XCD_BAR_WORDS 3456
#define XB_SPIN_CAP (1u << 18)
#define XB_LAS __attribute__((address_space(3)))
__device__ __forceinline__ unsigned xb_ld(unsigned* p)              { return __hip_atomic_load(p, __ATOMIC_RELAXED, __HIP_MEMORY_SCOPE_AGENT); }
__device__ __forceinline__ unsigned xb_add(unsigned* p, unsigned v) { return __hip_atomic_fetch_add(p, v, __ATOMIC_RELAXED, __HIP_MEMORY_SCOPE_AGENT); }
__device__ __forceinline__ unsigned xb_xcc_id() { return (unsigned)__builtin_amdgcn_s_getreg((3 << 11) | 20) & 0xFu; }
#define XB_SPIN(cond, bar) do { unsigned _sp = 0; while (cond) { __builtin_amdgcn_s_sleep(1); \
    if ((++_sp & 255u) == 0u) { if (xb_ld(&(bar)[XB_TMO])) break; if (_sp > XB_SPIN_CAP) { atomicAdd(&(bar)[XB_TMO], 1u); break; } } } } while (0)
struct XcdBarrier { unsigned* bar; unsigned x; volatile XB_LAS unsigned* st; };
__device__ __forceinline__ XcdBarrier xcd_barrier_post(unsigned* bar, volatile XB_LAS unsigned* st) {
    XcdBarrier b; b.bar = bar; b.x = xb_xcc_id(); b.st = st;
    if (threadIdx.x == 0) (void)xb_add(&bar[XB_XCNT(b.x)], 1u);
    return b;
}
__device__ __forceinline__ void xcd_barrier_complete(unsigned* bar, unsigned x, unsigned& nloc, unsigned& nx) {
    const unsigned G = gridDim.x * gridDim.y * gridDim.z;
    unsigned sum, cnt, mine, sp = 0u;
    for (;;) {
        sum = 0u; cnt = 0u; mine = 0u;
#pragma unroll
        for (unsigned j = 0; j < 16; ++j) { const unsigned c = xb_ld(&bar[XB_XCNT(j)]); sum += c; cnt += (c > 0u) ? 1u : 0u; mine = (j == x) ? c : mine; }
        if (sum == G) break;
        __builtin_amdgcn_s_sleep(1);
        if ((++sp & 255u) == 0u) { if (xb_ld(&bar[XB_TMO])) break; if (sp > XB_SPIN_CAP) { atomicAdd(&bar[XB_TMO], 1u); break; } }
    }
    nloc = mine > 0u ? mine : 1u; nx = cnt > 0u ? cnt : 1u;
}
__device__ __forceinline__ void xcd_barrier(const XcdBarrier& b) {
    asm volatile("s_waitcnt vmcnt(0)" ::: "memory");
    __syncthreads();
    if (threadIdx.x == 0) {
        unsigned* bar = b.bar;
        __builtin_amdgcn_s_waitcnt(0);
        unsigned nloc = b.st[0], nx = b.st[1];
        if (nloc == 0u) { xcd_barrier_complete(bar, b.x, nloc, nx); b.st[0] = nloc; b.st[1] = nx; }
        const unsigned old = xb_add(&bar[XB_XSUB(b.x)], 1u);
        const unsigned gen = old / nloc;
        if (old + 1u == (gen + 1u) * nloc) {
            __builtin_amdgcn_fence(__ATOMIC_RELEASE, "agent");
            asm volatile("s_waitcnt vmcnt(0)" ::: "memory");
            const unsigned og = xb_add(&bar[XB_TOP], 1u);
            const unsigned tg = og / nx;
            if (og + 1u == (tg + 1u) * nx) xb_add(&bar[XB_TOPGEN], 1u);
            else XB_SPIN(xb_ld(&bar[XB_TOPGEN]) == tg, bar);
            __builtin_amdgcn_fence(__ATOMIC_ACQUIRE, "agent");
            xb_add(&bar[XB_XGEN(b.x)], 1u);
            asm volatile("s_waitcnt vmcnt(0)" ::: "memory");
        } else {
            XB_SPIN(xb_ld(&bar[XB_XGEN(b.x)]) == gen, bar);
            __builtin_amdgcn_fence(__ATOMIC_ACQUIRE, "agent");
            asm volatile("s_waitcnt vmcnt(0)" ::: "memory");
        }
    }
    __syncthreads();
}
#ifndef PH_MASK
#define PH_MASK 0xff
#endif
#define HAS(k) (((PH_MASK) >> (k)) & 1)
#ifndef SYNC_REPS
#define SYNC_REPS 1
#endif
#ifndef DUP_SKIP_SSM
#define DUP_SKIP_SSM 0
#endif
#ifndef G1_WGM
#define G1_WGM 8
#endif
#ifndef G1_ALIGN
#define G1_ALIGN true
#endif
#ifndef G1_SP2
#define G1_SP2 true
#endif
#ifndef DUP_MASK
#define DUP_MASK 0
#endif
#ifndef MK_MULTI
#define MK_MULTI 0
#endif
typedef unsigned short bf16;
constexpr size_t MiB = 1u << 20;
constexpr int MP = 16384;
constexpr size_t WS_WIN = 0, WS_WGLU = 40 * MiB, WS_WMRG = 42 * MiB, WS_WOUT = 50 * MiB, WS_SSMY = 58 * MiB, WS_SSME = 106 * MiB, WS_AT = 122 * MiB,
                 WS_H = 123 * MiB  , WS_UEXT = 187 * MiB  , WS_ZS = 235 * MiB, WS_Q = 267 * MiB, WS_K = 299 * MiB, WS_V = 331 * MiB,
                 WS_ZA = 363 * MiB, WS_Y = 395 * MiB, WS_E = 427 * MiB, WS_END = 459 * MiB;
constexpr int LDS_BYTES = 147456 + 2048 + 256;
constexpr size_t WS_BAR = WS_END, WS_BAR_BYTES = 16384;
constexpr int N_PHASES = 15;
extern "C" __device__ void __ockl_grid_sync(void);

constexpr int I_IN = 32 * 320, I_GLU = 16 * 32, I_BS = 16 * 64, I_OUT = 32 * 64, NITEMS = I_IN + I_GLU + 2 * I_BS + I_OUT;
__device__ __forceinline__ void weight_item(int r, const float* w_in, const float* w_glu, const float* w_bs, const float* w_ba, const float* w_out,
                                            unsigned short* WIN, unsigned short* WGLU, unsigned short* WMRG, unsigned short* WOUT, MISC_LAS float* scr, int lane) {
    if (r < I_IN) { const int kb = r / 320, nb = r % 320, n0 = nb * 32; int drow = n0;
        if (n0 >= 2048 && n0 < 4096) drow = (n0 & ~255) + 128 * ((n0 >> 5) & 1) + 32 * ((n0 >> 6) & 3);
        misc::transpose_item(w_in, 10240, WIN, 2048, 0, drow, scr, kb * 64, n0, lane); return; } r -= I_IN;
    if (r < I_GLU) { misc::transpose_item(w_glu, 1024, WGLU, 1024, 0, (r % 32) * 32, scr, (r / 32) * 64, (r % 32) * 32, lane); return; } r -= I_GLU;
    if (r < I_BS) { misc::transpose_item(w_bs, 2048, WMRG, 2048, 0, (r % 64) * 32, scr, (r / 64) * 64, (r % 64) * 32, lane); return; } r -= I_BS;
    if (r < I_BS) { misc::transpose_item(w_ba, 2048, WMRG, 2048, 1024, (r % 64) * 32, scr, (r / 64) * 64, (r % 64) * 32, lane); return; } r -= I_BS;
    misc::transpose_item(w_out, 2048, WOUT, 2048, 0, (r % 64) * 32, scr, (r / 64) * 64, (r % 64) * 32, lane);
}

struct Args { const float* in[20]; float* out; unsigned char* ws; int ph_lo, ph_hi; };

__global__ void __launch_bounds__(512, 2) hybrid_fwd(Args args) {
    extern __shared__ __attribute__((aligned(16))) unsigned char lds_raw[];
    PG8_LAS unsigned char* lds = (PG8_LAS unsigned char*)lds_raw;
#if !MK_MULTI
    { volatile XB_LAS unsigned* st0 = (volatile XB_LAS unsigned*)((PG8_LAS unsigned char*)lds_raw + (LDS_BYTES - 64)); if (threadIdx.x < 2) st0[threadIdx.x] = 0u; }
    __syncthreads();
    XcdBarrier xbar; xbar.bar = (unsigned*)(args.ws + WS_BAR); xbar.x = xb_xcc_id(); xbar.st = (volatile XB_LAS unsigned*)((PG8_LAS unsigned char*)lds_raw + (LDS_BYTES - 64));
    if (args.ph_lo == 0 && blockIdx.x == 0) { for (int w = threadIdx.x; w < XCD_BAR_WORDS; w += 512) xbar.bar[w] = 0u; }
#endif
    const int G = gridDim.x, bx = blockIdx.x, vcu = (G % 8 == 0) ? (bx % 8) * (G / 8) + bx / 8 : bx;
    bool rep = false, posted = false;
#pragma nounroll
    for (int ph = args.ph_lo; ph < args.ph_hi; ) {
    if (!MK_MULTI && G == 256 && ph != 0 && ((ph - 1) % 7) == 2) { ++ph; continue; }
    int tid = threadIdx.x; asm volatile("" : "+v"(tid));
    size_t zoff = 0; asm volatile("" : "+s"(zoff));
    unsigned char* ws = args.ws + zoff; float* outb = args.out + zoff;
    const int lane = tid & 63, wave = __builtin_amdgcn_readfirstlane(tid >> 6);
    bf16* WIN = (bf16*)(ws + WS_WIN); bf16* WGLU = (bf16*)(ws + WS_WGLU); bf16* WMRG = (bf16*)(ws + WS_WMRG); bf16* WOUT = (bf16*)(ws + WS_WOUT);
    bf16* SSMY = (bf16*)(ws + WS_SSMY); bf16* SSME = (bf16*)(ws + WS_SSME); float* AT = (float*)(ws + WS_AT);
    bf16* HB = (bf16*)(ws + WS_H); bf16* ACAT = HB; bf16* UEXT = (bf16*)(ws + WS_UEXT); bf16* MBUF = UEXT; bf16* ZS = (bf16*)(ws + WS_ZS);
    bf16* QB = (bf16*)(ws + WS_Q); bf16* KB = (bf16*)(ws + WS_K); bf16* VB = (bf16*)(ws + WS_V); bf16* ZA = (bf16*)(ws + WS_ZA); bf16* YB = (bf16*)(ws + WS_Y);
    float* EB = (float*)(ws + WS_E);
        if (ph == 0) { if (HAS(0)) {
            const int nssm = G > 64 ? 64 : 0;
            if (bx < nssm) {
                for (int g = bx; g < 64 && !(DUP_SKIP_SSM == 1 && rep); g += nssm)
                    misc::ssm_build((MISC_LAS float*)lds, g, args.in[4], args.in[5], args.in[6], args.in[7], args.in[8], args.in[9], args.in[10], args.in[11], SSMY, SSME, AT, tid, (DUP_SKIP_SSM > 1 && rep) ? DUP_SKIP_SSM - 1 : 9);
            } else {
                MISC_LAS float* scr = (MISC_LAS float*)(lds + wave * 16384);
                const int gw = (bx - nssm) * 8 + wave, NGW = (G - nssm) * 8;
                const int nearly = (G == 256) ? I_IN : NITEMS;
                for (int it = gw; it < nearly; it += NGW) weight_item(it, args.in[3], args.in[12], args.in[17], args.in[18], args.in[19], WIN, WGLU, WMRG, WOUT, scr, lane);
                for (int m = gw; m < MP; m += NGW) misc::rms_row(args.in[0] + (size_t)m * 2048, args.in[2], HB + (size_t)m * 2048, lane);
                { bf16* HB1 = (bf16*)((unsigned char*)outb + 192 * MiB);
                  for (int m = gw; m < MP; m += NGW) misc::rms_row(args.in[1] + (size_t)m * 2048, args.in[2], HB1 + (size_t)m * 2048, lane); }
            }
            }
            __syncthreads();
        } else {
            const int p = (ph - 1) / 7, s = (ph - 1) % 7;
            const float* xp = args.in[p]; float* outp = outb + (size_t)p * MP * 2048;
            unsigned char* GS = (unsigned char*)outp; unsigned char* GA = GS + (size_t)MP * 2048;
            if (s == 0) { if (HAS(1)) {
                pg8::Gemm g{p == 0 ? HB : (bf16*)((unsigned char*)outb + 192 * MiB), WIN, 2048, 2048, 2048}; pg8::StaticOrder S; S.init(MP, 10240, G, bx, G1_WGM);
                pg8::EpiProj E{UEXT, ZS, QB, KB, VB, ZA, GS, GA, args.in[14], args.in[15]};
                pg8::gemm_phase<pg8::EpiProj, pg8::StaticOrder, G1_ALIGN, G1_SP2>(lds, g, S, E, tid);
            } } else if (s == 1) { if (HAS(2)) {
                nat::attn_phase(lds, QB, KB, VB, ZA, ACAT, args.in[16], p == 0 ? 32 : 128, vcu, G, tid);
                pg8::Gemm g{UEXT, SSME, 768, 512, 512}; pg8::GroupOrder S; S.init(64, 2, 1, G, bx);
                pg8::EpiE E{EB};
                pg8::gemm_phase<pg8::EpiE, pg8::GroupOrder, true, true>(lds, g, S, E, tid);
                if (G == 256 && bx >= 128 && p == 0) {
                    MISC_LAS float* scr = (MISC_LAS float*)(lds + wave * 16384);
                    for (int it = I_IN + (bx - 128) * 8 + wave; it < NITEMS; it += 1024) weight_item(it, args.in[3], args.in[12], args.in[17], args.in[18], args.in[19], WIN, WGLU, WMRG, WOUT, scr, lane);
                }
                if (G == 256 && bx < 128) {
                    asm volatile("s_waitcnt vmcnt(0)" ::: "memory"); __syncthreads();
                    const int nc = p == 0 ? 64 : 256, nloc = 256 / nc;
                    if (wave < 2 * nloc) misc::rec_one(EB, UEXT, AT, (bx & 1) * nloc + (wave >> 1), bx >> 1, wave & 1, nc, lane);
                }
            } } else if (s == 2) { if (HAS(3)) {
                misc::rec_phase(EB, UEXT, AT, p == 0 ? 8 : 2, p == 0 ? 64 : 256, vcu * 8 + wave, G * 8, lane);
            } } else if (s == 3) { if (HAS(4)) {
                pg8::Gemm g{UEXT, SSMY, 768, 768, 768}; pg8::GroupOrder S; S.init(64, 2, 2, G, bx);
                pg8::EpiY E{YB};
                pg8::gemm_phase<pg8::EpiY, pg8::GroupOrder, true, true>(lds, g, S, E, tid);
            } } else if (s == 4) { if (HAS(5)) {
                pg8::Gemm g{YB, WGLU, 1024, 1024, 1024}; pg8::StaticOrder S; S.init(MP, 1024, G, bx);
                pg8::EpiGlu E{YB, ZS, args.in[13], ACAT};
                pg8::gemm_phase<pg8::EpiGlu, pg8::StaticOrder, true, true>(lds, g, S, E, tid);
            } } else if (s == 5) { if (HAS(6)) {
                pg8::Gemm g{ACAT, WMRG, 2048, 2048, 2048}; pg8::StaticOrder S; S.init(MP, 2048, G, bx);
                pg8::EpiMerge E{GS, GA, MBUF};
                pg8::gemm_phase<pg8::EpiMerge, pg8::StaticOrder, true, true>(lds, g, S, E, tid);
            } } else { if (HAS(7)) {
                pg8::Gemm g{MBUF, WOUT, 2048, 2048, 2048}; pg8::StaticOrder S; S.init(MP, 2048, G, bx);
                pg8::EpiOut E{xp, outp};
                pg8::gemm_phase<pg8::EpiOut, pg8::StaticOrder, true, true>(lds, g, S, E, tid);
            } }
            __syncthreads();
        }
        { const int kbit = ph == 0 ? 0 : ((ph - 1) % 7) + 1; const bool again = ((DUP_MASK >> kbit) & 1) && !rep;
          if (again) rep = true; else { rep = false; ++ph; }
#if !MK_MULTI
          if (ph < args.ph_hi) { if (!posted) { __ockl_grid_sync(); if (threadIdx.x == 0) (void)xb_add(&xbar.bar[XB_XCNT(xbar.x)], 1u); posted = true; } else xcd_barrier(xbar); }
#endif
        }
    }
}

#ifdef STOP_PH
__global__ void dump_k(const unsigned short* src, float* out, size_t n) {
    for (size_t i = (size_t)blockIdx.x * blockDim.x + threadIdx.x; i < n; i += (size_t)gridDim.x * blockDim.x) { float acc = 0.f;
        for (int w = 0; w < 4; ++w) { unsigned v = src[(size_t)w * n + i]; if ((v & 0x7f80u) == 0x7f80u) v = 0; acc += __uint_as_float(v << 16); }
        out[i] = acc; }
}
#endif
extern "C" void kernel_launch(void* const* d_in, const int* in_sizes, int n_in, void* d_out, int out_size, void* d_ws, size_t ws_size, hipStream_t stream) {
    static int grid = 0;
    if (grid == 0) {
        if (n_in != 20 || in_sizes[0] != MP * 2048 || in_sizes[1] != MP * 2048 || out_size != 2 * MP * 2048 || ws_size < WS_END + WS_BAR_BYTES) {
            fprintf(stderr, "kernel_launch: unexpected shapes / workspace (n_in %d, ws %zu)\n", n_in, ws_size); grid = -1; return; }
        int dev = 0, cus = 0, per_cu = 0;
        if (hipGetDevice(&dev) != hipSuccess || hipDeviceGetAttribute(&cus, hipDeviceAttributeMultiprocessorCount, dev) != hipSuccess) { grid = -1; return; }
        if (hipFuncSetAttribute((const void*)hybrid_fwd, hipFuncAttributeMaxDynamicSharedMemorySize, LDS_BYTES) != hipSuccess) { fprintf(stderr, "kernel_launch: hipFuncSetAttribute failed\n"); grid = -1; return; }
        if (hipOccupancyMaxActiveBlocksPerMultiprocessor(&per_cu, (const void*)hybrid_fwd, 512, LDS_BYTES) != hipSuccess || per_cu < 1) per_cu = 1;
        (void)hipGetLastError();
        grid = cus * per_cu;
        fprintf(stderr, "kernel_launch: grid %d (cus %d x %d), ws %zu\n", grid, cus, per_cu, ws_size);
    }
    if (grid < 0) return;
#ifdef MK_MEMSET
#if MK_MEMSET == 1
    (void)hipMemsetAsync(d_ws, 0xAA, WS_END, stream);
    (void)hipMemsetAsync(d_out, 0xAA, (size_t)out_size * 4, stream);
#elif MK_MEMSET == 2
    (void)hipMemsetAsync((char*)d_ws + WS_END, 0xAA, 64, stream);
#elif MK_MEMSET == 3
    (void)hipMemsetAsync(d_ws, 0xAA, WS_END, stream);
#elif MK_MEMSET == 4
    (void)hipMemsetAsync(d_out, 0xAA, (size_t)out_size * 4, stream);
#endif
#endif
    Args a{};
    for (int i = 0; i < 20; ++i) a.in[i] = (const float*)d_in[i];
    a.out = (float*)d_out; a.ws = (unsigned char*)d_ws;
#if MK_MULTI
#ifdef STOP_PH
    for (int ph = 0; ph <= STOP_PH; ++ph) { a.ph_lo = ph; a.ph_hi = ph + 1; hipLaunchKernelGGL(hybrid_fwd, dim3(grid), dim3(512), LDS_BYTES, stream, a); }
    hipLaunchKernelGGL(dump_k, dim3(2048), dim3(256), 0, stream, (const unsigned short*)d_ws, (float*)d_out, (size_t)out_size);
#else
    for (int ph = 0; ph < N_PHASES; ++ph) { a.ph_lo = ph; a.ph_hi = ph + 1; hipLaunchKernelGGL(hybrid_fwd, dim3(grid), dim3(512), LDS_BYTES, stream, a); }
#endif
#else
    a.ph_lo = 0; a.ph_hi = N_PHASES;
    void* kargs[] = {&a};
    const hipError_t e = hipLaunchCooperativeKernel((const void*)hybrid_fwd, dim3(grid), dim3(512), kargs, LDS_BYTES, stream);
    if (e != hipSuccess) fprintf(stderr, "kernel_launch: cooperative launch failed: %s (grid %d)\n", hipGetErrorString(e), grid);
#endif
}
```

```cpp
#define MK_MULTI 0
#include <hip/hip_runtime.h>
#include <cstdio>
#include <cstdint>
#include <cmath>
namespace pg8 {
#define PG8_LAS __attribute__((address_space(3)))
typedef unsigned short bf16_t;
typedef short bf16x8 __attribute__((ext_vector_type(8)));
typedef float f32x4 __attribute__((ext_vector_type(4)));
typedef float f32x2 __attribute__((ext_vector_type(2)));
typedef unsigned u32x4 __attribute__((ext_vector_type(4)));
typedef unsigned u32x2 __attribute__((ext_vector_type(2)));
constexpr int BM = 256, BK = 64, HALF = 128, HTB = HALF * BK * 2  , STAGE_BYTES = 8 * HTB, NXCD = 8, WGM = 8;

__host__ __device__ __forceinline__ int lds_byte(int r, int c) { const int st = (r >> 4) * 2 + (c >> 5), rr = r & 15, cc = c & 31, ob = rr * 64 + cc * 2; return st * 1024 + (ob ^ (((ob >> 9) & 1) << 5)); }
__host__ __device__ __forceinline__ void stage_rc(int b, int& R, int& C) { const int st = b / 1024, sb = b % 1024, swz = sb ^ (((sb >> 9) & 1) << 5); R = (st >> 1) * 16 + swz / 64; C = (st & 1) * 32 + (swz % 64) / 2; }
__host__ __device__ __forceinline__ int perm32(int rho) { const int n = rho >> 4, i = rho & 15; return 8 * (i >> 2) + 4 * n + (i & 3); }

struct Unit { int pm, pn; };
struct Gemm { const bf16_t* A; const bf16_t* Bt; int lda, ldb, K; };

struct StaticOrder {
    int nM, nN, nwg, G, c, wgm;
    __host__ __device__ void init(int M, int N, int G_, int c_, int wgm_ = WGM) { nM = M / BM; nN = N / BM; nwg = nM * nN; G = G_; c = c_; wgm = wgm_; }
    __host__ __device__ bool next(int i, Unit& u) const {
        const long L = (long)i * G + c; if (L >= nwg) return false;
        int wgid = (int)L; { const int q = nwg / NXCD, r = nwg % NXCD, xcd = wgid % NXCD, off = wgid / NXCD; wgid = (xcd < r ? xcd * (q + 1) : r * (q + 1) + (xcd - r) * q) + off; }
        const int nig = wgm * nN, gid = wgid / nig, fm = gid * wgm, gsz = (nM - fm) < wgm ? (nM - fm) : wgm;
        u.pm = fm + ((wgid % nig) % gsz); u.pn = (wgid % nig) / gsz; return true;
    }
};
struct RangeOrder {
    StaticOrder S; int i0, n;
    __host__ __device__ bool next(int i, Unit& u) const { if (i >= n) return false; return S.next(i0 + i, u); }
};
struct GroupOrder {
    int rt, ct, total, G, c;
    __host__ __device__ void init(int nG, int rt_, int ct_, int G_, int c_) { rt = rt_; ct = ct_; total = nG * rt_ * ct_; G = G_; c = c_; }
    __host__ __device__ bool next(int i, Unit& u) const {
        const int L = i * G + c; if (L >= total) return false;
        const int per = rt * ct, g = L / per, r = L % per; u.pm = g * rt + r % rt; u.pn = g * ct + r / rt; return true;
    }
};

typedef __bf16 bf16x2_t __attribute__((ext_vector_type(2)));
__device__ __forceinline__ unsigned cvt_pk_bf16(float lo, float hi) { const f32x2 v = {lo, hi}; const bf16x2_t b = __builtin_convertvector(v, bf16x2_t); return __builtin_bit_cast(unsigned, b); }
__device__ __forceinline__ float bf_lo(unsigned w) { return __uint_as_float(w << 16); }
__device__ __forceinline__ float bf_hi(unsigned w) { return __uint_as_float(w & 0xffff0000u); }

template <class Epi, class Sched, bool ALIGN_EPI = false, bool SP2 = false>
__device__ __forceinline__ void gemm_phase(PG8_LAS unsigned char* lds, const Gemm g, const Sched& S, const Epi& E, const int tid) {
    const int wid = __builtin_amdgcn_readfirstlane(tid >> 6), lane = tid & 63, wr = wid >> 2, wc = wid & 3, fr = lane & 15, fq = lane >> 4;
    const int K = g.K, nt = K / BK;
    unsigned voffA[2], voffB[2];
#pragma unroll
    for (int i = 0; i < 2; ++i) { int R, C; stage_rc(tid * 16 + i * 8192, R, C); const int Rb = Epi::PERM ? ((R & ~31) + perm32(R & 31)) : R;
        voffA[i] = (unsigned)(R * g.lda + C) * 2u; voffB[i] = (unsigned)(Rb * g.ldb + C) * 2u; }
    const size_t kstep = (size_t)(BK * 2);
    const size_t hstepA = (size_t)HALF * g.lda * 2, hstepB = (size_t)HALF * g.ldb * 2;
    const size_t tstepA = 2 * hstepA, tstepB = 2 * hstepB;
    const unsigned ldsw = (unsigned)wid * 1024u;
    const int aoff = lds_byte(wr * 64 + fr, fq * 8), boff = lds_byte(wc * 32 + fr, fq * 8);
#define PG8_SA(b, h) (((b) * 2 + (h)) * HTB)
#define PG8_SB(b, h) ((4 + (b) * 2 + (h)) * HTB)
#define PG8_STAGE(bufoff, gbase, voff) do { _Pragma("unroll") for (int _i = 0; _i < 2; ++_i) \
        __builtin_amdgcn_global_load_lds((const unsigned*)((const char*)(gbase) + (voff)[_i]), (PG8_LAS unsigned*)(lds + (bufoff) + ldsw + _i * 8192), 16, 0, 0); } while (0)
#define PG8_LDA(dst, b, h) do { _Pragma("unroll") for (int m = 0; m < 4; ++m) _Pragma("unroll") for (int k = 0; k < 2; ++k) dst[m][k] = *(const PG8_LAS bf16x8*)(lds + PG8_SA(b, h) + aoff + m * 2048 + k * 1024); } while (0)
#define PG8_LDB(dst, b, h) do { _Pragma("unroll") for (int n = 0; n < 2; ++n) _Pragma("unroll") for (int k = 0; k < 2; ++k) dst[n][k] = *(const PG8_LAS bf16x8*)(lds + PG8_SB(b, h) + boff + n * 2048 + k * 1024); } while (0)
#define PG8_MMA(ai, bj, At, Bt) do { __builtin_amdgcn_s_setprio(1); _Pragma("unroll") for (int m = 0; m < 4; ++m) _Pragma("unroll") for (int n = 0; n < 2; ++n) _Pragma("unroll") for (int k = 0; k < 2; ++k) \
        acc[ai][bj][m][n] = __builtin_amdgcn_mfma_f32_16x16x32_bf16(Bt[n][k], At[m][k], acc[ai][bj][m][n], 0, 0, 0); __builtin_amdgcn_s_setprio(0); } while (0)
#define PG8_WAIT_V(n) asm volatile("s_waitcnt vmcnt(" #n ")" ::: "memory")
#define PG8_WAIT_L(n) asm volatile("s_waitcnt lgkmcnt(" #n ")" ::: "memory")
#define PG8_BAR __builtin_amdgcn_s_barrier()
#define PG8_SCHED __builtin_amdgcn_sched_barrier(0)
    Unit cur, nxt; int ui = 0;
    if (!S.next(0, cur)) return;
    f32x4 acc[2][2][4][2];
#pragma unroll
    for (int a = 0; a < 2; ++a)
#pragma unroll
        for (int b = 0; b < 2; ++b)
#pragma unroll
            for (int m = 0; m < 4; ++m)
#pragma unroll
                for (int n = 0; n < 2; ++n) acc[a][b][m][n] = (f32x4){0.f, 0.f, 0.f, 0.f};
    bf16x8 At[4][2], B0[2][2], B1[2][2];
    const char* cA = (const char*)g.A + (size_t)cur.pm * tstepA; const char* cB = (const char*)g.Bt + (size_t)cur.pn * tstepB;
    if constexpr (SP2) {
        PG8_STAGE(PG8_SB(0, 0), cB, voffB); PG8_STAGE(PG8_SB(0, 1), cB + hstepB, voffB); PG8_STAGE(PG8_SA(0, 0), cA, voffA); PG8_STAGE(PG8_SA(0, 1), cA + hstepA, voffA);
        if (wr == 1) PG8_BAR;
        PG8_WAIT_V(2); PG8_BAR;
        PG8_STAGE(PG8_SB(1, 0), cB + kstep, voffB); PG8_STAGE(PG8_SA(1, 0), cA + kstep, voffA); PG8_STAGE(PG8_SB(1, 1), cB + hstepB + kstep, voffB);
        PG8_WAIT_V(6); PG8_BAR;
    } else {
        PG8_STAGE(PG8_SB(0, 0), cB, voffB); PG8_STAGE(PG8_SA(0, 0), cA, voffA); PG8_STAGE(PG8_SB(0, 1), cB + hstepB, voffB); PG8_STAGE(PG8_SA(0, 1), cA + hstepA, voffA);
        if (wr == 1) PG8_BAR;
        PG8_WAIT_V(4); PG8_BAR;
        PG8_STAGE(PG8_SB(1, 0), cB + kstep, voffB); PG8_STAGE(PG8_SA(1, 0), cA + kstep, voffA); PG8_STAGE(PG8_SB(1, 1), cB + hstepB + kstep, voffB);
        PG8_WAIT_V(6); PG8_BAR;
    }
    for (;;) {
        const bool has_next = S.next(ui + 1, nxt);
        const char* nA = has_next ? (const char*)g.A + (size_t)nxt.pm * tstepA : cA; const char* nB = has_next ? (const char*)g.Bt + (size_t)nxt.pn * tstepB : cB;
        for (int t = 0; t < nt; t += 2) {
            const bool last = (t == nt - 2);
            const char* a1 = cA + (size_t)(t + 1) * kstep;
            const char* a2 = last ? nA : cA + (size_t)(t + 2) * kstep; const char* b2 = last ? nB : cB + (size_t)(t + 2) * kstep;
            const char* a3 = a2 + kstep; const char* b3 = b2 + kstep;
            if constexpr (Epi::MIDK) { if (t == (nt >> 1)) E.mid(acc, cur, wr, wc, fr, fq); }
            if constexpr (SP2) {
            PG8_LDB(B0, 0, 0); PG8_LDB(B1, 0, 1); PG8_SCHED; PG8_LDA(At, 0, 0); PG8_STAGE(PG8_SA(1, 1), a1 + hstepA, voffA);
            PG8_WAIT_V(8); PG8_WAIT_L(0); PG8_BAR; PG8_MMA(0, 0, At, B0); PG8_MMA(0, 1, At, B1); PG8_BAR; PG8_SCHED;
            PG8_LDA(At, 0, 1); PG8_STAGE(PG8_SB(0, 0), b2, voffB); PG8_STAGE(PG8_SB(0, 1), b2 + hstepB, voffB); PG8_STAGE(PG8_SA(0, 0), a2, voffA);
            PG8_WAIT_V(8); PG8_WAIT_L(0); PG8_BAR; PG8_MMA(1, 0, At, B0); PG8_MMA(1, 1, At, B1); PG8_BAR; PG8_SCHED;
            PG8_LDB(B0, 1, 0); PG8_LDB(B1, 1, 1); PG8_SCHED; PG8_LDA(At, 1, 0); PG8_STAGE(PG8_SA(0, 1), a2 + hstepA, voffA);
            PG8_WAIT_V(8); PG8_WAIT_L(0); PG8_BAR; PG8_MMA(0, 0, At, B0); PG8_MMA(0, 1, At, B1); PG8_BAR; PG8_SCHED;
            PG8_LDA(At, 1, 1); PG8_STAGE(PG8_SB(1, 0), b3, voffB); PG8_STAGE(PG8_SB(1, 1), b3 + hstepB, voffB); PG8_STAGE(PG8_SA(1, 0), a3, voffA);
            PG8_WAIT_V(8); PG8_WAIT_L(0); PG8_BAR; PG8_MMA(1, 0, At, B0); PG8_MMA(1, 1, At, B1); PG8_BAR; PG8_SCHED;
            } else {
            PG8_LDB(B0, 0, 0); PG8_SCHED; PG8_LDA(At, 0, 0); PG8_STAGE(PG8_SA(1, 1), a1 + hstepA, voffA);
            PG8_WAIT_L(8); PG8_BAR; PG8_WAIT_L(0); PG8_MMA(0, 0, At, B0); PG8_BAR; PG8_SCHED;
            PG8_LDB(B1, 0, 1); PG8_STAGE(PG8_SB(0, 0), b2, voffB);
            PG8_BAR; PG8_WAIT_L(0); PG8_MMA(0, 1, At, B1); PG8_BAR;
            PG8_LDA(At, 0, 1); PG8_STAGE(PG8_SA(0, 0), a2, voffA);
            PG8_BAR; PG8_WAIT_L(0); PG8_MMA(1, 0, At, B0); PG8_BAR; PG8_SCHED;
            PG8_STAGE(PG8_SB(0, 1), b2 + hstepB, voffB);
            PG8_WAIT_V(6); PG8_BAR; PG8_MMA(1, 1, At, B1); PG8_BAR;
            PG8_LDB(B0, 1, 0); PG8_SCHED; PG8_LDA(At, 1, 0); PG8_STAGE(PG8_SA(0, 1), a2 + hstepA, voffA);
            PG8_WAIT_L(8); PG8_BAR; PG8_WAIT_L(0); PG8_MMA(0, 0, At, B0); PG8_BAR; PG8_SCHED;
            PG8_LDB(B1, 1, 1); PG8_STAGE(PG8_SB(1, 0), b3, voffB);
            PG8_BAR; PG8_WAIT_L(0); PG8_MMA(0, 1, At, B1); PG8_BAR;
            PG8_LDA(At, 1, 1); PG8_STAGE(PG8_SA(1, 0), a3, voffA);
            PG8_BAR; PG8_WAIT_L(0); PG8_MMA(1, 0, At, B0); PG8_BAR; PG8_SCHED;
            PG8_STAGE(PG8_SB(1, 1), b3 + hstepB, voffB);
            PG8_WAIT_V(6); PG8_BAR; PG8_MMA(1, 1, At, B1); PG8_BAR;
            }
        }
        if constexpr (ALIGN_EPI) { if (wr == 0) PG8_BAR; }
        E(acc, cur, wr, wc, fr, fq);
        if (!has_next) break;
#pragma unroll
        for (int a = 0; a < 2; ++a)
#pragma unroll
            for (int b = 0; b < 2; ++b)
#pragma unroll
                for (int m = 0; m < 4; ++m)
#pragma unroll
                    for (int n = 0; n < 2; ++n) acc[a][b][m][n] = (f32x4){0.f, 0.f, 0.f, 0.f};
        cur = nxt; cA = nA; cB = nB; ++ui;
        if constexpr (ALIGN_EPI) { if (wr == 1) PG8_BAR; }
    }
    PG8_WAIT_V(0);
    if constexpr (!ALIGN_EPI) { if (wr == 0) PG8_BAR; }
    PG8_BAR;
#undef PG8_SA
#undef PG8_SB
#undef PG8_STAGE
#undef PG8_LDA
#undef PG8_LDB
#undef PG8_MMA
#undef PG8_WAIT_V
#undef PG8_WAIT_L
#undef PG8_BAR
#undef PG8_SCHED
}
}
namespace pg8 {
constexpr float LOG2E = 1.4426950408889634f;
__device__ __forceinline__ float sigm(float x) { return __builtin_amdgcn_rcpf(1.f + __expf(-x)); }
__device__ __forceinline__ float gelu_tanh(float x) { const float in = 0.7978845608028654f * (x + 0.044715f * x * x * x); return x * sigm(2.f * in); }
__device__ __forceinline__ u32x4 pack8(const f32x4 a, const f32x4 b) { u32x4 w; w.x = cvt_pk_bf16(a[0], a[1]); w.y = cvt_pk_bf16(a[2], a[3]); w.z = cvt_pk_bf16(b[0], b[1]); w.w = cvt_pk_bf16(b[2], b[3]); return w; }
__device__ __forceinline__ void unpack8(const u32x4 w, f32x4& a, f32x4& b) { a = (f32x4){bf_lo(w.x), bf_hi(w.x), bf_lo(w.y), bf_hi(w.y)}; b = (f32x4){bf_lo(w.z), bf_hi(w.z), bf_lo(w.w), bf_hi(w.w)}; }

struct EpiProj {
    static constexpr bool PERM = true, MIDK = false;
    bf16_t *UEXT, *ZS, *Q, *Kb, *V, *ZA; unsigned char *GS, *GA; const float *qg, *kg;
    __device__ __forceinline__ static void gate8(const f32x4 (&acc)[2][2][4][2], unsigned char* dst, const int colt, const int row0, const int wc, const int fq) {
        const int col0 = colt + wc * 32 + 8 * fq;
#pragma unroll
        for (int ai = 0; ai < 2; ++ai)
#pragma unroll
            for (int m = 0; m < 4; ++m) { unsigned char* rowp = dst + (size_t)(row0 + ai * HALF + m * 16) * 2048 + col0;
#pragma unroll
                for (int bj = 0; bj < 2; ++bj) { u32x2 w = {0u, 0u};
#pragma unroll
                    for (int e = 0; e < 4; ++e) { w.x = __builtin_amdgcn_cvt_pk_u8_f32(fmaxf(sigm(acc[ai][bj][m][0][e]) * 255.f, 1.f), e, w.x);
                                                  w.y = __builtin_amdgcn_cvt_pk_u8_f32(fmaxf(sigm(acc[ai][bj][m][1][e]) * 255.f, 1.f), e, w.y); }
                    *(u32x2*)(rowp + bj * HALF) = w; } }
    }
    template <int KIND  > __device__ __forceinline__ static void plain(const f32x4 (&acc)[2][2][4][2], bf16_t* dst, const int ld, const int colt, const int row0, const int wc, const int fq) {
        const int col0 = colt + wc * 32 + 8 * fq;
#pragma unroll
        for (int ai = 0; ai < 2; ++ai)
#pragma unroll
            for (int m = 0; m < 4; ++m) { bf16_t* rowp = dst + (size_t)(row0 + ai * HALF + m * 16) * ld + col0;
#pragma unroll
                for (int bj = 0; bj < 2; ++bj) { f32x4 v0 = acc[ai][bj][m][0], v1 = acc[ai][bj][m][1];
                    if (KIND != 0) {
#pragma unroll
                        for (int e = 0; e < 4; ++e) { const float s0 = sigm(v0[e]), s1 = sigm(v1[e]); v0[e] = KIND == 1 ? v0[e] * s0 : s0; v1[e] = KIND == 1 ? v1[e] * s1 : s1; } }
                    *(u32x4*)(rowp + bj * HALF) = pack8(v0, v1); } }
    }
    __device__ __forceinline__ void operator()(const f32x4 (&acc)[2][2][4][2], const Unit& u, int wr, int wc, int fr, int fq) const {
        const int pn = u.pn; int row0 = u.pm * BM + wr * 64 + fr; asm volatile("" : "+v"(row0));
        if (pn >= 8 && pn < 16) {
            const bool isq = pn < 12; const float* gg = isq ? qg : kg; bf16_t* dst = isq ? Q : Kb; const float sc = isq ? 0.125f * LOG2E : 1.f;
            const int head = (pn - (isq ? 8 : 12)) * 4 + wc;
            f32x4 gv[2][2];
#pragma unroll
            for (int bj = 0; bj < 2; ++bj)
#pragma unroll
                for (int n = 0; n < 2; ++n) gv[bj][n] = *(const f32x4*)(gg + 32 * bj + 8 * fq + 4 * n) * sc;
#pragma unroll
            for (int ai = 0; ai < 2; ++ai)
#pragma unroll
                for (int m = 0; m < 4; ++m) {
                    float ss = 0.f;
#pragma unroll
                    for (int bj = 0; bj < 2; ++bj)
#pragma unroll
                        for (int n = 0; n < 2; ++n) { const f32x4 x = acc[ai][bj][m][n]; ss += (x[0] * x[0] + x[1] * x[1]) + (x[2] * x[2] + x[3] * x[3]); }
                    ss += __shfl_xor(ss, 16); ss += __shfl_xor(ss, 32);
                    const float rinv = __builtin_amdgcn_rsqf(ss * (1.f / 64.f) + 1e-6f);
                    bf16_t* rowp = dst + (size_t)(row0 + ai * HALF + m * 16) * 1024 + head * 64 + 8 * fq;
#pragma unroll
                    for (int bj = 0; bj < 2; ++bj) *(u32x4*)(rowp + 32 * bj) = pack8(acc[ai][bj][m][0] * rinv * gv[bj][0], acc[ai][bj][m][1] * rinv * gv[bj][1]);
                }
        } else if (pn < 4) {
#pragma unroll
            for (int ai = 0; ai < 2; ++ai)
#pragma unroll
                for (int m = 0; m < 4; ++m) { const int r = row0 + ai * HALF + m * 16;
#pragma unroll
                    for (int bj = 0; bj < 2; ++bj) { const int c = pn * BM + bj * HALF + wc * 32 + 8 * fq, gidx = c >> 4, h0 = c & 15;
                        *(u32x4*)(UEXT + ((size_t)(gidx * 512 + (r >> 5)) * 768 + (r & 31) * 16 + h0)) = pack8(acc[ai][bj][m][0], acc[ai][bj][m][1]); } }
        } else if (pn < 8) { plain<1>(acc, ZS, 1024, (pn - 4) * BM, row0, wc, fq); }
        else if (pn < 20) { plain<0>(acc, V, 1024, (pn - 16) * BM, row0, wc, fq); }
        else if (pn < 24) { plain<1>(acc, ZA, 1024, (pn - 20) * BM, row0, wc, fq); }
        else if (pn < 32) { gate8(acc, GS, (pn - 24) * BM, row0, wc, fq); }
        else { gate8(acc, GA, (pn - 32) * BM, row0, wc, fq); }
    }
};
struct EpiE {
    static constexpr bool PERM = false, MIDK = false;
    float* E;
    __device__ __forceinline__ void operator()(const f32x4 (&acc)[2][2][4][2], const Unit& u, int wr, int wc, int fr, int fq) const {
        int row0 = u.pm * BM + wr * 64 + fr; asm volatile("" : "+v"(row0)); const int col0 = wc * 32 + 4 * fq;
#pragma unroll
        for (int ai = 0; ai < 2; ++ai)
#pragma unroll
            for (int m = 0; m < 4; ++m) { float* rowp = E + (size_t)(row0 + ai * HALF + m * 16) * 256 + col0;
#pragma unroll
                for (int bj = 0; bj < 2; ++bj)
#pragma unroll
                    for (int n = 0; n < 2; ++n) *(f32x4*)(rowp + bj * HALF + n * 16) = acc[ai][bj][m][n]; }
    }
};
struct EpiY {
    static constexpr bool PERM = true, MIDK = false;
    bf16_t* Y;
    __device__ __forceinline__ void operator()(const f32x4 (&acc)[2][2][4][2], const Unit& u, int wr, int wc, int fr, int fq) const {
        const int gidx = u.pm >> 1; int chunk0 = (u.pm & 1) * BM + wr * 64 + fr; asm volatile("" : "+v"(chunk0));
#pragma unroll
        for (int ai = 0; ai < 2; ++ai)
#pragma unroll
            for (int m = 0; m < 4; ++m) { const int chunk = chunk0 + ai * HALF + m * 16;
#pragma unroll
                for (int bj = 0; bj < 2; ++bj) { const int nc = (u.pn & 1) * BM + bj * HALF + wc * 32 + 8 * fq, i = nc >> 4, h0 = nc & 15;
                    f32x4 v0 = acc[ai][bj][m][0], v1 = acc[ai][bj][m][1];
#pragma unroll
                    for (int e = 0; e < 4; ++e) { v0[e] = gelu_tanh(v0[e]); v1[e] = gelu_tanh(v1[e]); }
                    *(u32x4*)(Y + (size_t)(chunk * 32 + i) * 1024 + gidx * 16 + h0) = pack8(v0, v1); } }
    }
};
struct EpiGlu {
    static constexpr bool PERM = true, MIDK = false;
    const bf16_t *Y, *ZS; const float* bias; bf16_t* ACAT;
    __device__ __forceinline__ void operator()(const f32x4 (&acc)[2][2][4][2], const Unit& u, int wr, int wc, int fr, int fq) const {
        int row0 = u.pm * BM + wr * 64 + fr; asm volatile("" : "+v"(row0)); const int col0 = u.pn * BM + wc * 32 + 8 * fq;
#pragma unroll
        for (int ai = 0; ai < 2; ++ai) {
            u32x4 yw[4][2], zw[4][2];
#pragma unroll
            for (int m = 0; m < 4; ++m) { const size_t r = (size_t)(row0 + ai * HALF + m * 16);
#pragma unroll
                for (int bj = 0; bj < 2; ++bj) { yw[m][bj] = *(const u32x4*)(Y + r * 1024 + col0 + bj * HALF); zw[m][bj] = *(const u32x4*)(ZS + r * 1024 + col0 + bj * HALF); } }
#pragma unroll
            for (int m = 0; m < 4; ++m) { const size_t r = (size_t)(row0 + ai * HALF + m * 16);
#pragma unroll
                for (int bj = 0; bj < 2; ++bj) { const f32x4 b0 = *(const f32x4*)(bias + col0 + bj * HALF), b1 = *(const f32x4*)(bias + col0 + bj * HALF + 4);
                    f32x4 y0, y1, z0, z1; unpack8(yw[m][bj], y0, y1); unpack8(zw[m][bj], z0, z1);
                    f32x4 v0 = acc[ai][bj][m][0] + b0, v1 = acc[ai][bj][m][1] + b1;
#pragma unroll
                    for (int e = 0; e < 4; ++e) { v0[e] = y0[e] * sigm(v0[e]) * z0[e]; v1[e] = y1[e] * sigm(v1[e]) * z1[e]; }
                    *(u32x4*)(ACAT + r * 2048 + col0 + bj * HALF) = pack8(v0, v1); } }
            asm volatile("" ::: "memory"); }
    }
};
struct EpiMerge {
    static constexpr bool PERM = true, MIDK = true;
    const unsigned char *GS, *GA; bf16_t* MB;
    __device__ __forceinline__ static void ub8(const u32x2 w, f32x4& a, f32x4& b) {
        a = (f32x4){(float)(w.x & 0xffu), (float)((w.x >> 8) & 0xffu), (float)((w.x >> 16) & 0xffu), (float)(w.x >> 24)};
        b = (f32x4){(float)(w.y & 0xffu), (float)((w.y >> 8) & 0xffu), (float)((w.y >> 16) & 0xffu), (float)(w.y >> 24)}; }
    __device__ __forceinline__ void mid(f32x4 (&acc)[2][2][4][2], const Unit& u, int wr, int wc, int fr, int fq) const {
        int row0 = u.pm * BM + wr * 64 + fr; asm volatile("" : "+v"(row0)); const int col0 = u.pn * BM + wc * 32 + 8 * fq;
#pragma unroll
        for (int ai = 0; ai < 2; ++ai) {
            u32x2 sw[4][2], aw[4][2];
#pragma unroll
            for (int m = 0; m < 4; ++m) { const size_t r = (size_t)(row0 + ai * HALF + m * 16);
#pragma unroll
                for (int bj = 0; bj < 2; ++bj) { sw[m][bj] = *(const u32x2*)(GS + r * 2048 + col0 + bj * HALF); aw[m][bj] = *(const u32x2*)(GA + r * 2048 + col0 + bj * HALF); } }
#pragma unroll
            for (int m = 0; m < 4; ++m)
#pragma unroll
                for (int bj = 0; bj < 2; ++bj) { f32x4 s0, s1, a0, a1; ub8(sw[m][bj], s0, s1); ub8(aw[m][bj], a0, a1);
#pragma unroll
                    for (int e = 0; e < 4; ++e) { acc[ai][bj][m][0][e] *= s0[e] * __builtin_amdgcn_rcpf(a0[e]); acc[ai][bj][m][1][e] *= s1[e] * __builtin_amdgcn_rcpf(a1[e]); } }
            asm volatile("" ::: "memory"); }
    }
    __device__ __forceinline__ void operator()(const f32x4 (&acc)[2][2][4][2], const Unit& u, int wr, int wc, int fr, int fq) const {
        int row0 = u.pm * BM + wr * 64 + fr; asm volatile("" : "+v"(row0)); const int col0 = u.pn * BM + wc * 32 + 8 * fq;
        u32x2 aw[2][4][2];
#pragma unroll
        for (int ai = 0; ai < 2; ++ai)
#pragma unroll
            for (int m = 0; m < 4; ++m) { const size_t r = (size_t)(row0 + ai * HALF + m * 16);
#pragma unroll
                for (int bj = 0; bj < 2; ++bj) aw[ai][m][bj] = *(const u32x2*)(GA + r * 2048 + col0 + bj * HALF); }
#pragma unroll
        for (int ai = 0; ai < 2; ++ai)
#pragma unroll
            for (int m = 0; m < 4; ++m) { const size_t r = (size_t)(row0 + ai * HALF + m * 16);
#pragma unroll
                for (int bj = 0; bj < 2; ++bj) { f32x4 a0, a1; ub8(aw[ai][m][bj], a0, a1);
                    *(u32x4*)(MB + r * 2048 + col0 + bj * HALF) = pack8(acc[ai][bj][m][0] * a0 * (1.f / 255.f), acc[ai][bj][m][1] * a1 * (1.f / 255.f)); } }
    }
};
struct EpiOut {
    static constexpr bool PERM = false, MIDK = false;
    const float* X; float* O;
    __device__ __forceinline__ void operator()(const f32x4 (&acc)[2][2][4][2], const Unit& u, int wr, int wc, int fr, int fq) const {
        int row0 = u.pm * BM + wr * 64 + fr; asm volatile("" : "+v"(row0)); const int col0 = u.pn * BM + wc * 32 + 4 * fq;
#pragma unroll
        for (int ai = 0; ai < 2; ++ai) {
            f32x4 xv[4][2][2];
#pragma unroll
            for (int m = 0; m < 4; ++m) { const size_t off = (size_t)(row0 + ai * HALF + m * 16) * 2048 + col0;
#pragma unroll
                for (int bj = 0; bj < 2; ++bj)
#pragma unroll
                    for (int n = 0; n < 2; ++n) xv[m][bj][n] = *(const f32x4*)(X + off + bj * HALF + n * 16); }
#pragma unroll
            for (int m = 0; m < 4; ++m) { const size_t off = (size_t)(row0 + ai * HALF + m * 16) * 2048 + col0;
#pragma unroll
                for (int bj = 0; bj < 2; ++bj)
#pragma unroll
                    for (int n = 0; n < 2; ++n) *(f32x4*)(O + off + bj * HALF + n * 16) = xv[m][bj][n] + acc[ai][bj][m][n]; }
            asm volatile("" ::: "memory"); }
    }
};
}
namespace nat {
typedef unsigned short bf16_t;
typedef short bf16x8 __attribute__((ext_vector_type(8)));
typedef short s16x4 __attribute__((ext_vector_type(4)));
typedef float f32x4 __attribute__((ext_vector_type(4)));
typedef unsigned u32x4 __attribute__((ext_vector_type(4)));
typedef unsigned u32x2 __attribute__((ext_vector_type(2)));
#define NAT_LAS __attribute__((address_space(3)))
constexpr int SLOTB = 8192, KIMG = 0, VIMG = 9 * SLOTB, BIAS_OFF = 18 * SLOTB;
__device__ __forceinline__ s16x4 vtr(unsigned addr) { return __builtin_bit_cast(s16x4, __builtin_amdgcn_ds_read_tr16_b64_v4i16((NAT_LAS s16x4*)addr)); }
__device__ __forceinline__ void glds16(const void* gsrc, unsigned lds_dst) { unsigned keep;
    asm volatile("s_mov_b32 %0, m0\n\ts_mov_b32 m0, %2\n\ts_nop 0\n\tglobal_load_lds_dwordx4 %1, off\n\ts_mov_b32 m0, %0" : "=&s"(keep) : "v"(gsrc), "s"(lds_dst) : "memory"); }
#define NAT_BAR() asm volatile("s_barrier" ::: "memory")
#define NAT_WAITV_BAR(N) asm volatile("s_waitcnt vmcnt(" #N ")\n\ts_barrier" ::: "memory")
__device__ __forceinline__ int clampi(int v, int lo, int hi) { return v < lo ? lo : (v > hi ? hi : v); }

__device__ __forceinline__ void attn_phase(NAT_LAS unsigned char* lds, const bf16_t* Q, const bf16_t* K, const bf16_t* V, const bf16_t* ZA, bf16_t* ACAT,
                                           const float* rel_bias, int rps  , int vcu, int G, const int tid) {
    const int lane = tid & 63, wid = __builtin_amdgcn_readfirstlane(tid >> 6), fr = lane & 15, fq = lane >> 4;
    const int rsel = wid >> 2, qb = wid & 3;
    const int c0 = 16 * qb, w0 = (qb == 0) ? 0 : (qb == 1) ? 8 : (qb == 2) ? 24 : 32;
    NAT_LAS float* biasL = (NAT_LAS float*)(lds + BIAS_OFF);
    const unsigned ldsbase = (unsigned)(size_t)lds;
    const int dcol = lane >> 3, dpos = lane & 7;
    int koff[2][2];
#pragma unroll
    for (int hf = 0; hf < 2; ++hf)
#pragma unroll
        for (int ks = 0; ks < 2; ++ks) { const int col = w0 + 16 * hf + fr; koff[hf][ks] = col * 128 + 16 * ((ks * 4 + fq) ^ ((col >> 1) & 7)); }
    const int vcol = w0 + 4 * fq + (fr >> 2), vx = (vcol >> 1) & 3, vlane = vcol * 128 + 16 * ((fr & 3) >> 1) + 8 * (fr & 1);
    bool selhi[4]; int dcs[4]; unsigned mlo[2], mhi[2];
    { const int cq = c0 + fr; int cs = cq - 8; cs = cs < 0 ? 0 : (cs > 48 ? 48 : cs);
#pragma unroll
      for (int j = 0; j < 4; ++j) { const int clo = w0 + 4 * fq + j; selhi[j] = clo < cs; const int ck = selhi[j] ? clo + 16 : clo; int dc = ck - cq + 15; dc = dc < 0 ? 0 : (dc > 30 ? 30 : dc); dcs[j] = dc; }
#pragma unroll
      for (int q = 0; q < 2; ++q) { mlo[q] = (selhi[2 * q] ? 0u : 0xffffu) | (selhi[2 * q + 1] ? 0u : 0xffff0000u); mhi[q] = ~mlo[q]; } }
    for (int bt = vcu; bt < 256; bt += G) {
        const int h = bt >> 4, rp0 = (bt & 15) * 8;
        const int seq = (2 * rp0) / rps, rl0 = 2 * rp0 - seq * rps, srow = seq * rps;
        const bf16_t* Kh = K + (size_t)srow * 64 * 1024 + h * 64; const bf16_t* Vh = V + (size_t)srow * 64 * 1024 + h * 64;
        {
            const int kr0 = clampi(rl0 - 4, 0, rps - 8), hi = clampi(rl0 - 3, 0, rps - 8) + 8, nr = hi - kr0;
            for (int j = wid; j < nr * 16; j += 8) { const int row = kr0 + (j >> 4), isv = (j >> 3) & 1, c8 = j & 7, col = c8 * 8 + dcol, slot = row % 9;
                const int gch = isv ? (dpos ^ (((col >> 1) & 3) << 1)) : (dpos ^ ((col >> 1) & 7));
                const bf16_t* src = (isv ? Vh : Kh) + (size_t)(row * 64 + col) * 1024 + gch * 8;
                glds16(src, (unsigned)__builtin_amdgcn_readfirstlane((int)(ldsbase + (isv ? VIMG : KIMG) + slot * SLOTB + c8 * 1024))); }
            if (tid < 465) biasL[tid] = rel_bias[h * 465 + tid] * 1.4426950408889634f;
        }
        bf16x8 qn[2];
        { const int qtok = (srow + rl0 + rsel) * 64 + c0 + fr;
#pragma unroll
          for (int ks = 0; ks < 2; ++ks) qn[ks] = *(const bf16x8*)(Q + (size_t)qtok * 1024 + h * 64 + ks * 32 + fq * 8); }
        asm volatile("" :: "v"(qn[0]), "v"(qn[1]));
        asm volatile("s_waitcnt vmcnt(0) lgkmcnt(0)\n\ts_barrier" ::: "memory");
#pragma nounroll
        for (int i = 0; i < 8; ++i) {
            const int rl = rl0 + 2 * i;
            const int kr0 = clampi(rl - 4, 0, rps - 8), kr1 = clampi(rl - 3, 0, rps - 8), hi = kr1 + 8;
            const int hin = clampi(rl - 1, 0, rps - 8) + 8;
            const int r = rl + rsel, krow0 = rsel ? kr1 : kr0;
            const int qtok = (srow + r) * 64 + c0 + fr;
            bf16x8 qf[2]; qf[0] = qn[0]; qf[1] = qn[1];
            u32x2 zw[4];
            { const bf16_t* zp = ZA + (size_t)qtok * 1024 + h * 64 + 4 * fq;
#pragma unroll
              for (int nt = 0; nt < 4; ++nt) zw[nt] = *(const u32x2*)(zp + 16 * nt);
              const int qtn = i < 7 ? qtok + 128 : qtok;
#pragma unroll
              for (int ks = 0; ks < 2; ++ks) qn[ks] = *(const bf16x8*)(Q + (size_t)qtn * 1024 + h * 64 + ks * 32 + fq * 8); }
            f32x4 acc[16];
            { int slot = krow0 % 9;
#pragma unroll
              for (int n2 = 0; n2 < 8; ++n2) { const NAT_LAS unsigned char* kp = lds + KIMG + slot * SLOTB;
#pragma unroll
                  for (int hf = 0; hf < 2; ++hf) { const int n = 2 * n2 + hf;
                      const bf16x8 k0 = *(const NAT_LAS bf16x8*)(kp + koff[hf][0]), k1 = *(const NAT_LAS bf16x8*)(kp + koff[hf][1]);
                      acc[n] = __builtin_amdgcn_mfma_f32_16x16x32_bf16(k0, qf[0], (f32x4){0.f, 0.f, 0.f, 0.f}, 0, 0, 0);
                      acc[n] = __builtin_amdgcn_mfma_f32_16x16x32_bf16(k1, qf[1], acc[n], 0, 0, 0); }
                  slot = slot == 8 ? 0 : slot + 1; } }
            asm volatile("s_waitcnt lgkmcnt(0)\n\ts_barrier" ::: "memory");
            if (i < 7) { int row = hi + rsel; row = row > hin - 1 ? hin - 1 : row; const int slot = row % 9;
#pragma unroll
                for (int e = 0; e < 2; ++e) { const int c8 = qb * 2 + e, col = c8 * 8 + dcol, gch = dpos ^ ((col >> 1) & 7);
                    glds16(Kh + (size_t)(row * 64 + col) * 1024 + gch * 8, (unsigned)__builtin_amdgcn_readfirstlane((int)(ldsbase + KIMG + slot * SLOTB + c8 * 1024))); } }
            float sc[8][4];
            { float bvv[8][4];
#pragma unroll
              for (int n2 = 0; n2 < 8; ++n2) { const NAT_LAS float* brow = biasL + (krow0 + n2 - r + 7) * 31;
#pragma unroll
                  for (int j = 0; j < 4; ++j) bvv[n2][j] = brow[dcs[j]]; }
              asm volatile("s_waitcnt lgkmcnt(0)" ::: "memory");
#pragma unroll
              for (int n2 = 0; n2 < 8; ++n2)
#pragma unroll
                  for (int j = 0; j < 4; ++j) sc[n2][j] = (selhi[j] ? acc[2 * n2 + 1][j] : acc[2 * n2][j]) + bvv[n2][j]; }
            float mx = sc[0][0];
#pragma unroll
            for (int n2 = 0; n2 < 8; ++n2)
#pragma unroll
                for (int j = 0; j < 4; ++j) mx = fmaxf(mx, sc[n2][j]);
            mx = fmaxf(mx, __shfl_xor(mx, 16)); mx = fmaxf(mx, __shfl_xor(mx, 32));
            float l0 = 0.f, l1 = 0.f;
#pragma unroll
            for (int n2 = 0; n2 < 8; ++n2) {
#pragma unroll
                for (int j = 0; j < 4; ++j) sc[n2][j] = __builtin_amdgcn_exp2f(sc[n2][j] - mx);
                l0 += sc[n2][0] + sc[n2][1]; l1 += sc[n2][2] + sc[n2][3]; }
            float l = l0 + l1;
            l += __shfl_xor(l, 16); l += __shfl_xor(l, 32);
            const float linv = __builtin_amdgcn_rcpf(l);
            bf16x8 pf[8];
#pragma unroll
            for (int s8 = 0; s8 < 8; ++s8) { const unsigned w0p = pg8::cvt_pk_bf16(sc[s8][0], sc[s8][1]), w1p = pg8::cvt_pk_bf16(sc[s8][2], sc[s8][3]);
                u32x4 w; w.x = w0p & mlo[0]; w.y = w1p & mlo[1]; w.z = w0p & mhi[0]; w.w = w1p & mhi[1]; pf[s8] = __builtin_bit_cast(bf16x8, w); }
            asm volatile("s_waitcnt vmcnt(2) lgkmcnt(0)\n\ts_barrier" ::: "memory");
            f32x4 o[4];
#pragma unroll
            for (int nt = 0; nt < 4; ++nt) o[nt] = (f32x4){0.f, 0.f, 0.f, 0.f};
            { int slot = krow0 % 9;
#pragma unroll
              for (int s8 = 0; s8 < 8; ++s8) { const unsigned vb = ldsbase + VIMG + slot * SLOTB + vlane;
#pragma unroll
                  for (int nt = 0; nt < 4; ++nt) {
                      const s16x4 lo = vtr(vb + (unsigned)(32 * (nt ^ vx)));
                      const s16x4 hi2 = vtr(vb + (unsigned)(2048 + 32 * (nt ^ vx)));
                      const bf16x8 vf = (bf16x8){lo[0], lo[1], lo[2], lo[3], hi2[0], hi2[1], hi2[2], hi2[3]};
                      o[nt] = __builtin_amdgcn_mfma_f32_16x16x32_bf16(vf, pf[s8], o[nt], 0, 0, 0); }
                  slot = slot == 8 ? 0 : slot + 1; } }
            asm volatile("" :: "v"(zw[0]), "v"(zw[1]), "v"(zw[2]), "v"(zw[3]), "v"(qn[0]), "v"(qn[1]));
            asm volatile("s_waitcnt vmcnt(0) lgkmcnt(0)\n\ts_barrier" ::: "memory");
            if (i < 7) { int row = hi + rsel; row = row > hin - 1 ? hin - 1 : row; const int slot = row % 9;
#pragma unroll
                for (int e = 0; e < 2; ++e) { const int c8 = qb * 2 + e, col = c8 * 8 + dcol, gch = dpos ^ (((col >> 1) & 3) << 1);
                    glds16(Vh + (size_t)(row * 64 + col) * 1024 + gch * 8, (unsigned)__builtin_amdgcn_readfirstlane((int)(ldsbase + VIMG + slot * SLOTB + c8 * 1024))); } }
            { bf16_t* op = ACAT + (size_t)qtok * 2048 + 1024 + h * 64 + 4 * fq;
#pragma unroll
              for (int nt = 0; nt < 4; ++nt) { u32x2 w; w.x = pg8::cvt_pk_bf16(o[nt][0] * linv * pg8::bf_lo(zw[nt].x), o[nt][1] * linv * pg8::bf_hi(zw[nt].x));
                  w.y = pg8::cvt_pk_bf16(o[nt][2] * linv * pg8::bf_lo(zw[nt].y), o[nt][3] * linv * pg8::bf_hi(zw[nt].y));
                  *(u32x2*)(op + 16 * nt) = w; } }
        }
        asm volatile("s_waitcnt vmcnt(0) lgkmcnt(0)\n\ts_barrier" ::: "memory");
    }
}
}
namespace misc {
typedef unsigned short bf16_t;
typedef float f32x4 __attribute__((ext_vector_type(4)));
typedef float f32x2 __attribute__((ext_vector_type(2)));
typedef unsigned u32x4 __attribute__((ext_vector_type(4)));
typedef unsigned u32x2 __attribute__((ext_vector_type(2)));
#define MISC_LAS __attribute__((address_space(3)))
#define LDS_WAIT() asm volatile("s_waitcnt lgkmcnt(0)" ::: "memory")
__device__ __forceinline__ unsigned f2bf(float f) { unsigned u = __builtin_bit_cast(unsigned, f); return (u + 0x7fffu + ((u >> 16) & 1u)) >> 16; }
__device__ __forceinline__ unsigned pk2(float lo, float hi) { return f2bf(lo) | (f2bf(hi) << 16); }
__device__ __forceinline__ float wave_sum(float v) {
#pragma unroll
    for (int o = 1; o < 64; o <<= 1) v += __shfl_xor(v, o);
    return v;
}
__device__ __forceinline__ void transpose_item(const float* W, int N, bf16_t* WT, int ldt, int koff, int drow, MISC_LAS float* scr, int k0, int n0, int lane) {
    float v[32];
#pragma unroll
    for (int i = 0; i < 32; ++i) { const int kk = 2 * i + (lane >> 5); v[i] = W[(size_t)(k0 + kk) * N + n0 + (lane & 31)]; }
#pragma unroll
    for (int i = 0; i < 32; ++i) { const int kk = 2 * i + (lane >> 5); scr[kk * 33 + (lane & 31)] = v[i]; }
    LDS_WAIT(); asm volatile("" ::: "memory");
    const int c = lane & 7;
#pragma unroll
    for (int j = 0; j < 4; ++j) { const int n = (lane >> 3) + 8 * j; const MISC_LAS float* s = scr + (8 * c) * 33 + n;
        u32x4 o; o.x = pk2(s[0 * 33], s[1 * 33]); o.y = pk2(s[2 * 33], s[3 * 33]); o.z = pk2(s[4 * 33], s[5 * 33]); o.w = pk2(s[6 * 33], s[7 * 33]);
        *(u32x4*)(WT + (size_t)(drow + n) * ldt + koff + k0 + 8 * c) = o; }
    LDS_WAIT(); asm volatile("" ::: "memory");
}
__device__ __forceinline__ void rms_row(const float* xrow, const float* gam, bf16_t* orow, int lane) {
    const f32x4* xr = (const f32x4*)xrow + lane; const f32x4* gr = (const f32x4*)gam + lane;
    f32x4 v[8]; float s = 0.f;
#pragma unroll
    for (int j = 0; j < 8; ++j) { v[j] = xr[64 * j]; s += (v[j].x * v[j].x + v[j].y * v[j].y) + (v[j].z * v[j].z + v[j].w * v[j].w); }
    const float rs = __builtin_amdgcn_rsqf(wave_sum(s) * (1.f / 2048.f) + 1e-6f);
    u32x2* o8 = (u32x2*)orow + lane;
#pragma unroll
    for (int j = 0; j < 8; ++j) { const f32x4 gg = gr[64 * j]; u32x2 w; w.x = pk2(v[j].x * rs * gg.x, v[j].y * rs * gg.y); w.y = pk2(v[j].z * rs * gg.z, v[j].w * rs * gg.w); o8[64 * j] = w; }
}
__device__ __forceinline__ float exp_small(float x) {
    float t = 1.f, s = 1.f;
#pragma nounroll
    for (int k = 1; k <= 11; ++k) { t *= x * __builtin_amdgcn_rcpf((float)k); s += t; }
    return s;
}
__device__ __forceinline__ float exp_f(float x) {
    float r = exp_small(x * 0.0625f);
    r *= r; r *= r; r *= r; r *= r; return r;
}
__device__ __forceinline__ void sincos_f(float a, float& s, float& c) {
    const float k = __builtin_rintf(a * 0.15915494309189535f);
    float r = __builtin_fmaf(-k, 6.28318548202514648f, a); r = __builtin_fmaf(-k, -1.7484556000744883e-07f, r); r *= 0.25f;
    const float r2 = r * r; float ts = r, tc = 1.f, ss = r, cc = 1.f;
#pragma nounroll
    for (int i = 1; i <= 7; ++i) { const float e = (float)(2 * i); tc *= -r2 * __builtin_amdgcn_rcpf((e - 1.f) * e); ts *= -r2 * __builtin_amdgcn_rcpf(e * (e + 1.f)); cc += tc; ss += ts; }
#pragma nounroll
    for (int i = 0; i < 2; ++i) { const float c2 = cc * cc - ss * ss, s2 = 2.f * ss * cc; cc = c2; ss = s2; }
    s = ss; c = cc;
}
constexpr int SM_POW = 0;
constexpr int SM_FC = SM_POW + 2 * 33 * 65 * 2;
constexpr int SM_BRE = SM_FC + 256;
constexpr int SM_BIM = SM_BRE + 2048;
constexpr int SM_CC = SM_BIM + 2048;
constexpr int SM_TB = SM_CC + 2 * 16 * 65 * 2;
constexpr int TBS = 264;
constexpr int SM_END = SM_TB + 63 * TBS / 2;
static_assert(SM_END * 4 <= 140 * 1024, "SSM builder LDS");

__device__ __forceinline__ void ssm_build(MISC_LAS float* L, int g, const float* a_re, const float* a_im, const float* log_dt, const float* b_re, const float* b_im,
                                          const float* c_re, const float* c_im, const float* dsk, bf16_t* SSMY, bf16_t* SSME, float* AT, int tid, const int stop_at = 9) {
    MISC_LAS f32x2* POW = (MISC_LAS f32x2*)(L + SM_POW); MISC_LAS f32x2* FC = (MISC_LAS f32x2*)(L + SM_FC);
    MISC_LAS float* BRE = L + SM_BRE; MISC_LAS float* BIM = L + SM_BIM; MISC_LAS f32x2* CC = (MISC_LAS f32x2*)(L + SM_CC); MISC_LAS bf16_t* TB = (MISC_LAS bf16_t*)(L + SM_TB);
    if (tid < 128) { const int d = tid >> 6, p = tid & 63;
        float lre = a_re[(d * 64 + g) * 64 + p]; lre = lre < -1e-4f ? lre : -1e-4f; const float lim = a_im[(d * 64 + g) * 64 + p];
        const float dt = exp_f(log_dt[d * 64 + g]);
        const float mag = exp_f(lre * dt); float sn, cs; sincos_f(lim * dt, sn, cs);
        const float zr = mag * cs, zi = mag * sn, rden = 1.f / (lre * lre + lim * lim);
        FC[d * 64 + p] = (f32x2){((zr - 1.f) * lre + zi * lim) * rden, (zi * lre - (zr - 1.f) * lim) * rden};
        float pr = 1.f, pi = 0.f;
#pragma nounroll
        for (int j = 0; j <= 32; ++j) { POW[(d * 33 + j) * 65 + p] = (f32x2){pr, pi}; const float nr = pr * zr - pi * zi, ni = pr * zi + pi * zr; pr = nr; pi = ni; }
        const f32x2 a32 = POW[(d * 33 + 32) * 65 + p]; *(f32x2*)(AT + ((g * 2 + d) * 64 + p) * 2) = a32;
    }
    __syncthreads();
    if (stop_at == 1) return;
    for (int idx = tid; idx < 2048; idx += 512) {
        { const int d = idx >> 10, p = (idx >> 4) & 63, h = idx & 15; const size_t gi = ((size_t)(d * 64 + g) * 64 + p) * 16 + h; const float br = b_re[gi], bi = b_im[gi]; const f32x2 f = FC[d * 64 + p];
          BRE[idx] = f.x * br - f.y * bi; BIM[idx] = f.x * bi + f.y * br; }
        { const int d = idx >> 10, hp = (idx >> 6) & 15, p = idx & 63; const size_t gi = ((size_t)(d * 64 + g) * 16 + hp) * 64 + p; CC[(d * 16 + hp) * 65 + p] = (f32x2){c_re[gi], c_im[gi]}; }
    }
    __syncthreads();
    { const int j = (tid >> 4) & 31, hp = tid & 15; float a[2][16];
#pragma unroll
      for (int d = 0; d < 2; ++d) {
#pragma unroll
        for (int h = 0; h < 16; ++h) a[d][h] = 0.f;
        for (int p = 0; p < 64; ++p) { const f32x2 c = CC[(d * 16 + hp) * 65 + p], w = POW[(d * 33 + j) * 65 + p]; const float cpr = c.x * w.x - c.y * w.y, cpi = c.x * w.y + c.y * w.x;
            const MISC_LAS f32x4* br = (const MISC_LAS f32x4*)(BRE + (d * 64 + p) * 16); const MISC_LAS f32x4* bi = (const MISC_LAS f32x4*)(BIM + (d * 64 + p) * 16);
#pragma unroll
            for (int q = 0; q < 4; ++q) { const f32x4 r4 = br[q], i4 = bi[q];
#pragma unroll
                for (int e = 0; e < 4; ++e) a[d][4 * q + e] += cpr * r4[e] - cpi * i4[e]; } } }
      if (j == 0) { const float dd = dsk[g * 16 + hp];
#pragma unroll
          for (int h = 0; h < 16; h += 2) *(MISC_LAS unsigned*)(TB + 31 * TBS + hp * 16 + h) = pk2(a[0][h] + a[1][h] + (h == hp ? dd : 0.f), a[0][h + 1] + a[1][h + 1] + (h + 1 == hp ? dd : 0.f));
      } else {
#pragma unroll
          for (int h = 0; h < 16; h += 2) { *(MISC_LAS unsigned*)(TB + (31 + j) * TBS + hp * 16 + h) = pk2(a[0][h], a[0][h + 1]); *(MISC_LAS unsigned*)(TB + (31 - j) * TBS + hp * 16 + h) = pk2(a[1][h], a[1][h + 1]); } }
    }
    __syncthreads();
    if (stop_at == 2) return;
    bf16_t* Yg = SSMY + (size_t)g * 512 * 768;
    for (int idx = tid; idx < 512 * 96; idx += 512) { const int n = idx / 96, kc = idx - n * 96, i = n >> 4, hp = n & 15; float v[8];
        if (kc < 64) { const int j = kc >> 1, h0 = (kc & 1) * 8;
            *(u32x4*)(Yg + (size_t)n * 768 + kc * 8) = *(const MISC_LAS u32x4*)(TB + (31 + i - j) * TBS + hp * 16 + h0); continue;
        } else { const int kk = (kc - 64) * 8, d = kk >> 7, ri = (kk >> 6) & 1, p0 = kk & 63, jj = d == 0 ? i + 1 : 32 - i;
#pragma unroll
            for (int e = 0; e < 8; ++e) { const f32x2 c = CC[(d * 16 + hp) * 65 + p0 + e], w = POW[(d * 33 + jj) * 65 + p0 + e]; v[e] = ri ? -(c.x * w.y + c.y * w.x) : (c.x * w.x - c.y * w.y); } }
        u32x4 o; o.x = pk2(v[0], v[1]); o.y = pk2(v[2], v[3]); o.z = pk2(v[4], v[5]); o.w = pk2(v[6], v[7]);
        *(u32x4*)(Yg + (size_t)n * 768 + kc * 8) = o; }
    bf16_t* Eg = SSME + (size_t)g * 256 * 512;
    for (int idx = tid; idx < 256 * 64; idx += 512) { const int n = idx >> 6, kc = idx & 63, d = n >> 7, ri = (n >> 6) & 1, p = n & 63, j = kc >> 1, h0 = (kc & 1) * 8, jj = d == 0 ? 31 - j : j;
        const f32x2 w = POW[(d * 33 + jj) * 65 + p]; float v[8];
#pragma unroll
        for (int e = 0; e < 8; ++e) { const float br = BRE[(d * 64 + p) * 16 + h0 + e], bi = BIM[(d * 64 + p) * 16 + h0 + e]; v[e] = ri ? (w.x * bi + w.y * br) : (w.x * br - w.y * bi); }
        u32x4 o; o.x = pk2(v[0], v[1]); o.y = pk2(v[2], v[3]); o.z = pk2(v[4], v[5]); o.w = pk2(v[6], v[7]);
        *(u32x4*)(Eg + (size_t)n * 512 + kc * 8) = o; }
    __syncthreads();
}
__device__ __forceinline__ void rec_one(const float* __restrict__ E, bf16_t* __restrict__ UEXT, const float* __restrict__ AT, int seq, int g, int d, int nc, int lane) {
    const f32x2 at = *(const f32x2*)(AT + ((g * 2 + d) * 64 + lane) * 2);
    float sr = 0.f, si = 0.f;
    const int cb = seq * nc;
#pragma unroll 8
    for (int q = 0; q < nc; ++q) { const int c = cb + (d == 0 ? q : nc - 1 - q);
        const float er = E[((size_t)(g * 512 + c)) * 256 + d * 128 + lane], ei = E[((size_t)(g * 512 + c)) * 256 + d * 128 + 64 + lane];
        bf16_t* up = UEXT + ((size_t)(g * 512 + c)) * 768 + 512 + d * 128 + lane;
        up[0] = (bf16_t)f2bf(sr); up[64] = (bf16_t)f2bf(si);
        const float nr = at.x * sr - at.y * si + er, ni = at.x * si + at.y * sr + ei; sr = nr; si = ni; }
}
__device__ __forceinline__ void rec_phase(const float* __restrict__ E, bf16_t* __restrict__ UEXT, const float* __restrict__ AT, int nseq, int nc, int gw, int NGW, int lane) {
    for (int task = gw; task < nseq * 128; task += NGW) rec_one(E, UEXT, AT, task >> 7, (task >> 1) & 63, task & 1, nc, lane);
}
}
#define XB_TMO      128
#define XB_XCNT(j)  (256  + 64 * (j))
#define XB_XSUB(j)  (1280 + 64 * (j))
#define XB_XGEN(j)  (2304 + 64 * (j))
#define XB_TOP      3328
#define XB_TOPGEN   3392
#define XCD_BAR_WORDS 3456
#define XB_SPIN_CAP (1u << 18)
#define XB_LAS __attribute__((address_space(3)))
__device__ __forceinline__ unsigned xb_ld(unsigned* p)              { return __hip_atomic_load(p, __ATOMIC_RELAXED, __HIP_MEMORY_SCOPE_AGENT); }
__device__ __forceinline__ unsigned xb_add(unsigned* p, unsigned v) { return __hip_atomic_fetch_add(p, v, __ATOMIC_RELAXED, __HIP_MEMORY_SCOPE_AGENT); }
__device__ __forceinline__ unsigned xb_xcc_id() { return (unsigned)__builtin_amdgcn_s_getreg((3 << 11) | 20) & 0xFu; }
#define XB_SPIN(cond, bar) do { unsigned _sp = 0; while (cond) { __builtin_amdgcn_s_sleep(1); \
    if ((++_sp & 255u) == 0u) { if (xb_ld(&(bar)[XB_TMO])) break; if (_sp > XB_SPIN_CAP) { atomicAdd(&(bar)[XB_TMO], 1u); break; } } } } while (0)
struct XcdBarrier { unsigned* bar; unsigned x; volatile XB_LAS unsigned* st; };
__device__ __forceinline__ XcdBarrier xcd_barrier_post(unsigned* bar, volatile XB_LAS unsigned* st) {
    XcdBarrier b; b.bar = bar; b.x = xb_xcc_id(); b.st = st;
    if (threadIdx.x == 0) (void)xb_add(&bar[XB_XCNT(b.x)], 1u);
    return b;
}
__device__ __forceinline__ void xcd_barrier_complete(unsigned* bar, unsigned x, unsigned& nloc, unsigned& nx) {
    const unsigned G = gridDim.x * gridDim.y * gridDim.z;
    unsigned sum, cnt, mine, sp = 0u;
    for (;;) {
        sum = 0u; cnt = 0u; mine = 0u;
#pragma unroll
        for (unsigned j = 0; j < 16; ++j) { const unsigned c = xb_ld(&bar[XB_XCNT(j)]); sum += c; cnt += (c > 0u) ? 1u : 0u; mine = (j == x) ? c : mine; }
        if (sum == G) break;
        __builtin_amdgcn_s_sleep(1);
        if ((++sp & 255u) == 0u) { if (xb_ld(&bar[XB_TMO])) break; if (sp > XB_SPIN_CAP) { atomicAdd(&bar[XB_TMO], 1u); break; } }
    }
    nloc = mine > 0u ? mine : 1u; nx = cnt > 0u ? cnt : 1u;
}
__device__ __forceinline__ void xcd_barrier(const XcdBarrier& b) {
    asm volatile("s_waitcnt vmcnt(0)" ::: "memory");
    __syncthreads();
    if (threadIdx.x == 0) {
        unsigned* bar = b.bar;
        __builtin_amdgcn_s_waitcnt(0);
        unsigned nloc = b.st[0], nx = b.st[1];
        if (nloc == 0u) { xcd_barrier_complete(bar, b.x, nloc, nx); b.st[0] = nloc; b.st[1] = nx; }
        const unsigned old = xb_add(&bar[XB_XSUB(b.x)], 1u);
        const unsigned gen = old / nloc;
        if (old + 1u == (gen + 1u) * nloc) {
            __builtin_amdgcn_fence(__ATOMIC_RELEASE, "agent");
            asm volatile("s_waitcnt vmcnt(0)" ::: "memory");
            const unsigned og = xb_add(&bar[XB_TOP], 1u);
            const unsigned tg = og / nx;
            if (og + 1u == (tg + 1u) * nx) xb_add(&bar[XB_TOPGEN], 1u);
            else XB_SPIN(xb_ld(&bar[XB_TOPGEN]) == tg, bar);
            __builtin_amdgcn_fence(__ATOMIC_ACQUIRE, "agent");
            xb_add(&bar[XB_XGEN(b.x)], 1u);
            asm volatile("s_waitcnt vmcnt(0)" ::: "memory");
        } else {
            XB_SPIN(xb_ld(&bar[XB_XGEN(b.x)]) == gen, bar);
            __builtin_amdgcn_fence(__ATOMIC_ACQUIRE, "agent");
            asm volatile("s_waitcnt vmcnt(0)" ::: "memory");
        }
    }
    __syncthreads();
}
#ifndef PH_MASK
#define PH_MASK 0xff
#endif
#define HAS(k) (((PH_MASK) >> (k)) & 1)
#ifndef SYNC_REPS
#define SYNC_REPS 1
#endif
#ifndef DUP_SKIP_SSM
#define DUP_SKIP_SSM 0
#endif
#ifndef G1_WGM
#define G1_WGM 8
#endif
#ifndef G1_ALIGN
#define G1_ALIGN true
#endif
#ifndef G1_SP2
#define G1_SP2 true
#endif
#ifndef DUP_MASK
#define DUP_MASK 0
#endif
#ifndef MK_MULTI
#define MK_MULTI 0
#endif
typedef unsigned short bf16;
constexpr size_t MiB = 1u << 20;
constexpr int MP = 16384;
constexpr size_t WS_WIN = 0, WS_WGLU = 40 * MiB, WS_WMRG = 42 * MiB, WS_WOUT = 50 * MiB, WS_SSMY = 58 * MiB, WS_SSME = 106 * MiB, WS_AT = 122 * MiB,
                 WS_H = 123 * MiB  , WS_UEXT = 187 * MiB  , WS_ZS = 235 * MiB, WS_Q = 267 * MiB, WS_K = 299 * MiB, WS_V = 331 * MiB,
                 WS_ZA = 363 * MiB, WS_Y = 395 * MiB, WS_E = 427 * MiB, WS_END = 459 * MiB;
constexpr int LDS_BYTES = 147456 + 2048 + 256;
constexpr size_t WS_BAR = WS_END, WS_BAR_BYTES = 16384;
constexpr int N_PHASES = 15;
extern "C" __device__ void __ockl_grid_sync(void);

constexpr int I_IN = 32 * 320, I_GLU = 16 * 32, I_BS = 16 * 64, I_OUT = 32 * 64, NITEMS = I_IN + I_GLU + 2 * I_BS + I_OUT;
__device__ __forceinline__ void weight_item(int r, const float* w_in, const float* w_glu, const float* w_bs, const float* w_ba, const float* w_out,
                                            unsigned short* WIN, unsigned short* WGLU, unsigned short* WMRG, unsigned short* WOUT, MISC_LAS float* scr, int lane) {
    if (r < I_IN) { const int kb = r / 320, nb = r % 320, n0 = nb * 32; int drow = n0;
        if (n0 >= 2048 && n0 < 4096) drow = (n0 & ~255) + 128 * ((n0 >> 5) & 1) + 32 * ((n0 >> 6) & 3);
        misc::transpose_item(w_in, 10240, WIN, 2048, 0, drow, scr, kb * 64, n0, lane); return; } r -= I_IN;
    if (r < I_GLU) { misc::transpose_item(w_glu, 1024, WGLU, 1024, 0, (r % 32) * 32, scr, (r / 32) * 64, (r % 32) * 32, lane); return; } r -= I_GLU;
    if (r < I_BS) { misc::transpose_item(w_bs, 2048, WMRG, 2048, 0, (r % 64) * 32, scr, (r / 64) * 64, (r % 64) * 32, lane); return; } r -= I_BS;
    if (r < I_BS) { misc::transpose_item(w_ba, 2048, WMRG, 2048, 1024, (r % 64) * 32, scr, (r / 64) * 64, (r % 64) * 32, lane); return; } r -= I_BS;
    misc::transpose_item(w_out, 2048, WOUT, 2048, 0, (r % 64) * 32, scr, (r / 64) * 64, (r % 64) * 32, lane);
}

struct Args { const float* in[20]; float* out; unsigned char* ws; int ph_lo, ph_hi; };

__global__ void __launch_bounds__(512, 2) hybrid_fwd(Args args) {
    extern __shared__ __attribute__((aligned(16))) unsigned char lds_raw[];
    PG8_LAS unsigned char* lds = (PG8_LAS unsigned char*)lds_raw;
#if !MK_MULTI
    { volatile XB_LAS unsigned* st0 = (volatile XB_LAS unsigned*)((PG8_LAS unsigned char*)lds_raw + (LDS_BYTES - 64)); if (threadIdx.x < 2) st0[threadIdx.x] = 0u; }
    __syncthreads();
    XcdBarrier xbar; xbar.bar = (unsigned*)(args.ws + WS_BAR); xbar.x = xb_xcc_id(); xbar.st = (volatile XB_LAS unsigned*)((PG8_LAS unsigned char*)lds_raw + (LDS_BYTES - 64));
    if (args.ph_lo == 0 && blockIdx.x == 0) { for (int w = threadIdx.x; w < XCD_BAR_WORDS; w += 512) xbar.bar[w] = 0u; }
#endif
    const int G = gridDim.x, bx = blockIdx.x, vcu = (G % 8 == 0) ? (bx % 8) * (G / 8) + bx / 8 : bx;
    bool rep = false, posted = false;
#pragma nounroll
    for (int ph = args.ph_lo; ph < args.ph_hi; ) {
    if (!MK_MULTI && G == 256 && ph != 0 && ((ph - 1) % 7) == 2) { ++ph; continue; }
    int tid = threadIdx.x; asm volatile("" : "+v"(tid));
    size_t zoff = 0; asm volatile("" : "+s"(zoff));
    unsigned char* ws = args.ws + zoff; float* outb = args.out + zoff;
    const int lane = tid & 63, wave = __builtin_amdgcn_readfirstlane(tid >> 6);
    bf16* WIN = (bf16*)(ws + WS_WIN); bf16* WGLU = (bf16*)(ws + WS_WGLU); bf16* WMRG = (bf16*)(ws + WS_WMRG); bf16* WOUT = (bf16*)(ws + WS_WOUT);
    bf16* SSMY = (bf16*)(ws + WS_SSMY); bf16* SSME = (bf16*)(ws + WS_SSME); float* AT = (float*)(ws + WS_AT);
    bf16* HB = (bf16*)(ws + WS_H); bf16* ACAT = HB; bf16* UEXT = (bf16*)(ws + WS_UEXT); bf16* MBUF = UEXT; bf16* ZS = (bf16*)(ws + WS_ZS);
    bf16* QB = (bf16*)(ws + WS_Q); bf16* KB = (bf16*)(ws + WS_K); bf16* VB = (bf16*)(ws + WS_V); bf16* ZA = (bf16*)(ws + WS_ZA); bf16* YB = (bf16*)(ws + WS_Y);
    float* EB = (float*)(ws + WS_E);
        if (ph == 0) { if (HAS(0)) {
            const int nssm = G > 64 ? 64 : 0;
            if (bx < nssm) {
                for (int g = bx; g < 64 && !(DUP_SKIP_SSM == 1 && rep); g += nssm)
                    misc::ssm_build((MISC_LAS float*)lds, g, args.in[4], args.in[5], args.in[6], args.in[7], args.in[8], args.in[9], args.in[10], args.in[11], SSMY, SSME, AT, tid, (DUP_SKIP_SSM > 1 && rep) ? DUP_SKIP_SSM - 1 : 9);
            } else {
                MISC_LAS float* scr = (MISC_LAS float*)(lds + wave * 16384);
                const int gw = (bx - nssm) * 8 + wave, NGW = (G - nssm) * 8;
                const int nearly = (G == 256) ? I_IN : NITEMS;
                for (int it = gw; it < nearly; it += NGW) weight_item(it, args.in[3], args.in[12], args.in[17], args.in[18], args.in[19], WIN, WGLU, WMRG, WOUT, scr, lane);
                for (int m = gw; m < MP; m += NGW) misc::rms_row(args.in[0] + (size_t)m * 2048, args.in[2], HB + (size_t)m * 2048, lane);
                { bf16* HB1 = (bf16*)((unsigned char*)outb + 192 * MiB);
                  for (int m = gw; m < MP; m += NGW) misc::rms_row(args.in[1] + (size_t)m * 2048, args.in[2], HB1 + (size_t)m * 2048, lane); }
            }
            }
            __syncthreads();
        } else {
            const int p = (ph - 1) / 7, s = (ph - 1) % 7;
            const float* xp = args.in[p]; float* outp = outb + (size_t)p * MP * 2048;
            unsigned char* GS = (unsigned char*)outp; unsigned char* GA = GS + (size_t)MP * 2048;
            if (s == 0) { if (HAS(1)) {
                pg8::Gemm g{p == 0 ? HB : (bf16*)((unsigned char*)outb + 192 * MiB), WIN, 2048, 2048, 2048}; pg8::StaticOrder S; S.init(MP, 10240, G, bx, G1_WGM);
                pg8::EpiProj E{UEXT, ZS, QB, KB, VB, ZA, GS, GA, args.in[14], args.in[15]};
                pg8::gemm_phase<pg8::EpiProj, pg8::StaticOrder, G1_ALIGN, G1_SP2>(lds, g, S, E, tid);
            } } else if (s == 1) { if (HAS(2)) {
                nat::attn_phase(lds, QB, KB, VB, ZA, ACAT, args.in[16], p == 0 ? 32 : 128, vcu, G, tid);
                pg8::Gemm g{UEXT, SSME, 768, 512, 512}; pg8::GroupOrder S; S.init(64, 2, 1, G, bx);
                pg8::EpiE E{EB};
                pg8::gemm_phase<pg8::EpiE, pg8::GroupOrder, true, true>(lds, g, S, E, tid);
                if (G == 256 && bx >= 128 && p == 0) {
                    MISC_LAS float* scr = (MISC_LAS float*)(lds + wave * 16384);
                    for (int it = I_IN + (bx - 128) * 8 + wave; it < NITEMS; it += 1024) weight_item(it, args.in[3], args.in[12], args.in[17], args.in[18], args.in[19], WIN, WGLU, WMRG, WOUT, scr, lane);
                }
                if (G == 256 && bx < 128) {
                    asm volatile("s_waitcnt vmcnt(0)" ::: "memory"); __syncthreads();
                    const int nc = p == 0 ? 64 : 256, nloc = 256 / nc;
                    if (wave < 2 * nloc) misc::rec_one(EB, UEXT, AT, (bx & 1) * nloc + (wave >> 1), bx >> 1, wave & 1, nc, lane);
                }
            } } else if (s == 2) { if (HAS(3)) {
                misc::rec_phase(EB, UEXT, AT, p == 0 ? 8 : 2, p == 0 ? 64 : 256, vcu * 8 + wave, G * 8, lane);
            } } else if (s == 3) { if (HAS(4)) {
                pg8::Gemm g{UEXT, SSMY, 768, 768, 768}; pg8::GroupOrder S; S.init(64, 2, 2, G, bx);
                pg8::EpiY E{YB};
                pg8::gemm_phase<pg8::EpiY, pg8::GroupOrder, true, true>(lds, g, S, E, tid);
            } } else if (s == 4) { if (HAS(5)) {
                pg8::Gemm g{YB, WGLU, 1024, 1024, 1024}; pg8::StaticOrder S; S.init(MP, 1024, G, bx);
                pg8::EpiGlu E{YB, ZS, args.in[13], ACAT};
                pg8::gemm_phase<pg8::EpiGlu, pg8::StaticOrder, true, true>(lds, g, S, E, tid);
            } } else if (s == 5) { if (HAS(6)) {
                pg8::Gemm g{ACAT, WMRG, 2048, 2048, 2048}; pg8::StaticOrder S; S.init(MP, 2048, G, bx);
                pg8::EpiMerge E{GS, GA, MBUF};
                pg8::gemm_phase<pg8::EpiMerge, pg8::StaticOrder, true, true>(lds, g, S, E, tid);
            } } else { if (HAS(7)) {
                pg8::Gemm g{MBUF, WOUT, 2048, 2048, 2048}; pg8::StaticOrder S; S.init(MP, 2048, G, bx);
                pg8::EpiOut E{xp, outp};
                pg8::gemm_phase<pg8::EpiOut, pg8::StaticOrder, true, true>(lds, g, S, E, tid);
            } }
            __syncthreads();
        }
        { const int kbit = ph == 0 ? 0 : ((ph - 1) % 7) + 1; const bool again = ((DUP_MASK >> kbit) & 1) && !rep;
          if (again) rep = true; else { rep = false; ++ph; }
#if !MK_MULTI
          if (ph < args.ph_hi) { if (!posted) { __ockl_grid_sync(); if (threadIdx.x == 0) (void)xb_add(&xbar.bar[XB_XCNT(xbar.x)], 1u); posted = true; } else xcd_barrier(xbar); }
#endif
        }
    }
}

#ifdef STOP_PH
__global__ void dump_k(const unsigned short* src, float* out, size_t n) {
    for (size_t i = (size_t)blockIdx.x * blockDim.x + threadIdx.x; i < n; i += (size_t)gridDim.x * blockDim.x) { float acc = 0.f;
        for (int w = 0; w < 4; ++w) { unsigned v = src[(size_t)w * n + i]; if ((v & 0x7f80u) == 0x7f80u) v = 0; acc += __uint_as_float(v << 16); }
        out[i] = acc; }
}
#endif
extern "C" void kernel_launch(void* const* d_in, const int* in_sizes, int n_in, void* d_out, int out_size, void* d_ws, size_t ws_size, hipStream_t stream) {
    static int grid = 0;
    if (grid == 0) {
        if (n_in != 20 || in_sizes[0] != MP * 2048 || in_sizes[1] != MP * 2048 || out_size != 2 * MP * 2048 || ws_size < WS_END + WS_BAR_BYTES) {
            fprintf(stderr, "kernel_launch: unexpected shapes / workspace (n_in %d, ws %zu)\n", n_in, ws_size); grid = -1; return; }
        int dev = 0, cus = 0, per_cu = 0;
        if (hipGetDevice(&dev) != hipSuccess || hipDeviceGetAttribute(&cus, hipDeviceAttributeMultiprocessorCount, dev) != hipSuccess) { grid = -1; return; }
        if (hipFuncSetAttribute((const void*)hybrid_fwd, hipFuncAttributeMaxDynamicSharedMemorySize, LDS_BYTES) != hipSuccess) { fprintf(stderr, "kernel_launch: hipFuncSetAttribute failed\n"); grid = -1; return; }
        if (hipOccupancyMaxActiveBlocksPerMultiprocessor(&per_cu, (const void*)hybrid_fwd, 512, LDS_BYTES) != hipSuccess || per_cu < 1) per_cu = 1;
        (void)hipGetLastError();
        grid = cus * per_cu;
        fprintf(stderr, "kernel_launch: grid %d (cus %d x %d), ws %zu\n", grid, cus, per_cu, ws_size);
    }
    if (grid < 0) return;
#ifdef MK_MEMSET
#if MK_MEMSET == 1
    (void)hipMemsetAsync(d_ws, 0xAA, WS_END, stream);
    (void)hipMemsetAsync(d_out, 0xAA, (size_t)out_size * 4, stream);
#elif MK_MEMSET == 2
    (void)hipMemsetAsync((char*)d_ws + WS_END, 0xAA, 64, stream);
#elif MK_MEMSET == 3
    (void)hipMemsetAsync(d_ws, 0xAA, WS_END, stream);
#elif MK_MEMSET == 4
    (void)hipMemsetAsync(d_out, 0xAA, (size_t)out_size * 4, stream);
#endif
#endif
    Args a{};
    for (int i = 0; i < 20; ++i) a.in[i] = (const float*)d_in[i];
    a.out = (float*)d_out; a.ws = (unsigned char*)d_ws;
#if MK_MULTI
#ifdef STOP_PH
    for (int ph = 0; ph <= STOP_PH; ++ph) { a.ph_lo = ph; a.ph_hi = ph + 1; hipLaunchKernelGGL(hybrid_fwd, dim3(grid), dim3(512), LDS_BYTES, stream, a); }
    hipLaunchKernelGGL(dump_k, dim3(2048), dim3(256), 0, stream, (const unsigned short*)d_ws, (float*)d_out, (size_t)out_size);
#else
    for (int ph = 0; ph < N_PHASES; ++ph) { a.ph_lo = ph; a.ph_hi = ph + 1; hipLaunchKernelGGL(hybrid_fwd, dim3(grid), dim3(512), LDS_BYTES, stream, a); }
#endif
#else
    a.ph_lo = 0; a.ph_hi = N_PHASES;
    void* kargs[] = {&a};
    const hipError_t e = hipLaunchCooperativeKernel((const void*)hybrid_fwd, dim3(grid), dim3(512), kargs, LDS_BYTES, stream);
    if (e != hipSuccess) fprintf(stderr, "kernel_launch: cooperative launch failed: %s (grid %d)\n", hipGetErrorString(e), grid);
#endif
}
```

```cpp
#define MK_MULTI 0
#include <hip/hip_runtime.h>
#include <cstdio>
#include <cstdint>
#include <cmath>
namespace pg8 {
#define PG8_LAS __attribute__((address_space(3)))
typedef unsigned short bf16_t;
typedef short bf16x8 __attribute__((ext_vector_type(8)));
typedef float f32x4 __attribute__((ext_vector_type(4)));
typedef float f32x2 __attribute__((ext_vector_type(2)));
typedef unsigned u32x4 __attribute__((ext_vector_type(4)));
typedef unsigned u32x2 __attribute__((ext_vector_type(2)));
constexpr int BM = 256, BK = 64, HALF = 128, HTB = HALF * BK * 2  , STAGE_BYTES = 8 * HTB, NXCD = 8, WGM = 8;

__host__ __device__ __forceinline__ int lds_byte(int r, int c) { const int st = (r >> 4) * 2 + (c >> 5), rr = r & 15, cc = c & 31, ob = rr * 64 + cc * 2; return st * 1024 + (ob ^ (((ob >> 9) & 1) << 5)); }
__host__ __device__ __forceinline__ void stage_rc(int b, int& R, int& C) { const int st = b / 1024, sb = b % 1024, swz = sb ^ (((sb >> 9) & 1) << 5); R = (st >> 1) * 16 + swz / 64; C = (st & 1) * 32 + (swz % 64) / 2; }
__host__ __device__ __forceinline__ int perm32(int rho) { const int n = rho >> 4, i = rho & 15; return 8 * (i >> 2) + 4 * n + (i & 3); }

struct Unit { int pm, pn; };
struct Gemm { const bf16_t* A; const bf16_t* Bt; int lda, ldb, K; };

struct StaticOrder {
    int nM, nN, nwg, G, c, wgm;
    __host__ __device__ void init(int M, int N, int G_, int c_, int wgm_ = WGM) { nM = M / BM; nN = N / BM; nwg = nM * nN; G = G_; c = c_; wgm = wgm_; }
    __host__ __device__ bool next(int i, Unit& u) const {
        const long L = (long)i * G + c; if (L >= nwg) return false;
        int wgid = (int)L; { const int q = nwg / NXCD, r = nwg % NXCD, xcd = wgid % NXCD, off = wgid / NXCD; wgid = (xcd < r ? xcd * (q + 1) : r * (q + 1) + (xcd - r) * q) + off; }
        const int nig = wgm * nN, gid = wgid / nig, fm = gid * wgm, gsz = (nM - fm) < wgm ? (nM - fm) : wgm;
        u.pm = fm + ((wgid % nig) % gsz); u.pn = (wgid % nig) / gsz; return true;
    }
};
struct RangeOrder {
    StaticOrder S; int i0, n;
    __host__ __device__ bool next(int i, Unit& u) const { if (i >= n) return false; return S.next(i0 + i, u); }
};
struct GroupOrder {
    int rt, ct, total, G, c;
    __host__ __device__ void init(int nG, int rt_, int ct_, int G_, int c_) { rt = rt_; ct = ct_; total = nG * rt_ * ct_; G = G_; c = c_; }
    __host__ __device__ bool next(int i, Unit& u) const {
        const int L = i * G + c; if (L >= total) return false;
        const int per = rt * ct, g = L / per, r = L % per; u.pm = g * rt + r % rt; u.pn = g * ct + r / rt; return true;
    }
};

typedef __bf16 bf16x2_t __attribute__((ext_vector_type(2)));
__device__ __forceinline__ unsigned cvt_pk_bf16(float lo, float hi) { const f32x2 v = {lo, hi}; const bf16x2_t b = __builtin_convertvector(v, bf16x2_t); return __builtin_bit_cast(unsigned, b); }
__device__ __forceinline__ float bf_lo(unsigned w) { return __uint_as_float(w << 16); }
__device__ __forceinline__ float bf_hi(unsigned w) { return __uint_as_float(w & 0xffff0000u); }

template <class Epi, class Sched, bool ALIGN_EPI = false, bool SP2 = false>
__device__ __forceinline__ void gemm_phase(PG8_LAS unsigned char* lds, const Gemm g, const Sched& S, const Epi& E, const int tid) {
    const int wid = __builtin_amdgcn_readfirstlane(tid >> 6), lane = tid & 63, wr = wid >> 2, wc = wid & 3, fr = lane & 15, fq = lane >> 4;
    const int K = g.K, nt = K / BK;
    unsigned voffA[2], voffB[2];
#pragma unroll
    for (int i = 0; i < 2; ++i) { int R, C; stage_rc(tid * 16 + i * 8192, R, C); const int Rb = Epi::PERM ? ((R & ~31) + perm32(R & 31)) : R;
        voffA[i] = (unsigned)(R * g.lda + C) * 2u; voffB[i] = (unsigned)(Rb * g.ldb + C) * 2u; }
    const size_t kstep = (size_t)(BK * 2);
    const size_t hstepA = (size_t)HALF * g.lda * 2, hstepB = (size_t)HALF * g.ldb * 2;
    const size_t tstepA = 2 * hstepA, tstepB = 2 * hstepB;
    const unsigned ldsw = (unsigned)wid * 1024u;
    const int aoff = lds_byte(wr * 64 + fr, fq * 8), boff = lds_byte(wc * 32 + fr, fq * 8);
#define PG8_SA(b, h) (((b) * 2 + (h)) * HTB)
#define PG8_SB(b, h) ((4 + (b) * 2 + (h)) * HTB)
#define PG8_STAGE(bufoff, gbase, voff) do { _Pragma("unroll") for (int _i = 0; _i < 2; ++_i) \
        __builtin_amdgcn_global_load_lds((const unsigned*)((const char*)(gbase) + (voff)[_i]), (PG8_LAS unsigned*)(lds + (bufoff) + ldsw + _i * 8192), 16, 0, 0); } while (0)
#define PG8_LDA(dst, b, h) do { _Pragma("unroll") for (int m = 0; m < 4; ++m) _Pragma("unroll") for (int k = 0; k < 2; ++k) dst[m][k] = *(const PG8_LAS bf16x8*)(lds + PG8_SA(b, h) + aoff + m * 2048 + k * 1024); } while (0)
#define PG8_LDB(dst, b, h) do { _Pragma("unroll") for (int n = 0; n < 2; ++n) _Pragma("unroll") for (int k = 0; k < 2; ++k) dst[n][k] = *(const PG8_LAS bf16x8*)(lds + PG8_SB(b, h) + boff + n * 2048 + k * 1024); } while (0)
#define PG8_MMA(ai, bj, At, Bt) do { __builtin_amdgcn_s_setprio(1); _Pragma("unroll") for (int m = 0; m < 4; ++m) _Pragma("unroll") for (int n = 0; n < 2; ++n) _Pragma("unroll") for (int k = 0; k < 2; ++k) \
        acc[ai][bj][m][n] = __builtin_amdgcn_mfma_f32_16x16x32_bf16(Bt[n][k], At[m][k], acc[ai][bj][m][n], 0, 0, 0); __builtin_amdgcn_s_setprio(0); } while (0)
#define PG8_WAIT_V(n) asm volatile("s_waitcnt vmcnt(" #n ")" ::: "memory")
#define PG8_WAIT_L(n) asm volatile("s_waitcnt lgkmcnt(" #n ")" ::: "memory")
#define PG8_BAR __builtin_amdgcn_s_barrier()
#define PG8_SCHED __builtin_amdgcn_sched_barrier(0)
    Unit cur, nxt; int ui = 0;
    if (!S.next(0, cur)) return;
    f32x4 acc[2][2][4][2];
#pragma unroll
    for (int a = 0; a < 2; ++a)
#pragma unroll
        for (int b = 0; b < 2; ++b)
#pragma unroll
            for (int m = 0; m < 4; ++m)
#pragma unroll
                for (int n = 0; n < 2; ++n) acc[a][b][m][n] = (f32x4){0.f, 0.f, 0.f, 0.f};
    bf16x8 At[4][2], B0[2][2], B1[2][2];
    const char* cA = (const char*)g.A + (size_t)cur.pm * tstepA; const char* cB = (const char*)g.Bt + (size_t)cur.pn * tstepB;
    if constexpr (SP2) {
        PG8_STAGE(PG8_SB(0, 0), cB, voffB); PG8_STAGE(PG8_SB(0, 1), cB + hstepB, voffB); PG8_STAGE(PG8_SA(0, 0), cA, voffA); PG8_STAGE(PG8_SA(0, 1), cA + hstepA, voffA);
        if (wr == 1) PG8_BAR;
        PG8_WAIT_V(2); PG8_BAR;
        PG8_STAGE(PG8_SB(1, 0), cB + kstep, voffB); PG8_STAGE(PG8_SA(1, 0), cA + kstep, voffA); PG8_STAGE(PG8_SB(1, 1), cB + hstepB + kstep, voffB);
        PG8_WAIT_V(6); PG8_BAR;
    } else {
        PG8_STAGE(PG8_SB(0, 0), cB, voffB); PG8_STAGE(PG8_SA(0, 0), cA, voffA); PG8_STAGE(PG8_SB(0, 1), cB + hstepB, voffB); PG8_STAGE(PG8_SA(0, 1), cA + hstepA, voffA);
        if (wr == 1) PG8_BAR;
        PG8_WAIT_V(4); PG8_BAR;
        PG8_STAGE(PG8_SB(1, 0), cB + kstep, voffB); PG8_STAGE(PG8_SA(1, 0), cA + kstep, voffA); PG8_STAGE(PG8_SB(1, 1), cB + hstepB + kstep, voffB);
        PG8_WAIT_V(6); PG8_BAR;
    }
    for (;;) {
        const bool has_next = S.next(ui + 1, nxt);
        const char* nA = has_next ? (const char*)g.A + (size_t)nxt.pm * tstepA : cA; const char* nB = has_next ? (const char*)g.Bt + (size_t)nxt.pn * tstepB : cB;
        for (int t = 0; t < nt; t += 2) {
            const bool last = (t == nt - 2);
            const char* a1 = cA + (size_t)(t + 1) * kstep;
            const char* a2 = last ? nA : cA + (size_t)(t + 2) * kstep; const char* b2 = last ? nB : cB + (size_t)(t + 2) * kstep;
            const char* a3 = a2 + kstep; const char* b3 = b2 + kstep;
            if constexpr (Epi::MIDK) { if (t == (nt >> 1)) E.mid(acc, cur, wr, wc, fr, fq); }
            if constexpr (SP2) {
            PG8_LDB(B0, 0, 0); PG8_LDB(B1, 0, 1); PG8_SCHED; PG8_LDA(At, 0, 0); PG8_STAGE(PG8_SA(1, 1), a1 + hstepA, voffA);
            PG8_WAIT_V(8); PG8_WAIT_L(0); PG8_BAR; PG8_MMA(0, 0, At, B0); PG8_MMA(0, 1, At, B1); PG8_BAR; PG8_SCHED;
            PG8_LDA(At, 0, 1); PG8_STAGE(PG8_SB(0, 0), b2, voffB); PG8_STAGE(PG8_SB(0, 1), b2 + hstepB, voffB); PG8_STAGE(PG8_SA(0, 0), a2, voffA);
            PG8_WAIT_V(8); PG8_WAIT_L(0); PG8_BAR; PG8_MMA(1, 0, At, B0); PG8_MMA(1, 1, At, B1); PG8_BAR; PG8_SCHED;
            PG8_LDB(B0, 1, 0); PG8_LDB(B1, 1, 1); PG8_SCHED; PG8_LDA(At, 1, 0); PG8_STAGE(PG8_SA(0, 1), a2 + hstepA, voffA);
            PG8_WAIT_V(8); PG8_WAIT_L(0); PG8_BAR; PG8_MMA(0, 0, At, B0); PG8_MMA(0, 1, At, B1); PG8_BAR; PG8_SCHED;
            PG8_LDA(At, 1, 1); PG8_STAGE(PG8_SB(1, 0), b3, voffB); PG8_STAGE(PG8_SB(1, 1), b3 + hstepB, voffB); PG8_STAGE(PG8_SA(1, 0), a3, voffA);
            PG8_WAIT_V(8); PG8_WAIT_L(0); PG8_BAR; PG8_MMA(1, 0, At, B0); PG8_MMA(1, 1, At, B1); PG8_BAR; PG8_SCHED;
            } else {
            PG8_LDB(B0, 0, 0); PG8_SCHED; PG8_LDA(At, 0, 0); PG8_STAGE(PG8_SA(1, 1), a1 + hstepA, voffA);
            PG8_WAIT_L(8); PG8_BAR; PG8_WAIT_L(0); PG8_MMA(0, 0, At, B0); PG8_BAR; PG8_SCHED;
            PG8_LDB(B1, 0, 1); PG8_STAGE(PG8_SB(0, 0), b2, voffB);
            PG8_BAR; PG8_WAIT_L(0); PG8_MMA(0, 1, At, B1); PG8_BAR;
            PG8_LDA(At, 0, 1); PG8_STAGE(PG8_SA(0, 0), a2, voffA);
            PG8_BAR; PG8_WAIT_L(0); PG8_MMA(1, 0, At, B0); PG8_BAR; PG8_SCHED;
            PG8_STAGE(PG8_SB(0, 1), b2 + hstepB, voffB);
            PG8_WAIT_V(6); PG8_BAR; PG8_MMA(1, 1, At, B1); PG8_BAR;
            PG8_LDB(B0, 1, 0); PG8_SCHED; PG8_LDA(At, 1, 0); PG8_STAGE(PG8_SA(0, 1), a2 + hstepA, voffA);
            PG8_WAIT_L(8); PG8_BAR; PG8_WAIT_L(0); PG8_MMA(0, 0, At, B0); PG8_BAR; PG8_SCHED;
            PG8_LDB(B1, 1, 1); PG8_STAGE(PG8_SB(1, 0), b3, voffB);
            PG8_BAR; PG8_WAIT_L(0); PG8_MMA(0, 1, At, B1); PG8_BAR;
            PG8_LDA(At, 1, 1); PG8_STAGE(PG8_SA(1, 0), a3, voffA);
            PG8_BAR; PG8_WAIT_L(0); PG8_MMA(1, 0, At, B0); PG8_BAR; PG8_SCHED;
            PG8_STAGE(PG8_SB(1, 1), b3 + hstepB, voffB);
            PG8_WAIT_V(6); PG8_BAR; PG8_MMA(1, 1, At, B1); PG8_BAR;
            }
        }
        if constexpr (ALIGN_EPI) { if (wr == 0) PG8_BAR; }
        E(acc, cur, wr, wc, fr, fq);
        if (!has_next) break;
#pragma unroll
        for (int a = 0; a < 2; ++a)
#pragma unroll
            for (int b = 0; b < 2; ++b)
#pragma unroll
                for (int m = 0; m < 4; ++m)
#pragma unroll
                    for (int n = 0; n < 2; ++n) acc[a][b][m][n] = (f32x4){0.f, 0.f, 0.f, 0.f};
        cur = nxt; cA = nA; cB = nB; ++ui;
        if constexpr (ALIGN_EPI) { if (wr == 1) PG8_BAR; }
    }
    PG8_WAIT_V(0);
    if constexpr (!ALIGN_EPI) { if (wr == 0) PG8_BAR; }
    PG8_BAR;
#undef PG8_SA
#undef PG8_SB
#undef PG8_STAGE
#undef PG8_LDA
#undef PG8_LDB
#undef PG8_MMA
#undef PG8_WAIT_V
#undef PG8_WAIT_L
#undef PG8_BAR
#undef PG8_SCHED
}
}
namespace pg8 {
constexpr float LOG2E = 1.4426950408889634f;
__device__ __forceinline__ float sigm(float x) { return __builtin_amdgcn_rcpf(1.f + __expf(-x)); }
__device__ __forceinline__ float gelu_tanh(float x) { const float in = 0.7978845608028654f * (x + 0.044715f * x * x * x); return x * sigm(2.f * in); }
__device__ __forceinline__ u32x4 pack8(const f32x4 a, const f32x4 b) { u32x4 w; w.x = cvt_pk_bf16(a[0], a[1]); w.y = cvt_pk_bf16(a[2], a[3]); w.z = cvt_pk_bf16(b[0], b[1]); w.w = cvt_pk_bf16(b[2], b[3]); return w; }
__device__ __forceinline__ void unpack8(const u32x4 w, f32x4& a, f32x4& b) { a = (f32x4){bf_lo(w.x), bf_hi(w.x), bf_lo(w.y), bf_hi(w.y)}; b = (f32x4){bf_lo(w.z), bf_hi(w.z), bf_lo(w.w), bf_hi(w.w)}; }

struct EpiProj {
    static constexpr bool PERM = true, MIDK = false;
    bf16_t *UEXT, *ZS, *Q, *Kb, *V, *ZA; unsigned char *GS, *GA; const float *qg, *kg;
    __device__ __forceinline__ static void gate8(const f32x4 (&acc)[2][2][4][2], unsigned char* dst, const int colt, const int row0, const int wc, const int fq) {
        const int col0 = colt + wc * 32 + 8 * fq;
#pragma unroll
        for (int ai = 0; ai < 2; ++ai)
#pragma unroll
            for (int m = 0; m < 4; ++m) { unsigned char* rowp = dst + (size_t)(row0 + ai * HALF + m * 16) * 2048 + col0;
#pragma unroll
                for (int bj = 0; bj < 2; ++bj) { u32x2 w = {0u, 0u};
#pragma unroll
                    for (int e = 0; e < 4; ++e) { w.x = __builtin_amdgcn_cvt_pk_u8_f32(fmaxf(sigm(acc[ai][bj][m][0][e]) * 255.f, 1.f), e, w.x);
                                                  w.y = __builtin_amdgcn_cvt_pk_u8_f32(fmaxf(sigm(acc[ai][bj][m][1][e]) * 255.f, 1.f), e, w.y); }
                    *(u32x2*)(rowp + bj * HALF) = w; } }
    }
    template <int KIND  > __device__ __forceinline__ static void plain(const f32x4 (&acc)[2][2][4][2], bf16_t* dst, const int ld, const int colt, const int row0, const int wc, const int fq) {
        const int col0 = colt + wc * 32 + 8 * fq;
#pragma unroll
        for (int ai = 0; ai < 2; ++ai)
#pragma unroll
            for (int m = 0; m < 4; ++m) { bf16_t* rowp = dst + (size_t)(row0 + ai * HALF + m * 16) * ld + col0;
#pragma unroll
                for (int bj = 0; bj < 2; ++bj) { f32x4 v0 = acc[ai][bj][m][0], v1 = acc[ai][bj][m][1];
                    if (KIND != 0) {
#pragma unroll
                        for (int e = 0; e < 4; ++e) { const float s0 = sigm(v0[e]), s1 = sigm(v1[e]); v0[e] = KIND == 1 ? v0[e] * s0 : s0; v1[e] = KIND == 1 ? v1[e] * s1 : s1; } }
                    *(u32x4*)(rowp + bj * HALF) = pack8(v0, v1); } }
    }
    __device__ __forceinline__ void operator()(const f32x4 (&acc)[2][2][4][2], const Unit& u, int wr, int wc, int fr, int fq) const {
        const int pn = u.pn; int row0 = u.pm * BM + wr * 64 + fr; asm volatile("" : "+v"(row0));
        if (pn >= 8 && pn < 16) {
            const bool isq = pn < 12; const float* gg = isq ? qg : kg; bf16_t* dst = isq ? Q : Kb; const float sc = isq ? 0.125f * LOG2E : 1.f;
            const int head = (pn - (isq ? 8 : 12)) * 4 + wc;
            f32x4 gv[2][2];
#pragma unroll
            for (int bj = 0; bj < 2; ++bj)
#pragma unroll
                for (int n = 0; n < 2; ++n) gv[bj][n] = *(const f32x4*)(gg + 32 * bj + 8 * fq + 4 * n) * sc;
#pragma unroll
            for (int ai = 0; ai < 2; ++ai)
#pragma unroll
                for (int m = 0; m < 4; ++m) {
                    float ss = 0.f;
#pragma unroll
                    for (int bj = 0; bj < 2; ++bj)
#pragma unroll
                        for (int n = 0; n < 2; ++n) { const f32x4 x = acc[ai][bj][m][n]; ss += (x[0] * x[0] + x[1] * x[1]) + (x[2] * x[2] + x[3] * x[3]); }
                    ss += __shfl_xor(ss, 16); ss += __shfl_xor(ss, 32);
                    const float rinv = __builtin_amdgcn_rsqf(ss * (1.f / 64.f) + 1e-6f);
                    bf16_t* rowp = dst + (size_t)(row0 + ai * HALF + m * 16) * 1024 + head * 64 + 8 * fq;
#pragma unroll
                    for (int bj = 0; bj < 2; ++bj) *(u32x4*)(rowp + 32 * bj) = pack8(acc[ai][bj][m][0] * rinv * gv[bj][0], acc[ai][bj][m][1] * rinv * gv[bj][1]);
                }
        } else if (pn < 4) {
#pragma unroll
            for (int ai = 0; ai < 2; ++ai)
#pragma unroll
                for (int m = 0; m < 4; ++m) { const int r = row0 + ai * HALF + m * 16;
#pragma unroll
                    for (int bj = 0; bj < 2; ++bj) { const int c = pn * BM + bj * HALF + wc * 32 + 8 * fq, gidx = c >> 4, h0 = c & 15;
                        *(u32x4*)(UEXT + ((size_t)(gidx * 512 + (r >> 5)) * 768 + (r & 31) * 16 + h0)) = pack8(acc[ai][bj][m][0], acc[ai][bj][m][1]); } }
        } else if (pn < 8) { plain<1>(acc, ZS, 1024, (pn - 4) * BM, row0, wc, fq); }
        else if (pn < 20) { plain<0>(acc, V, 1024, (pn - 16) * BM, row0, wc, fq); }
        else if (pn < 24) { plain<1>(acc, ZA, 1024, (pn - 20) * BM, row0, wc, fq); }
        else if (pn < 32) { gate8(acc, GS, (pn - 24) * BM, row0, wc, fq); }
        else { gate8(acc, GA, (pn - 32) * BM, row0, wc, fq); }
    }
};
struct EpiE {
    static constexpr bool PERM = false, MIDK = false;
    float* E;
    __device__ __forceinline__ void operator()(const f32x4 (&acc)[2][2][4][2], const Unit& u, int wr, int wc, int fr, int fq) const {
        int row0 = u.pm * BM + wr * 64 + fr; asm volatile("" : "+v"(row0)); const int col0 = wc * 32 + 4 * fq;
#pragma unroll
        for (int ai = 0; ai < 2; ++ai)
#pragma unroll
            for (int m = 0; m < 4; ++m) { float* rowp = E + (size_t)(row0 + ai * HALF + m * 16) * 256 + col0;
#pragma unroll
                for (int bj = 0; bj < 2; ++bj)
#pragma unroll
                    for (int n = 0; n < 2; ++n) *(f32x4*)(rowp + bj * HALF + n * 16) = acc[ai][bj][m][n]; }
    }
};
struct EpiY {
    static constexpr bool PERM = true, MIDK = false;
    bf16_t* Y;
    __device__ __forceinline__ void operator()(const f32x4 (&acc)[2][2][4][2], const Unit& u, int wr, int wc, int fr, int fq) const {
        const int gidx = u.pm >> 1; int chunk0 = (u.pm & 1) * BM + wr * 64 + fr; asm volatile("" : "+v"(chunk0));
#pragma unroll
        for (int ai = 0; ai < 2; ++ai)
#pragma unroll
            for (int m = 0; m < 4; ++m) { const int chunk = chunk0 + ai * HALF + m * 16;
#pragma unroll
                for (int bj = 0; bj < 2; ++bj) { const int nc = (u.pn & 1) * BM + bj * HALF + wc * 32 + 8 * fq, i = nc >> 4, h0 = nc & 15;
                    f32x4 v0 = acc[ai][bj][m][0], v1 = acc[ai][bj][m][1];
#pragma unroll
                    for (int e = 0; e < 4; ++e) { v0[e] = gelu_tanh(v0[e]); v1[e] = gelu_tanh(v1[e]); }
                    *(u32x4*)(Y + (size_t)(chunk * 32 + i) * 1024 + gidx * 16 + h0) = pack8(v0, v1); } }
    }
};
struct EpiGlu {
    static constexpr bool PERM = true, MIDK = false;
    const bf16_t *Y, *ZS; const float* bias; bf16_t* ACAT;
    __device__ __forceinline__ void operator()(const f32x4 (&acc)[2][2][4][2], const Unit& u, int wr, int wc, int fr, int fq) const {
        int row0 = u.pm * BM + wr * 64 + fr; asm volatile("" : "+v"(row0)); const int col0 = u.pn * BM + wc * 32 + 8 * fq;
#pragma unroll
        for (int ai = 0; ai < 2; ++ai) {
            u32x4 yw[4][2], zw[4][2];
#pragma unroll
            for (int m = 0; m < 4; ++m) { const size_t r = (size_t)(row0 + ai * HALF + m * 16);
#pragma unroll
                for (int bj = 0; bj < 2; ++bj) { yw[m][bj] = *(const u32x4*)(Y + r * 1024 + col0 + bj * HALF); zw[m][bj] = *(const u32x4*)(ZS + r * 1024 + col0 + bj * HALF); } }
#pragma unroll
            for (int m = 0; m < 4; ++m) { const size_t r = (size_t)(row0 + ai * HALF + m * 16);
#pragma unroll
                for (int bj = 0; bj < 2; ++bj) { const f32x4 b0 = *(const f32x4*)(bias + col0 + bj * HALF), b1 = *(const f32x4*)(bias + col0 + bj * HALF + 4);
                    f32x4 y0, y1, z0, z1; unpack8(yw[m][bj], y0, y1); unpack8(zw[m][bj], z0, z1);
                    f32x4 v0 = acc[ai][bj][m][0] + b0, v1 = acc[ai][bj][m][1] + b1;
#pragma unroll
                    for (int e = 0; e < 4; ++e) { v0[e] = y0[e] * sigm(v0[e]) * z0[e]; v1[e] = y1[e] * sigm(v1[e]) * z1[e]; }
                    *(u32x4*)(ACAT + r * 2048 + col0 + bj * HALF) = pack8(v0, v1); } }
            asm volatile("" ::: "memory"); }
    }
};
struct EpiMerge {
    static constexpr bool PERM = true, MIDK = true;
    const unsigned char *GS, *GA; bf16_t* MB;
    __device__ __forceinline__ static void ub8(const u32x2 w, f32x4& a, f32x4& b) {
        a = (f32x4){(float)(w.x & 0xffu), (float)((w.x >> 8) & 0xffu), (float)((w.x >> 16) & 0xffu), (float)(w.x >> 24)};
        b = (f32x4){(float)(w.y & 0xffu), (float)((w.y >> 8) & 0xffu), (float)((w.y >> 16) & 0xffu), (float)(w.y >> 24)}; }
    __device__ __forceinline__ void mid(f32x4 (&acc)[2][2][4][2], const Unit& u, int wr, int wc, int fr, int fq) const {
        int row0 = u.pm * BM + wr * 64 + fr; asm volatile("" : "+v"(row0)); const int col0 = u.pn * BM + wc * 32 + 8 * fq;
#pragma unroll
        for (int ai = 0; ai < 2; ++ai) {
            u32x2 sw[4][2], aw[4][2];
#pragma unroll
            for (int m = 0; m < 4; ++m) { const size_t r = (size_t)(row0 + ai * HALF + m * 16);
#pragma unroll
                for (int bj = 0; bj < 2; ++bj) { sw[m][bj] = *(const u32x2*)(GS + r * 2048 + col0 + bj * HALF); aw[m][bj] = *(const u32x2*)(GA + r * 2048 + col0 + bj * HALF); } }
#pragma unroll
            for (int m = 0; m < 4; ++m)
#pragma unroll
                for (int bj = 0; bj < 2; ++bj) { f32x4 s0, s1, a0, a1; ub8(sw[m][bj], s0, s1); ub8(aw[m][bj], a0, a1);
#pragma unroll
                    for (int e = 0; e < 4; ++e) { acc[ai][bj][m][0][e] *= s0[e] * __builtin_amdgcn_rcpf(a0[e]); acc[ai][bj][m][1][e] *= s1[e] * __builtin_amdgcn_rcpf(a1[e]); } }
            asm volatile("" ::: "memory"); }
    }
    __device__ __forceinline__ void operator()(const f32x4 (&acc)[2][2][4][2], const Unit& u, int wr, int wc, int fr, int fq) const {
        int row0 = u.pm * BM + wr * 64 + fr; asm volatile("" : "+v"(row0)); const int col0 = u.pn * BM + wc * 32 + 8 * fq;
        u32x2 aw[2][4][2];
#pragma unroll
        for (int ai = 0; ai < 2; ++ai)
#pragma unroll
            for (int m = 0; m < 4; ++m) { const size_t r = (size_t)(row0 + ai * HALF + m * 16);
#pragma unroll
                for (int bj = 0; bj < 2; ++bj) aw[ai][m][bj] = *(const u32x2*)(GA + r * 2048 + col0 + bj * HALF); }
#pragma unroll
        for (int ai = 0; ai < 2; ++ai)
#pragma unroll
            for (int m = 0; m < 4; ++m) { const size_t r = (size_t)(row0 + ai * HALF + m * 16);
#pragma unroll
                for (int bj = 0; bj < 2; ++bj) { f32x4 a0, a1; ub8(aw[ai][m][bj], a0, a1);
                    *(u32x4*)(MB + r * 2048 + col0 + bj * HALF) = pack8(acc[ai][bj][m][0] * a0 * (1.f / 255.f), acc[ai][bj][m][1] * a1 * (1.f / 255.f)); } }
    }
};
struct EpiOut {
    static constexpr bool PERM = false, MIDK = false;
    const float* X; float* O;
    __device__ __forceinline__ void operator()(const f32x4 (&acc)[2][2][4][2], const Unit& u, int wr, int wc, int fr, int fq) const {
        int row0 = u.pm * BM + wr * 64 + fr; asm volatile("" : "+v"(row0)); const int col0 = u.pn * BM + wc * 32 + 4 * fq;
#pragma unroll
        for (int ai = 0; ai < 2; ++ai) {
            f32x4 xv[4][2][2];
#pragma unroll
            for (int m = 0; m < 4; ++m) { const size_t off = (size_t)(row0 + ai * HALF + m * 16) * 2048 + col0;
#pragma unroll
                for (int bj = 0; bj < 2; ++bj)
#pragma unroll
                    for (int n = 0; n < 2; ++n) xv[m][bj][n] = *(const f32x4*)(X + off + bj * HALF + n * 16); }
#pragma unroll
            for (int m = 0; m < 4; ++m) { const size_t off = (size_t)(row0 + ai * HALF + m * 16) * 2048 + col0;
#pragma unroll
                for (int bj = 0; bj < 2; ++bj)
#pragma unroll
                    for (int n = 0; n < 2; ++n) *(f32x4*)(O + off + bj * HALF + n * 16) = xv[m][bj][n] + acc[ai][bj][m][n]; }
            asm volatile("" ::: "memory"); }
    }
};
}
namespace nat {
typedef unsigned short bf16_t;
typedef short bf16x8 __attribute__((ext_vector_type(8)));
typedef short s16x4 __attribute__((ext_vector_type(4)));
typedef float f32x4 __attribute__((ext_vector_type(4)));
typedef unsigned u32x4 __attribute__((ext_vector_type(4)));
typedef unsigned u32x2 __attribute__((ext_vector_type(2)));
#define NAT_LAS __attribute__((address_space(3)))
constexpr int SLOTB = 8192, KIMG = 0, VIMG = 9 * SLOTB, BIAS_OFF = 18 * SLOTB;
__device__ __forceinline__ s16x4 vtr(unsigned addr) { return __builtin_bit_cast(s16x4, __builtin_amdgcn_ds_read_tr16_b64_v4i16((NAT_LAS s16x4*)addr)); }
__device__ __forceinline__ void glds16(const void* gsrc, unsigned lds_dst) { unsigned keep;
    asm volatile("s_mov_b32 %0, m0\n\ts_mov_b32 m0, %2\n\ts_nop 0\n\tglobal_load_lds_dwordx4 %1, off\n\ts_mov_b32 m0, %0" : "=&s"(keep) : "v"(gsrc), "s"(lds_dst) : "memory"); }
#define NAT_BAR() asm volatile("s_barrier" ::: "memory")
#define NAT_WAITV_BAR(N) asm volatile("s_waitcnt vmcnt(" #N ")\n\ts_barrier" ::: "memory")
__device__ __forceinline__ int clampi(int v, int lo, int hi) { return v < lo ? lo : (v > hi ? hi : v); }

__device__ __forceinline__ void attn_phase(NAT_LAS unsigned char* lds, const bf16_t* Q, const bf16_t* K, const bf16_t* V, const bf16_t* ZA, bf16_t* ACAT,
                                           const float* rel_bias, int rps  , int vcu, int G, const int tid) {
    const int lane = tid & 63, wid = __builtin_amdgcn_readfirstlane(tid >> 6), fr = lane & 15, fq = lane >> 4;
    const int rsel = wid >> 2, qb = wid & 3;
    const int c0 = 16 * qb, w0 = (qb == 0) ? 0 : (qb == 1) ? 8 : (qb == 2) ? 24 : 32;
    NAT_LAS float* biasL = (NAT_LAS float*)(lds + BIAS_OFF);
    const unsigned ldsbase = (unsigned)(size_t)lds;
    const int dcol = lane >> 3, dpos = lane & 7;
    int koff[2][2];
#pragma unroll
    for (int hf = 0; hf < 2; ++hf)
#pragma unroll
        for (int ks = 0; ks < 2; ++ks) { const int col = w0 + 16 * hf + fr; koff[hf][ks] = col * 128 + 16 * ((ks * 4 + fq) ^ ((col >> 1) & 7)); }
    const int vcol = w0 + 4 * fq + (fr >> 2), vx = (vcol >> 1) & 3, vlane = vcol * 128 + 16 * ((fr & 3) >> 1) + 8 * (fr & 1);
    bool selhi[4]; int dcs[4]; unsigned mlo[2], mhi[2];
    { const int cq = c0 + fr; int cs = cq - 8; cs = cs < 0 ? 0 : (cs > 48 ? 48 : cs);
#pragma unroll
      for (int j = 0; j < 4; ++j) { const int clo = w0 + 4 * fq + j; selhi[j] = clo < cs; const int ck = selhi[j] ? clo + 16 : clo; int dc = ck - cq + 15; dc = dc < 0 ? 0 : (dc > 30 ? 30 : dc); dcs[j] = dc; }
#pragma unroll
      for (int q = 0; q < 2; ++q) { mlo[q] = (selhi[2 * q] ? 0u : 0xffffu) | (selhi[2 * q + 1] ? 0u : 0xffff0000u); mhi[q] = ~mlo[q]; } }
    for (int bt = vcu; bt < 256; bt += G) {
        const int h = bt >> 4, rp0 = (bt & 15) * 8;
        const int seq = (2 * rp0) / rps, rl0 = 2 * rp0 - seq * rps, srow = seq * rps;
        const bf16_t* Kh = K + (size_t)srow * 64 * 1024 + h * 64; const bf16_t* Vh = V + (size_t)srow * 64 * 1024 + h * 64;
        {
            const int kr0 = clampi(rl0 - 4, 0, rps - 8), hi = clampi(rl0 - 3, 0, rps - 8) + 8, nr = hi - kr0;
            for (int j = wid; j < nr * 16; j += 8) { const int row = kr0 + (j >> 4), isv = (j >> 3) & 1, c8 = j & 7, col = c8 * 8 + dcol, slot = row % 9;
                const int gch = isv ? (dpos ^ (((col >> 1) & 3) << 1)) : (dpos ^ ((col >> 1) & 7));
                const bf16_t* src = (isv ? Vh : Kh) + (size_t)(row * 64 + col) * 1024 + gch * 8;
                glds16(src, (unsigned)__builtin_amdgcn_readfirstlane((int)(ldsbase + (isv ? VIMG : KIMG) + slot * SLOTB + c8 * 1024))); }
            if (tid < 465) biasL[tid] = rel_bias[h * 465 + tid] * 1.4426950408889634f;
        }
        bf16x8 qn[2];
        { const int qtok = (srow + rl0 + rsel) * 64 + c0 + fr;
#pragma unroll
          for (int ks = 0; ks < 2; ++ks) qn[ks] = *(const bf16x8*)(Q + (size_t)qtok * 1024 + h * 64 + ks * 32 + fq * 8); }
        asm volatile("" :: "v"(qn[0]), "v"(qn[1]));
        asm volatile("s_waitcnt vmcnt(0) lgkmcnt(0)\n\ts_barrier" ::: "memory");
#pragma nounroll
        for (int i = 0; i < 8; ++i) {
            const int rl = rl0 + 2 * i;
            const int kr0 = clampi(rl - 4, 0, rps - 8), kr1 = clampi(rl - 3, 0, rps - 8), hi = kr1 + 8;
            const int hin = clampi(rl - 1, 0, rps - 8) + 8;
            const int r = rl + rsel, krow0 = rsel ? kr1 : kr0;
            const int qtok = (srow + r) * 64 + c0 + fr;
            bf16x8 qf[2]; qf[0] = qn[0]; qf[1] = qn[1];
            u32x2 zw[4];
            { const bf16_t* zp = ZA + (size_t)qtok * 1024 + h * 64 + 4 * fq;
#pragma unroll
              for (int nt = 0; nt < 4; ++nt) zw[nt] = *(const u32x2*)(zp + 16 * nt);
              const int qtn = i < 7 ? qtok + 128 : qtok;
#pragma unroll
              for (int ks = 0; ks < 2; ++ks) qn[ks] = *(const bf16x8*)(Q + (size_t)qtn * 1024 + h * 64 + ks * 32 + fq * 8); }
            f32x4 acc[16];
            { int slot = krow0 % 9;
#pragma unroll
              for (int n2 = 0; n2 < 8; ++n2) { const NAT_LAS unsigned char* kp = lds + KIMG + slot * SLOTB;
#pragma unroll
                  for (int hf = 0; hf < 2; ++hf) { const int n = 2 * n2 + hf;
                      const bf16x8 k0 = *(const NAT_LAS bf16x8*)(kp + koff[hf][0]), k1 = *(const NAT_LAS bf16x8*)(kp + koff[hf][1]);
                      acc[n] = __builtin_amdgcn_mfma_f32_16x16x32_bf16(k0, qf[0], (f32x4){0.f, 0.f, 0.f, 0.f}, 0, 0, 0);
                      acc[n] = __builtin_amdgcn_mfma_f32_16x16x32_bf16(k1, qf[1], acc[n], 0, 0, 0); }
                  slot = slot == 8 ? 0 : slot + 1; } }
            asm volatile("s_waitcnt lgkmcnt(0)\n\ts_barrier" ::: "memory");
            if (i < 7) { int row = hi + rsel; row = row > hin - 1 ? hin - 1 : row; const int slot = row % 9;
#pragma unroll
                for (int e = 0; e < 2; ++e) { const int c8 = qb * 2 + e, col = c8 * 8 + dcol, gch = dpos ^ ((col >> 1) & 7);
                    glds16(Kh + (size_t)(row * 64 + col) * 1024 + gch * 8, (unsigned)__builtin_amdgcn_readfirstlane((int)(ldsbase + KIMG + slot * SLOTB + c8 * 1024))); } }
            float sc[8][4];
            { float bvv[8][4];
#pragma unroll
              for (int n2 = 0; n2 < 8; ++n2) { const NAT_LAS float* brow = biasL + (krow0 + n2 - r + 7) * 31;
#pragma unroll
                  for (int j = 0; j < 4; ++j) bvv[n2][j] = brow[dcs[j]]; }
              asm volatile("s_waitcnt lgkmcnt(0)" ::: "memory");
#pragma unroll
              for (int n2 = 0; n2 < 8; ++n2)
#pragma unroll
                  for (int j = 0; j < 4; ++j) sc[n2][j] = (selhi[j] ? acc[2 * n2 + 1][j] : acc[2 * n2][j]) + bvv[n2][j]; }
            float mx = sc[0][0];
#pragma unroll
            for (int n2 = 0; n2 < 8; ++n2)
#pragma unroll
                for (int j = 0; j < 4; ++j) mx = fmaxf(mx, sc[n2][j]);
            mx = fmaxf(mx, __shfl_xor(mx, 16)); mx = fmaxf(mx, __shfl_xor(mx, 32));
            float l0 = 0.f, l1 = 0.f;
#pragma unroll
            for (int n2 = 0; n2 < 8; ++n2) {
#pragma unroll
                for (int j = 0; j < 4; ++j) sc[n2][j] = __builtin_amdgcn_exp2f(sc[n2][j] - mx);
                l0 += sc[n2][0] + sc[n2][1]; l1 += sc[n2][2] + sc[n2][3]; }
            float l = l0 + l1;
            l += __shfl_xor(l, 16); l += __shfl_xor(l, 32);
            const float linv = __builtin_amdgcn_rcpf(l);
            bf16x8 pf[8];
#pragma unroll
            for (int s8 = 0; s8 < 8; ++s8) { const unsigned w0p = pg8::cvt_pk_bf16(sc[s8][0], sc[s8][1]), w1p = pg8::cvt_pk_bf16(sc[s8][2], sc[s8][3]);
                u32x4 w; w.x = w0p & mlo[0]; w.y = w1p & mlo[1]; w.z = w0p & mhi[0]; w.w = w1p & mhi[1]; pf[s8] = __builtin_bit_cast(bf16x8, w); }
            asm volatile("s_waitcnt vmcnt(2) lgkmcnt(0)\n\ts_barrier" ::: "memory");
            f32x4 o[4];
#pragma unroll
            for (int nt = 0; nt < 4; ++nt) o[nt] = (f32x4){0.f, 0.f, 0.f, 0.f};
            { int slot = krow0 % 9;
#pragma unroll
              for (int s8 = 0; s8 < 8; ++s8) { const unsigned vb = ldsbase + VIMG + slot * SLOTB + vlane;
#pragma unroll
                  for (int nt = 0; nt < 4; ++nt) {
                      const s16x4 lo = vtr(vb + (unsigned)(32 * (nt ^ vx)));
                      const s16x4 hi2 = vtr(vb + (unsigned)(2048 + 32 * (nt ^ vx)));
                      const bf16x8 vf = (bf16x8){lo[0], lo[1], lo[2], lo[3], hi2[0], hi2[1], hi2[2], hi2[3]};
                      o[nt] = __builtin_amdgcn_mfma_f32_16x16x32_bf16(vf, pf[s8], o[nt], 0, 0, 0); }
                  slot = slot == 8 ? 0 : slot + 1; } }
            asm volatile("" :: "v"(zw[0]), "v"(zw[1]), "v"(zw[2]), "v"(zw[3]), "v"(qn[0]), "v"(qn[1]));
            asm volatile("s_waitcnt vmcnt(0) lgkmcnt(0)\n\ts_barrier" ::: "memory");
            if (i < 7) { int row = hi + rsel; row = row > hin - 1 ? hin - 1 : row; const int slot = row % 9;
#pragma unroll
                for (int e = 0; e < 2; ++e) { const int c8 = qb * 2 + e, col = c8 * 8 + dcol, gch = dpos ^ (((col >> 1) & 3) << 1);
                    glds16(Vh + (size_t)(row * 64 + col) * 1024 + gch * 8, (unsigned)__builtin_amdgcn_readfirstlane((int)(ldsbase + VIMG + slot * SLOTB + c8 * 1024))); } }
            { bf16_t* op = ACAT + (size_t)qtok * 2048 + 1024 + h * 64 + 4 * fq;
#pragma unroll
              for (int nt = 0; nt < 4; ++nt) { u32x2 w; w.x = pg8::cvt_pk_bf16(o[nt][0] * linv * pg8::bf_lo(zw[nt].x), o[nt][1] * linv * pg8::bf_hi(zw[nt].x));
                  w.y = pg8::cvt_pk_bf16(o[nt][2] * linv * pg8::bf_lo(zw[nt].y), o[nt][3] * linv * pg8::bf_hi(zw[nt].y));
                  *(u32x2*)(op + 16 * nt) = w; } }
        }
        asm volatile("s_waitcnt vmcnt(0) lgkmcnt(0)\n\ts_barrier" ::: "memory");
    }
}
}
namespace misc {
typedef unsigned short bf16_t;
typedef float f32x4 __attribute__((ext_vector_type(4)));
typedef float f32x2 __attribute__((ext_vector_type(2)));
typedef unsigned u32x4 __attribute__((ext_vector_type(4)));
typedef unsigned u32x2 __attribute__((ext_vector_type(2)));
#define MISC_LAS __attribute__((address_space(3)))
#define LDS_WAIT() asm volatile("s_waitcnt lgkmcnt(0)" ::: "memory")
__device__ __forceinline__ unsigned f2bf(float f) { unsigned u = __builtin_bit_cast(unsigned, f); return (u + 0x7fffu + ((u >> 16) & 1u)) >> 16; }
__device__ __forceinline__ unsigned pk2(float lo, float hi) { return f2bf(lo) | (f2bf(hi) << 16); }
__device__ __forceinline__ float wave_sum(float v) {
#pragma unroll
    for (int o = 1; o < 64; o <<= 1) v += __shfl_xor(v, o);
    return v;
}
__device__ __forceinline__ void transpose_item(const float* W, int N, bf16_t* WT, int ldt, int koff, int drow, MISC_LAS float* scr, int k0, int n0, int lane) {
    float v[32];
#pragma unroll
    for (int i = 0; i < 32; ++i) { const int kk = 2 * i + (lane >> 5); v[i] = W[(size_t)(k0 + kk) * N + n0 + (lane & 31)]; }
#pragma unroll
    for (int i = 0; i < 32; ++i) { const int kk = 2 * i + (lane >> 5); scr[kk * 33 + (lane & 31)] = v[i]; }
    LDS_WAIT(); asm volatile("" ::: "memory");
    const int c = lane & 7;
#pragma unroll
    for (int j = 0; j < 4; ++j) { const int n = (lane >> 3) + 8 * j; const MISC_LAS float* s = scr + (8 * c) * 33 + n;
        u32x4 o; o.x = pk2(s[0 * 33], s[1 * 33]); o.y = pk2(s[2 * 33], s[3 * 33]); o.z = pk2(s[4 * 33], s[5 * 33]); o.w = pk2(s[6 * 33], s[7 * 33]);
        *(u32x4*)(WT + (size_t)(drow + n) * ldt + koff + k0 + 8 * c) = o; }
    LDS_WAIT(); asm volatile("" ::: "memory");
}
__device__ __forceinline__ void rms_rows(const float* x, const float* gam, bf16_t* o, int m0, int stride, int nrows, int lane) {
    const f32x4* gr = (const f32x4*)gam + lane; f32x4 gg[8];
#pragma unroll
    for (int j = 0; j < 8; ++j) gg[j] = gr[64 * j];
    if (m0 >= nrows) return;
    f32x4 v[8];
    { const f32x4* xr = (const f32x4*)(x + (size_t)m0 * 2048) + lane;
#pragma unroll
      for (int j = 0; j < 8; ++j) v[j] = xr[64 * j]; }
    for (int m = m0; m < nrows; m += stride) {
        float s = 0.f;
#pragma unroll
        for (int j = 0; j < 8; ++j) s += (v[j].x * v[j].x + v[j].y * v[j].y) + (v[j].z * v[j].z + v[j].w * v[j].w);
        const float rs = __builtin_amdgcn_rsqf(wave_sum(s) * (1.f / 2048.f) + 1e-6f);
        u32x2 w[8];
#pragma unroll
        for (int j = 0; j < 8; ++j) { w[j].x = pk2(v[j].x * rs * gg[j].x, v[j].y * rs * gg[j].y); w[j].y = pk2(v[j].z * rs * gg[j].z, v[j].w * rs * gg[j].w); }
        const int mn = m + stride;
        if (mn < nrows) { const f32x4* xr = (const f32x4*)(x + (size_t)mn * 2048) + lane;
#pragma unroll
            for (int j = 0; j < 8; ++j) v[j] = xr[64 * j]; }
        u32x2* o8 = (u32x2*)(o + (size_t)m * 2048) + lane;
#pragma unroll
        for (int j = 0; j < 8; ++j) o8[64 * j] = w[j];
    }
}
__device__ __forceinline__ float exp_small(float x) {
    float t = 1.f, s = 1.f;
#pragma nounroll
    for (int k = 1; k <= 11; ++k) { t *= x * __builtin_amdgcn_rcpf((float)k); s += t; }
    return s;
}
__device__ __forceinline__ float exp_f(float x) {
    float r = exp_small(x * 0.0625f);
    r *= r; r *= r; r *= r; r *= r; return r;
}
__device__ __forceinline__ void sincos_f(float a, float& s, float& c) {
    const float k = __builtin_rintf(a * 0.15915494309189535f);
    float r = __builtin_fmaf(-k, 6.28318548202514648f, a); r = __builtin_fmaf(-k, -1.7484556000744883e-07f, r); r *= 0.25f;
    const float r2 = r * r; float ts = r, tc = 1.f, ss = r, cc = 1.f;
#pragma nounroll
    for (int i = 1; i <= 7; ++i) { const float e = (float)(2 * i); tc *= -r2 * __builtin_amdgcn_rcpf((e - 1.f) * e); ts *= -r2 * __builtin_amdgcn_rcpf(e * (e + 1.f)); cc += tc; ss += ts; }
#pragma nounroll
    for (int i = 0; i < 2; ++i) { const float c2 = cc * cc - ss * ss, s2 = 2.f * ss * cc; cc = c2; ss = s2; }
    s = ss; c = cc;
}
constexpr int SM_POW = 0;
constexpr int SM_FC = SM_POW + 2 * 33 * 65 * 2;
constexpr int SM_BRE = SM_FC + 256;
constexpr int SM_BIM = SM_BRE + 2048;
constexpr int SM_CC = SM_BIM + 2048;
constexpr int SM_TB = SM_CC + 2 * 16 * 65 * 2;
constexpr int TBS = 264;
constexpr int SM_END = SM_TB + 63 * TBS / 2;
static_assert(SM_END * 4 <= 140 * 1024, "SSM builder LDS");

__device__ __forceinline__ void ssm_build(MISC_LAS float* L, int g, const float* a_re, const float* a_im, const float* log_dt, const float* b_re, const float* b_im,
                                          const float* c_re, const float* c_im, const float* dsk, bf16_t* SSMY, bf16_t* SSME, float* AT, int tid, const int stop_at = 9) {
    MISC_LAS f32x2* POW = (MISC_LAS f32x2*)(L + SM_POW); MISC_LAS f32x2* FC = (MISC_LAS f32x2*)(L + SM_FC);
    MISC_LAS float* BRE = L + SM_BRE; MISC_LAS float* BIM = L + SM_BIM; MISC_LAS f32x2* CC = (MISC_LAS f32x2*)(L + SM_CC); MISC_LAS bf16_t* TB = (MISC_LAS bf16_t*)(L + SM_TB);
    if (tid < 128) { const int d = tid >> 6, p = tid & 63;
        float lre = a_re[(d * 64 + g) * 64 + p]; lre = lre < -1e-4f ? lre : -1e-4f; const float lim = a_im[(d * 64 + g) * 64 + p];
        const float dt = exp_f(log_dt[d * 64 + g]);
        const float mag = exp_f(lre * dt); float sn, cs; sincos_f(lim * dt, sn, cs);
        const float zr = mag * cs, zi = mag * sn, rden = 1.f / (lre * lre + lim * lim);
        FC[d * 64 + p] = (f32x2){((zr - 1.f) * lre + zi * lim) * rden, (zi * lre - (zr - 1.f) * lim) * rden};
        float pr = 1.f, pi = 0.f;
#pragma nounroll
        for (int j = 0; j <= 32; ++j) { POW[(d * 33 + j) * 65 + p] = (f32x2){pr, pi}; const float nr = pr * zr - pi * zi, ni = pr * zi + pi * zr; pr = nr; pi = ni; }
        const f32x2 a32 = POW[(d * 33 + 32) * 65 + p]; *(f32x2*)(AT + ((g * 2 + d) * 64 + p) * 2) = a32;
    }
    __syncthreads();
    if (stop_at == 1) return;
    for (int idx = tid; idx < 2048; idx += 512) {
        { const int d = idx >> 10, p = (idx >> 4) & 63, h = idx & 15; const size_t gi = ((size_t)(d * 64 + g) * 64 + p) * 16 + h; const float br = b_re[gi], bi = b_im[gi]; const f32x2 f = FC[d * 64 + p];
          BRE[idx] = f.x * br - f.y * bi; BIM[idx] = f.x * bi + f.y * br; }
        { const int d = idx >> 10, hp = (idx >> 6) & 15, p = idx & 63; const size_t gi = ((size_t)(d * 64 + g) * 16 + hp) * 64 + p; CC[(d * 16 + hp) * 65 + p] = (f32x2){c_re[gi], c_im[gi]}; }
    }
    __syncthreads();
    { const int j = (tid >> 4) & 31, hp = tid & 15; float a[2][16];
#pragma unroll
      for (int d = 0; d < 2; ++d) {
#pragma unroll
        for (int h = 0; h < 16; ++h) a[d][h] = 0.f;
        for (int p = 0; p < 64; ++p) { const f32x2 c = CC[(d * 16 + hp) * 65 + p], w = POW[(d * 33 + j) * 65 + p]; const float cpr = c.x * w.x - c.y * w.y, cpi = c.x * w.y + c.y * w.x;
            const MISC_LAS f32x4* br = (const MISC_LAS f32x4*)(BRE + (d * 64 + p) * 16); const MISC_LAS f32x4* bi = (const MISC_LAS f32x4*)(BIM + (d * 64 + p) * 16);
#pragma unroll
            for (int q = 0; q < 4; ++q) { const f32x4 r4 = br[q], i4 = bi[q];
#pragma unroll
                for (int e = 0; e < 4; ++e) a[d][4 * q + e] += cpr * r4[e] - cpi * i4[e]; } } }
      if (j == 0) { const float dd = dsk[g * 16 + hp];
#pragma unroll
          for (int h = 0; h < 16; h += 2) *(MISC_LAS unsigned*)(TB + 31 * TBS + hp * 16 + h) = pk2(a[0][h] + a[1][h] + (h == hp ? dd : 0.f), a[0][h + 1] + a[1][h + 1] + (h + 1 == hp ? dd : 0.f));
      } else {
#pragma unroll
          for (int h = 0; h < 16; h += 2) { *(MISC_LAS unsigned*)(TB + (31 + j) * TBS + hp * 16 + h) = pk2(a[0][h], a[0][h + 1]); *(MISC_LAS unsigned*)(TB + (31 - j) * TBS + hp * 16 + h) = pk2(a[1][h], a[1][h + 1]); } }
    }
    __syncthreads();
    if (stop_at == 2) return;
    bf16_t* Yg = SSMY + (size_t)g * 512 * 768;
    for (int idx = tid; idx < 512 * 96; idx += 512) { const int n = idx / 96, kc = idx - n * 96, i = n >> 4, hp = n & 15; float v[8];
        if (kc < 64) { const int j = kc >> 1, h0 = (kc & 1) * 8;
            *(u32x4*)(Yg + (size_t)n * 768 + kc * 8) = *(const MISC_LAS u32x4*)(TB + (31 + i - j) * TBS + hp * 16 + h0); continue;
        } else { const int kk = (kc - 64) * 8, d = kk >> 7, ri = (kk >> 6) & 1, p0 = kk & 63, jj = d == 0 ? i + 1 : 32 - i;
#pragma unroll
            for (int e = 0; e < 8; ++e) { const f32x2 c = CC[(d * 16 + hp) * 65 + p0 + e], w = POW[(d * 33 + jj) * 65 + p0 + e]; v[e] = ri ? -(c.x * w.y + c.y * w.x) : (c.x * w.x - c.y * w.y); } }
        u32x4 o; o.x = pk2(v[0], v[1]); o.y = pk2(v[2], v[3]); o.z = pk2(v[4], v[5]); o.w = pk2(v[6], v[7]);
        *(u32x4*)(Yg + (size_t)n * 768 + kc * 8) = o; }
    bf16_t* Eg = SSME + (size_t)g * 256 * 512;
    for (int idx = tid; idx < 256 * 64; idx += 512) { const int n = idx >> 6, kc = idx & 63, d = n >> 7, ri = (n >> 6) & 1, p = n & 63, j = kc >> 1, h0 = (kc & 1) * 8, jj = d == 0 ? 31 - j : j;
        const f32x2 w = POW[(d * 33 + jj) * 65 + p]; float v[8];
#pragma unroll
        for (int e = 0; e < 8; ++e) { const float br = BRE[(d * 64 + p) * 16 + h0 + e], bi = BIM[(d * 64 + p) * 16 + h0 + e]; v[e] = ri ? (w.x * bi + w.y * br) : (w.x * br - w.y * bi); }
        u32x4 o; o.x = pk2(v[0], v[1]); o.y = pk2(v[2], v[3]); o.z = pk2(v[4], v[5]); o.w = pk2(v[6], v[7]);
        *(u32x4*)(Eg + (size_t)n * 512 + kc * 8) = o; }
    __syncthreads();
}
__device__ __forceinline__ void rec_one(const float* __restrict__ E, bf16_t* __restrict__ UEXT, const float* __restrict__ AT, int seq, int g, int d, int nc, int lane) {
    const f32x2 at = *(const f32x2*)(AT + ((g * 2 + d) * 64 + lane) * 2);
    float sr = 0.f, si = 0.f;
    const int cb = seq * nc;
#pragma unroll 8
    for (int q = 0; q < nc; ++q) { const int c = cb + (d == 0 ? q : nc - 1 - q);
        const float er = E[((size_t)(g * 512 + c)) * 256 + d * 128 + lane], ei = E[((size_t)(g * 512 + c)) * 256 + d * 128 + 64 + lane];
        bf16_t* up = UEXT + ((size_t)(g * 512 + c)) * 768 + 512 + d * 128 + lane;
        up[0] = (bf16_t)f2bf(sr); up[64] = (bf16_t)f2bf(si);
        const float nr = at.x * sr - at.y * si + er, ni = at.x * si + at.y * sr + ei; sr = nr; si = ni; }
}
__device__ __forceinline__ void rec_phase(const float* __restrict__ E, bf16_t* __restrict__ UEXT, const float* __restrict__ AT, int nseq, int nc, int gw, int NGW, int lane) {
    for (int task = gw; task < nseq * 128; task += NGW) rec_one(E, UEXT, AT, task >> 7, (task >> 1) & 63, task & 1, nc, lane);
}
}
#define XB_TMO      128
#define XB_XCNT(j)  (256  + 64 * (j))
#define XB_XSUB(j)  (1280 + 64 * (j))
#define XB_XGEN(j)  (2304 + 64 * (j))
#define XB_TOP      3328
#define XB_TOPGEN   3392
#define XCD_BAR_WORDS 3456
#define XB_SPIN_CAP (1u << 18)
#define XB_LAS __attribute__((address_space(3)))
__device__ __forceinline__ unsigned xb_ld(unsigned* p)              { return __hip_atomic_load(p, __ATOMIC_RELAXED, __HIP_MEMORY_SCOPE_AGENT); }
__device__ __forceinline__ unsigned xb_add(unsigned* p, unsigned v) { return __hip_atomic_fetch_add(p, v, __ATOMIC_RELAXED, __HIP_MEMORY_SCOPE_AGENT); }
__device__ __forceinline__ unsigned xb_xcc_id() { return (unsigned)__builtin_amdgcn_s_getreg((3 << 11) | 20) & 0xFu; }
#define XB_SPIN(cond, bar) do { unsigned _sp = 0; while (cond) { __builtin_amdgcn_s_sleep(1); \
    if ((++_sp & 255u) == 0u) { if (xb_ld(&(bar)[XB_TMO])) break; if (_sp > XB_SPIN_CAP) { atomicAdd(&(bar)[XB_TMO], 1u); break; } } } } while (0)
struct XcdBarrier { unsigned* bar; unsigned x; volatile XB_LAS unsigned* st; };
__device__ __forceinline__ XcdBarrier xcd_barrier_post(unsigned* bar, volatile XB_LAS unsigned* st) {
    XcdBarrier b; b.bar = bar; b.x = xb_xcc_id(); b.st = st;
    if (threadIdx.x == 0) (void)xb_add(&bar[XB_XCNT(b.x)], 1u);
    return b;
}
__device__ __forceinline__ void xcd_barrier_complete(unsigned* bar, unsigned x, unsigned& nloc, unsigned& nx) {
    const unsigned G = gridDim.x * gridDim.y * gridDim.z;
    unsigned sum, cnt, mine, sp = 0u;
    for (;;) {
        sum = 0u; cnt = 0u; mine = 0u;
#pragma unroll
        for (unsigned j = 0; j < 16; ++j) { const unsigned c = xb_ld(&bar[XB_XCNT(j)]); sum += c; cnt += (c > 0u) ? 1u : 0u; mine = (j == x) ? c : mine; }
        if (sum == G) break;
        __builtin_amdgcn_s_sleep(1);
        if ((++sp & 255u) == 0u) { if (xb_ld(&bar[XB_TMO])) break; if (sp > XB_SPIN_CAP) { atomicAdd(&bar[XB_TMO], 1u); break; } }
    }
    nloc = mine > 0u ? mine : 1u; nx = cnt > 0u ? cnt : 1u;
}
__device__ __forceinline__ void xcd_barrier(const XcdBarrier& b) {
    asm volatile("s_waitcnt vmcnt(0)" ::: "memory");
    __syncthreads();
    if (threadIdx.x == 0) {
        unsigned* bar = b.bar;
        __builtin_amdgcn_s_waitcnt(0);
        unsigned nloc = b.st[0], nx = b.st[1];
        if (nloc == 0u) { xcd_barrier_complete(bar, b.x, nloc, nx); b.st[0] = nloc; b.st[1] = nx; }
        const unsigned old = xb_add(&bar[XB_XSUB(b.x)], 1u);
        const unsigned gen = old / nloc;
        if (old + 1u == (gen + 1u) * nloc) {
            __builtin_amdgcn_fence(__ATOMIC_RELEASE, "agent");
            asm volatile("s_waitcnt vmcnt(0)" ::: "memory");
            const unsigned og = xb_add(&bar[XB_TOP], 1u);
            const unsigned tg = og / nx;
            if (og + 1u == (tg + 1u) * nx) xb_add(&bar[XB_TOPGEN], 1u);
            else XB_SPIN(xb_ld(&bar[XB_TOPGEN]) == tg, bar);
            __builtin_amdgcn_fence(__ATOMIC_ACQUIRE, "agent");
            xb_add(&bar[XB_XGEN(b.x)], 1u);
            asm volatile("s_waitcnt vmcnt(0)" ::: "memory");
        } else {
            XB_SPIN(xb_ld(&bar[XB_XGEN(b.x)]) == gen, bar);
            __builtin_amdgcn_fence(__ATOMIC_ACQUIRE, "agent");
            asm volatile("s_waitcnt vmcnt(0)" ::: "memory");
        }
    }
    __syncthreads();
}
#ifndef PH_MASK
#define PH_MASK 0xff
#endif
#define HAS(k) (((PH_MASK) >> (k)) & 1)
#ifndef SYNC_REPS
#define SYNC_REPS 1
#endif
#ifndef DUP_SKIP_SSM
#define DUP_SKIP_SSM 0
#endif
#ifndef G1_WGM
#define G1_WGM 8
#endif
#ifndef G1_ALIGN
#define G1_ALIGN true
#endif
#ifndef G1_SP2
#define G1_SP2 true
#endif
#ifndef DUP_MASK
#define DUP_MASK 0
#endif
#ifndef MK_MULTI
#define MK_MULTI 0
#endif
typedef unsigned short bf16;
constexpr size_t MiB = 1u << 20;
constexpr int MP = 16384;
constexpr size_t WS_WIN = 0, WS_WGLU = 40 * MiB, WS_WMRG = 42 * MiB, WS_WOUT = 50 * MiB, WS_SSMY = 58 * MiB, WS_SSME = 106 * MiB, WS_AT = 122 * MiB,
                 WS_H = 123 * MiB  , WS_UEXT = 187 * MiB  , WS_ZS = 235 * MiB, WS_Q = 267 * MiB, WS_K = 299 * MiB, WS_V = 331 * MiB,
                 WS_ZA = 363 * MiB, WS_Y = 395 * MiB, WS_E = 427 * MiB, WS_END = 459 * MiB;
constexpr int LDS_BYTES = 147456 + 2048 + 256;
constexpr size_t WS_BAR = WS_END, WS_BAR_BYTES = 16384;
constexpr int N_PHASES = 15;
extern "C" __device__ void __ockl_grid_sync(void);

constexpr int I_IN = 32 * 320, I_GLU = 16 * 32, I_BS = 16 * 64, I_OUT = 32 * 64, NITEMS = I_IN + I_GLU + 2 * I_BS + I_OUT;
__device__ __forceinline__ void weight_item(int r, const float* w_in, const float* w_glu, const float* w_bs, const float* w_ba, const float* w_out,
                                            unsigned short* WIN, unsigned short* WGLU, unsigned short* WMRG, unsigned short* WOUT, MISC_LAS float* scr, int lane) {
    if (r < I_IN) { const int kb = r / 320, nb = r % 320, n0 = nb * 32; int drow = n0;
        if (n0 >= 2048 && n0 < 4096) drow = (n0 & ~255) + 128 * ((n0 >> 5) & 1) + 32 * ((n0 >> 6) & 3);
        misc::transpose_item(w_in, 10240, WIN, 2048, 0, drow, scr, kb * 64, n0, lane); return; } r -= I_IN;
    if (r < I_GLU) { misc::transpose_item(w_glu, 1024, WGLU, 1024, 0, (r % 32) * 32, scr, (r / 32) * 64, (r % 32) * 32, lane); return; } r -= I_GLU;
    if (r < I_BS) { misc::transpose_item(w_bs, 2048, WMRG, 2048, 0, (r % 64) * 32, scr, (r / 64) * 64, (r % 64) * 32, lane); return; } r -= I_BS;
    if (r < I_BS) { misc::transpose_item(w_ba, 2048, WMRG, 2048, 1024, (r % 64) * 32, scr, (r / 64) * 64, (r % 64) * 32, lane); return; } r -= I_BS;
    misc::transpose_item(w_out, 2048, WOUT, 2048, 0, (r % 64) * 32, scr, (r / 64) * 64, (r % 64) * 32, lane);
}

struct Args { const float* in[20]; float* out; unsigned char* ws; int ph_lo, ph_hi; };

__global__ void __launch_bounds__(512, 2) hybrid_fwd(Args args) {
    extern __shared__ __attribute__((aligned(16))) unsigned char lds_raw[];
    PG8_LAS unsigned char* lds = (PG8_LAS unsigned char*)lds_raw;
#if !MK_MULTI
    { volatile XB_LAS unsigned* st0 = (volatile XB_LAS unsigned*)((PG8_LAS unsigned char*)lds_raw + (LDS_BYTES - 64)); if (threadIdx.x < 2) st0[threadIdx.x] = 0u; }
    __syncthreads();
    XcdBarrier xbar; xbar.bar = (unsigned*)(args.ws + WS_BAR); xbar.x = xb_xcc_id(); xbar.st = (volatile XB_LAS unsigned*)((PG8_LAS unsigned char*)lds_raw + (LDS_BYTES - 64));
    if (args.ph_lo == 0 && blockIdx.x == 0) { for (int w = threadIdx.x; w < XCD_BAR_WORDS; w += 512) xbar.bar[w] = 0u; }
#endif
    const int G = gridDim.x, bx = blockIdx.x, vcu = (G % 8 == 0) ? (bx % 8) * (G / 8) + bx / 8 : bx;
    bool rep = false, posted = false;
#pragma nounroll
    for (int ph = args.ph_lo; ph < args.ph_hi; ) {
    if (!MK_MULTI && G == 256 && ph != 0 && ((ph - 1) % 7) == 2) { ++ph; continue; }
    int tid = threadIdx.x; asm volatile("" : "+v"(tid));
    size_t zoff = 0; asm volatile("" : "+s"(zoff));
    unsigned char* ws = args.ws + zoff; float* outb = args.out + zoff;
    const int lane = tid & 63, wave = __builtin_amdgcn_readfirstlane(tid >> 6);
    bf16* WIN = (bf16*)(ws + WS_WIN); bf16* WGLU = (bf16*)(ws + WS_WGLU); bf16* WMRG = (bf16*)(ws + WS_WMRG); bf16* WOUT = (bf16*)(ws + WS_WOUT);
    bf16* SSMY = (bf16*)(ws + WS_SSMY); bf16* SSME = (bf16*)(ws + WS_SSME); float* AT = (float*)(ws + WS_AT);
    bf16* HB = (bf16*)(ws + WS_H); bf16* ACAT = HB; bf16* UEXT = (bf16*)(ws + WS_UEXT); bf16* MBUF = UEXT; bf16* ZS = (bf16*)(ws + WS_ZS);
    bf16* QB = (bf16*)(ws + WS_Q); bf16* KB = (bf16*)(ws + WS_K); bf16* VB = (bf16*)(ws + WS_V); bf16* ZA = (bf16*)(ws + WS_ZA); bf16* YB = (bf16*)(ws + WS_Y);
    float* EB = (float*)(ws + WS_E);
        if (ph == 0) { if (HAS(0)) {
            const int nssm = G > 64 ? 64 : 0;
            if (bx < nssm) {
                for (int g = bx; g < 64 && !(DUP_SKIP_SSM == 1 && rep); g += nssm)
                    misc::ssm_build((MISC_LAS float*)lds, g, args.in[4], args.in[5], args.in[6], args.in[7], args.in[8], args.in[9], args.in[10], args.in[11], SSMY, SSME, AT, tid, (DUP_SKIP_SSM > 1 && rep) ? DUP_SKIP_SSM - 1 : 9);
            } else {
                MISC_LAS float* scr = (MISC_LAS float*)(lds + wave * 16384);
                const int gw = (bx - nssm) * 8 + wave, NGW = (G - nssm) * 8;
                const int nearly = (G == 256) ? I_IN : NITEMS;
                for (int it = gw; it < nearly; it += NGW) weight_item(it, args.in[3], args.in[12], args.in[17], args.in[18], args.in[19], WIN, WGLU, WMRG, WOUT, scr, lane);
                misc::rms_rows(args.in[0], args.in[2], HB, gw, NGW, MP, lane);
                { bf16* HB1 = (bf16*)((unsigned char*)outb + 192 * MiB);
                  misc::rms_rows(args.in[1], args.in[2], HB1, gw, NGW, MP, lane); }
            }
            }
            __syncthreads();
        } else {
            const int p = (ph - 1) / 7, s = (ph - 1) % 7;
            const float* xp = args.in[p]; float* outp = outb + (size_t)p * MP * 2048;
            unsigned char* GS = (unsigned char*)outp; unsigned char* GA = GS + (size_t)MP * 2048;
            if (s == 0) { if (HAS(1)) {
                pg8::Gemm g{p == 0 ? HB : (bf16*)((unsigned char*)outb + 192 * MiB), WIN, 2048, 2048, 2048}; pg8::StaticOrder S; S.init(MP, 10240, G, bx, G1_WGM);
                pg8::EpiProj E{UEXT, ZS, QB, KB, VB, ZA, GS, GA, args.in[14], args.in[15]};
                pg8::gemm_phase<pg8::EpiProj, pg8::StaticOrder, G1_ALIGN, G1_SP2>(lds, g, S, E, tid);
            } } else if (s == 1) { if (HAS(2)) {
                nat::attn_phase(lds, QB, KB, VB, ZA, ACAT, args.in[16], p == 0 ? 32 : 128, vcu, G, tid);
                pg8::Gemm g{UEXT, SSME, 768, 512, 512}; pg8::GroupOrder S; S.init(64, 2, 1, G, bx);
                pg8::EpiE E{EB};
                pg8::gemm_phase<pg8::EpiE, pg8::GroupOrder, true, true>(lds, g, S, E, tid);
                if (G == 256 && bx >= 128 && p == 0) {
                    MISC_LAS float* scr = (MISC_LAS float*)(lds + wave * 16384);
                    for (int it = I_IN + (bx - 128) * 8 + wave; it < NITEMS; it += 1024) weight_item(it, args.in[3], args.in[12], args.in[17], args.in[18], args.in[19], WIN, WGLU, WMRG, WOUT, scr, lane);
                }
                if (G == 256 && bx < 128) {
                    asm volatile("s_waitcnt vmcnt(0)" ::: "memory"); __syncthreads();
                    const int nc = p == 0 ? 64 : 256, nloc = 256 / nc;
                    if (wave < 2 * nloc) misc::rec_one(EB, UEXT, AT, (bx & 1) * nloc + (wave >> 1), bx >> 1, wave & 1, nc, lane);
                }
            } } else if (s == 2) { if (HAS(3)) {
                misc::rec_phase(EB, UEXT, AT, p == 0 ? 8 : 2, p == 0 ? 64 : 256, vcu * 8 + wave, G * 8, lane);
            } } else if (s == 3) { if (HAS(4)) {
                pg8::Gemm g{UEXT, SSMY, 768, 768, 768}; pg8::GroupOrder S; S.init(64, 2, 2, G, bx);
                pg8::EpiY E{YB};
                pg8::gemm_phase<pg8::EpiY, pg8::GroupOrder, true, true>(lds, g, S, E, tid);
            } } else if (s == 4) { if (HAS(5)) {
                pg8::Gemm g{YB, WGLU, 1024, 1024, 1024}; pg8::StaticOrder S; S.init(MP, 1024, G, bx);
                pg8::EpiGlu E{YB, ZS, args.in[13], ACAT};
                pg8::gemm_phase<pg8::EpiGlu, pg8::StaticOrder, true, true>(lds, g, S, E, tid);
            } } else if (s == 5) { if (HAS(6)) {
                pg8::Gemm g{ACAT, WMRG, 2048, 2048, 2048}; pg8::StaticOrder S; S.init(MP, 2048, G, bx);
                pg8::EpiMerge E{GS, GA, MBUF};
                pg8::gemm_phase<pg8::EpiMerge, pg8::StaticOrder, true, true>(lds, g, S, E, tid);
            } } else { if (HAS(7)) {
                pg8::Gemm g{MBUF, WOUT, 2048, 2048, 2048}; pg8::StaticOrder S; S.init(MP, 2048, G, bx);
                pg8::EpiOut E{xp, outp};
                pg8::gemm_phase<pg8::EpiOut, pg8::StaticOrder, true, true>(lds, g, S, E, tid);
            } }
            __syncthreads();
        }
        { const int kbit = ph == 0 ? 0 : ((ph - 1) % 7) + 1; const bool again = ((DUP_MASK >> kbit) & 1) && !rep;
          if (again) rep = true; else { rep = false; ++ph; }
#if !MK_MULTI
          if (ph < args.ph_hi) { if (!posted) { __ockl_grid_sync(); if (threadIdx.x == 0) (void)xb_add(&xbar.bar[XB_XCNT(xbar.x)], 1u); posted = true; } else xcd_barrier(xbar); }
#endif
        }
    }
}

#ifdef STOP_PH
__global__ void dump_k(const unsigned short* src, float* out, size_t n) {
    for (size_t i = (size_t)blockIdx.x * blockDim.x + threadIdx.x; i < n; i += (size_t)gridDim.x * blockDim.x) { float acc = 0.f;
        for (int w = 0; w < 4; ++w) { unsigned v = src[(size_t)w * n + i]; if ((v & 0x7f80u) == 0x7f80u) v = 0; acc += __uint_as_float(v << 16); }
        out[i] = acc; }
}
#endif
extern "C" void kernel_launch(void* const* d_in, const int* in_sizes, int n_in, void* d_out, int out_size, void* d_ws, size_t ws_size, hipStream_t stream) {
    static int grid = 0;
    if (grid == 0) {
        if (n_in != 20 || in_sizes[0] != MP * 2048 || in_sizes[1] != MP * 2048 || out_size != 2 * MP * 2048 || ws_size < WS_END + WS_BAR_BYTES) {
            fprintf(stderr, "kernel_launch: unexpected shapes / workspace (n_in %d, ws %zu)\n", n_in, ws_size); grid = -1; return; }
        int dev = 0, cus = 0, per_cu = 0;
        if (hipGetDevice(&dev) != hipSuccess || hipDeviceGetAttribute(&cus, hipDeviceAttributeMultiprocessorCount, dev) != hipSuccess) { grid = -1; return; }
        if (hipFuncSetAttribute((const void*)hybrid_fwd, hipFuncAttributeMaxDynamicSharedMemorySize, LDS_BYTES) != hipSuccess) { fprintf(stderr, "kernel_launch: hipFuncSetAttribute failed\n"); grid = -1; return; }
        if (hipOccupancyMaxActiveBlocksPerMultiprocessor(&per_cu, (const void*)hybrid_fwd, 512, LDS_BYTES) != hipSuccess || per_cu < 1) per_cu = 1;
        (void)hipGetLastError();
        grid = cus * per_cu;
        fprintf(stderr, "kernel_launch: grid %d (cus %d x %d), ws %zu\n", grid, cus, per_cu, ws_size);
    }
    if (grid < 0) return;
#ifdef MK_MEMSET
#if MK_MEMSET == 1
    (void)hipMemsetAsync(d_ws, 0xAA, WS_END, stream);
    (void)hipMemsetAsync(d_out, 0xAA, (size_t)out_size * 4, stream);
#elif MK_MEMSET == 2
    (void)hipMemsetAsync((char*)d_ws + WS_END, 0xAA, 64, stream);
#elif MK_MEMSET == 3
    (void)hipMemsetAsync(d_ws, 0xAA, WS_END, stream);
#elif MK_MEMSET == 4
    (void)hipMemsetAsync(d_out, 0xAA, (size_t)out_size * 4, stream);
#endif
#endif
    Args a{};
    for (int i = 0; i < 20; ++i) a.in[i] = (const float*)d_in[i];
    a.out = (float*)d_out; a.ws = (unsigned char*)d_ws;
#if MK_MULTI
#ifdef STOP_PH
    for (int ph = 0; ph <= STOP_PH; ++ph) { a.ph_lo = ph; a.ph_hi = ph + 1; hipLaunchKernelGGL(hybrid_fwd, dim3(grid), dim3(512), LDS_BYTES, stream, a); }
    hipLaunchKernelGGL(dump_k, dim3(2048), dim3(256), 0, stream, (const unsigned short*)d_ws, (float*)d_out, (size_t)out_size);
#else
    for (int ph = 0; ph < N_PHASES; ++ph) { a.ph_lo = ph; a.ph_hi = ph + 1; hipLaunchKernelGGL(hybrid_fwd, dim3(grid), dim3(512), LDS_BYTES, stream, a); }
#endif
#else
    a.ph_lo = 0; a.ph_hi = N_PHASES;
    void* kargs[] = {&a};
    const hipError_t e = hipLaunchCooperativeKernel((const void*)hybrid_fwd, dim3(grid), dim3(512), kargs, LDS_BYTES, stream);
    if (e != hipSuccess) fprintf(stderr, "kernel_launch: cooperative launch failed: %s (grid %d)\n", hipGetErrorString(e), grid);
#endif
}
```

```cpp
#define MK_MULTI 0
#include <hip/hip_runtime.h>
#include <cstdio>
#include <cstdint>
#include <cmath>
namespace pg8 {
#define PG8_LAS __attribute__((address_space(3)))
typedef unsigned short bf16_t;
typedef short bf16x8 __attribute__((ext_vector_type(8)));
typedef float f32x4 __attribute__((ext_vector_type(4)));
typedef float f32x2 __attribute__((ext_vector_type(2)));
typedef unsigned u32x4 __attribute__((ext_vector_type(4)));
typedef unsigned u32x2 __attribute__((ext_vector_type(2)));
constexpr int BM = 256, BK = 64, HALF = 128, HTB = HALF * BK * 2  , STAGE_BYTES = 8 * HTB, NXCD = 8, WGM = 8;

__host__ __device__ __forceinline__ int lds_byte(int r, int c) { const int st = (r >> 4) * 2 + (c >> 5), rr = r & 15, cc = c & 31, ob = rr * 64 + cc * 2; return st * 1024 + (ob ^ (((ob >> 9) & 1) << 5)); }
__host__ __device__ __forceinline__ void stage_rc(int b, int& R, int& C) { const int st = b / 1024, sb = b % 1024, swz = sb ^ (((sb >> 9) & 1) << 5); R = (st >> 1) * 16 + swz / 64; C = (st & 1) * 32 + (swz % 64) / 2; }
__host__ __device__ __forceinline__ int perm32(int rho) { const int n = rho >> 4, i = rho & 15; return 8 * (i >> 2) + 4 * n + (i & 3); }

struct Unit { int pm, pn; };
struct Gemm { const bf16_t* A; const bf16_t* Bt; int lda, ldb, K; };

struct StaticOrder {
    int nM, nN, nwg, G, c, wgm;
    __host__ __device__ void init(int M, int N, int G_, int c_, int wgm_ = WGM) { nM = M / BM; nN = N / BM; nwg = nM * nN; G = G_; c = c_; wgm = wgm_; }
    __host__ __device__ bool next(int i, Unit& u) const {
        const long L = (long)i * G + c; if (L >= nwg) return false;
        int wgid = (int)L; { const int q = nwg / NXCD, r = nwg % NXCD, xcd = wgid % NXCD, off = wgid / NXCD; wgid = (xcd < r ? xcd * (q + 1) : r * (q + 1) + (xcd - r) * q) + off; }
        const int nig = wgm * nN, gid = wgid / nig, fm = gid * wgm, gsz = (nM - fm) < wgm ? (nM - fm) : wgm;
        u.pm = fm + ((wgid % nig) % gsz); u.pn = (wgid % nig) / gsz; return true;
    }
};
struct RangeOrder {
    StaticOrder S; int i0, n;
    __host__ __device__ bool next(int i, Unit& u) const { if (i >= n) return false; return S.next(i0 + i, u); }
};
struct GroupOrder {
    int rt, ct, total, G, c;
    __host__ __device__ void init(int nG, int rt_, int ct_, int G_, int c_) { rt = rt_; ct = ct_; total = nG * rt_ * ct_; G = G_; c = c_; }
    __host__ __device__ bool next(int i, Unit& u) const {
        const int L = i * G + c; if (L >= total) return false;
        const int per = rt * ct, g = L / per, r = L % per; u.pm = g * rt + r % rt; u.pn = g * ct + r / rt; return true;
    }
};

typedef __bf16 bf16x2_t __attribute__((ext_vector_type(2)));
__device__ __forceinline__ unsigned cvt_pk_bf16(float lo, float hi) { const f32x2 v = {lo, hi}; const bf16x2_t b = __builtin_convertvector(v, bf16x2_t); return __builtin_bit_cast(unsigned, b); }
__device__ __forceinline__ float bf_lo(unsigned w) { return __uint_as_float(w << 16); }
__device__ __forceinline__ float bf_hi(unsigned w) { return __uint_as_float(w & 0xffff0000u); }

template <class Epi, class Sched, bool ALIGN_EPI = false, bool SP2 = false>
__device__ __forceinline__ void gemm_phase(PG8_LAS unsigned char* lds, const Gemm g, const Sched& S, const Epi& E, const int tid) {
    const int wid = __builtin_amdgcn_readfirstlane(tid >> 6), lane = tid & 63, wr = wid >> 2, wc = wid & 3, fr = lane & 15, fq = lane >> 4;
    const int K = g.K, nt = K / BK;
    unsigned voffA[2], voffB[2];
#pragma unroll
    for (int i = 0; i < 2; ++i) { int R, C; stage_rc(tid * 16 + i * 8192, R, C); const int Rb = Epi::PERM ? ((R & ~31) + perm32(R & 31)) : R;
        voffA[i] = (unsigned)(R * g.lda + C) * 2u; voffB[i] = (unsigned)(Rb * g.ldb + C) * 2u; }
    const size_t kstep = (size_t)(BK * 2);
    const size_t hstepA = (size_t)HALF * g.lda * 2, hstepB = (size_t)HALF * g.ldb * 2;
    const size_t tstepA = 2 * hstepA, tstepB = 2 * hstepB;
    const unsigned ldsw = (unsigned)wid * 1024u;
    const int aoff = lds_byte(wr * 64 + fr, fq * 8), boff = lds_byte(wc * 32 + fr, fq * 8);
#define PG8_SA(b, h) (((b) * 2 + (h)) * HTB)
#define PG8_SB(b, h) ((4 + (b) * 2 + (h)) * HTB)
#define PG8_STAGE(bufoff, gbase, voff) do { _Pragma("unroll") for (int _i = 0; _i < 2; ++_i) \
        __builtin_amdgcn_global_load_lds((const unsigned*)((const char*)(gbase) + (voff)[_i]), (PG8_LAS unsigned*)(lds + (bufoff) + ldsw + _i * 8192), 16, 0, 0); } while (0)
#define PG8_LDA(dst, b, h) do { _Pragma("unroll") for (int m = 0; m < 4; ++m) _Pragma("unroll") for (int k = 0; k < 2; ++k) dst[m][k] = *(const PG8_LAS bf16x8*)(lds + PG8_SA(b, h) + aoff + m * 2048 + k * 1024); } while (0)
#define PG8_LDB(dst, b, h) do { _Pragma("unroll") for (int n = 0; n < 2; ++n) _Pragma("unroll") for (int k = 0; k < 2; ++k) dst[n][k] = *(const PG8_LAS bf16x8*)(lds + PG8_SB(b, h) + boff + n * 2048 + k * 1024); } while (0)
#define PG8_MMA(ai, bj, At, Bt) do { __builtin_amdgcn_s_setprio(1); _Pragma("unroll") for (int m = 0; m < 4; ++m) _Pragma("unroll") for (int n = 0; n < 2; ++n) _Pragma("unroll") for (int k = 0; k < 2; ++k) \
        acc[ai][bj][m][n] = __builtin_amdgcn_mfma_f32_16x16x32_bf16(Bt[n][k], At[m][k], acc[ai][bj][m][n], 0, 0, 0); __builtin_amdgcn_s_setprio(0); } while (0)
#define PG8_WAIT_V(n) asm volatile("s_waitcnt vmcnt(" #n ")" ::: "memory")
#define PG8_WAIT_L(n) asm volatile("s_waitcnt lgkmcnt(" #n ")" ::: "memory")
#define PG8_BAR __builtin_amdgcn_s_barrier()
#define PG8_SCHED __builtin_amdgcn_sched_barrier(0)
    Unit cur, nxt; int ui = 0;
    if (!S.next(0, cur)) return;
    f32x4 acc[2][2][4][2];
#pragma unroll
    for (int a = 0; a < 2; ++a)
#pragma unroll
        for (int b = 0; b < 2; ++b)
#pragma unroll
            for (int m = 0; m < 4; ++m)
#pragma unroll
                for (int n = 0; n < 2; ++n) acc[a][b][m][n] = (f32x4){0.f, 0.f, 0.f, 0.f};
    bf16x8 At[4][2], B0[2][2], B1[2][2];
    const char* cA = (const char*)g.A + (size_t)cur.pm * tstepA; const char* cB = (const char*)g.Bt + (size_t)cur.pn * tstepB;
    if constexpr (SP2) {
        PG8_STAGE(PG8_SB(0, 0), cB, voffB); PG8_STAGE(PG8_SB(0, 1), cB + hstepB, voffB); PG8_STAGE(PG8_SA(0, 0), cA, voffA); PG8_STAGE(PG8_SA(0, 1), cA + hstepA, voffA);
        if (wr == 1) PG8_BAR;
        PG8_WAIT_V(2); PG8_BAR;
        PG8_STAGE(PG8_SB(1, 0), cB + kstep, voffB); PG8_STAGE(PG8_SA(1, 0), cA + kstep, voffA); PG8_STAGE(PG8_SB(1, 1), cB + hstepB + kstep, voffB);
        PG8_WAIT_V(6); PG8_BAR;
    } else {
        PG8_STAGE(PG8_SB(0, 0), cB, voffB); PG8_STAGE(PG8_SA(0, 0), cA, voffA); PG8_STAGE(PG8_SB(0, 1), cB + hstepB, voffB); PG8_STAGE(PG8_SA(0, 1), cA + hstepA, voffA);
        if (wr == 1) PG8_BAR;
        PG8_WAIT_V(4); PG8_BAR;
        PG8_STAGE(PG8_SB(1, 0), cB + kstep, voffB); PG8_STAGE(PG8_SA(1, 0), cA + kstep, voffA); PG8_STAGE(PG8_SB(1, 1), cB + hstepB + kstep, voffB);
        PG8_WAIT_V(6); PG8_BAR;
    }
    for (;;) {
        const bool has_next = S.next(ui + 1, nxt);
        const char* nA = has_next ? (const char*)g.A + (size_t)nxt.pm * tstepA : cA; const char* nB = has_next ? (const char*)g.Bt + (size_t)nxt.pn * tstepB : cB;
        for (int t = 0; t < nt; t += 2) {
            const bool last = (t == nt - 2);
            const char* a1 = cA + (size_t)(t + 1) * kstep;
            const char* a2 = last ? nA : cA + (size_t)(t + 2) * kstep; const char* b2 = last ? nB : cB + (size_t)(t + 2) * kstep;
            const char* a3 = a2 + kstep; const char* b3 = b2 + kstep;
            if constexpr (Epi::MIDK) { if (t == (nt >> 1)) E.mid(acc, cur, wr, wc, fr, fq); }
            if constexpr (SP2) {
            PG8_LDB(B0, 0, 0); PG8_LDB(B1, 0, 1); PG8_SCHED; PG8_LDA(At, 0, 0); PG8_STAGE(PG8_SA(1, 1), a1 + hstepA, voffA);
            PG8_WAIT_V(8); PG8_WAIT_L(0); PG8_BAR; PG8_MMA(0, 0, At, B0); PG8_MMA(0, 1, At, B1); PG8_BAR; PG8_SCHED;
            PG8_LDA(At, 0, 1); PG8_STAGE(PG8_SB(0, 0), b2, voffB); PG8_STAGE(PG8_SB(0, 1), b2 + hstepB, voffB); PG8_STAGE(PG8_SA(0, 0), a2, voffA);
            PG8_WAIT_V(8); PG8_WAIT_L(0); PG8_BAR; PG8_MMA(1, 0, At, B0); PG8_MMA(1, 1, At, B1); PG8_BAR; PG8_SCHED;
            PG8_LDB(B0, 1, 0); PG8_LDB(B1, 1, 1); PG8_SCHED; PG8_LDA(At, 1, 0); PG8_STAGE(PG8_SA(0, 1), a2 + hstepA, voffA);
            PG8_WAIT_V(8); PG8_WAIT_L(0); PG8_BAR; PG8_MMA(0, 0, At, B0); PG8_MMA(0, 1, At, B1); PG8_BAR; PG8_SCHED;
            PG8_LDA(At, 1, 1); PG8_STAGE(PG8_SB(1, 0), b3, voffB); PG8_STAGE(PG8_SB(1, 1), b3 + hstepB, voffB); PG8_STAGE(PG8_SA(1, 0), a3, voffA);
            PG8_WAIT_V(8); PG8_WAIT_L(0); PG8_BAR; PG8_MMA(1, 0, At, B0); PG8_MMA(1, 1, At, B1); PG8_BAR; PG8_SCHED;
            } else {
            PG8_LDB(B0, 0, 0); PG8_SCHED; PG8_LDA(At, 0, 0); PG8_STAGE(PG8_SA(1, 1), a1 + hstepA, voffA);
            PG8_WAIT_L(8); PG8_BAR; PG8_WAIT_L(0); PG8_MMA(0, 0, At, B0); PG8_BAR; PG8_SCHED;
            PG8_LDB(B1, 0, 1); PG8_STAGE(PG8_SB(0, 0), b2, voffB);
            PG8_BAR; PG8_WAIT_L(0); PG8_MMA(0, 1, At, B1); PG8_BAR;
            PG8_LDA(At, 0, 1); PG8_STAGE(PG8_SA(0, 0), a2, voffA);
            PG8_BAR; PG8_WAIT_L(0); PG8_MMA(1, 0, At, B0); PG8_BAR; PG8_SCHED;
            PG8_STAGE(PG8_SB(0, 1), b2 + hstepB, voffB);
            PG8_WAIT_V(6); PG8_BAR; PG8_MMA(1, 1, At, B1); PG8_BAR;
            PG8_LDB(B0, 1, 0); PG8_SCHED; PG8_LDA(At, 1, 0); PG8_STAGE(PG8_SA(0, 1), a2 + hstepA, voffA);
            PG8_WAIT_L(8); PG8_BAR; PG8_WAIT_L(0); PG8_MMA(0, 0, At, B0); PG8_BAR; PG8_SCHED;
            PG8_LDB(B1, 1, 1); PG8_STAGE(PG8_SB(1, 0), b3, voffB);
            PG8_BAR; PG8_WAIT_L(0); PG8_MMA(0, 1, At, B1); PG8_BAR;
            PG8_LDA(At, 1, 1); PG8_STAGE(PG8_SA(1, 0), a3, voffA);
            PG8_BAR; PG8_WAIT_L(0); PG8_MMA(1, 0, At, B0); PG8_BAR; PG8_SCHED;
            PG8_STAGE(PG8_SB(1, 1), b3 + hstepB, voffB);
            PG8_WAIT_V(6); PG8_BAR; PG8_MMA(1, 1, At, B1); PG8_BAR;
            }
        }
        if constexpr (ALIGN_EPI) { if (wr == 0) PG8_BAR; }
        E(acc, cur, wr, wc, fr, fq);
        if (!has_next) break;
#pragma unroll
        for (int a = 0; a < 2; ++a)
#pragma unroll
            for (int b = 0; b < 2; ++b)
#pragma unroll
                for (int m = 0; m < 4; ++m)
#pragma unroll
                    for (int n = 0; n < 2; ++n) acc[a][b][m][n] = (f32x4){0.f, 0.f, 0.f, 0.f};
        cur = nxt; cA = nA; cB = nB; ++ui;
        if constexpr (ALIGN_EPI) { if (wr == 1) PG8_BAR; }
    }
    PG8_WAIT_V(0);
    if constexpr (!ALIGN_EPI) { if (wr == 0) PG8_BAR; }
    PG8_BAR;
#undef PG8_SA
#undef PG8_SB
#undef PG8_STAGE
#undef PG8_LDA
#undef PG8_LDB
#undef PG8_MMA
#undef PG8_WAIT_V
#undef PG8_WAIT_L
#undef PG8_BAR
#undef PG8_SCHED
}
}
namespace pg8 {
constexpr float LOG2E = 1.4426950408889634f;
__device__ __forceinline__ float sigm(float x) { return __builtin_amdgcn_rcpf(1.f + __expf(-x)); }
__device__ __forceinline__ float gelu_tanh(float x) { const float in = 0.7978845608028654f * (x + 0.044715f * x * x * x); return x * sigm(2.f * in); }
__device__ __forceinline__ u32x4 pack8(const f32x4 a, const f32x4 b) { u32x4 w; w.x = cvt_pk_bf16(a[0], a[1]); w.y = cvt_pk_bf16(a[2], a[3]); w.z = cvt_pk_bf16(b[0], b[1]); w.w = cvt_pk_bf16(b[2], b[3]); return w; }
__device__ __forceinline__ void unpack8(const u32x4 w, f32x4& a, f32x4& b) { a = (f32x4){bf_lo(w.x), bf_hi(w.x), bf_lo(w.y), bf_hi(w.y)}; b = (f32x4){bf_lo(w.z), bf_hi(w.z), bf_lo(w.w), bf_hi(w.w)}; }

struct EpiProj {
    static constexpr bool PERM = true, MIDK = false;
    bf16_t *UEXT, *ZS, *Q, *Kb, *V, *ZA; unsigned char *GS, *GA; const float *qg, *kg;
    __device__ __forceinline__ static void gate8(const f32x4 (&acc)[2][2][4][2], unsigned char* dst, const int colt, const int row0, const int wc, const int fq) {
        const int col0 = colt + wc * 32 + 8 * fq;
#pragma unroll
        for (int ai = 0; ai < 2; ++ai)
#pragma unroll
            for (int m = 0; m < 4; ++m) { unsigned char* rowp = dst + (size_t)(row0 + ai * HALF + m * 16) * 2048 + col0;
#pragma unroll
                for (int bj = 0; bj < 2; ++bj) { u32x2 w = {0u, 0u};
#pragma unroll
                    for (int e = 0; e < 4; ++e) { w.x = __builtin_amdgcn_cvt_pk_u8_f32(fmaxf(sigm(acc[ai][bj][m][0][e]) * 255.f, 1.f), e, w.x);
                                                  w.y = __builtin_amdgcn_cvt_pk_u8_f32(fmaxf(sigm(acc[ai][bj][m][1][e]) * 255.f, 1.f), e, w.y); }
                    *(u32x2*)(rowp + bj * HALF) = w; } }
    }
    template <int KIND  > __device__ __forceinline__ static void plain(const f32x4 (&acc)[2][2][4][2], bf16_t* dst, const int ld, const int colt, const int row0, const int wc, const int fq) {
        const int col0 = colt + wc * 32 + 8 * fq;
#pragma unroll
        for (int ai = 0; ai < 2; ++ai)
#pragma unroll
            for (int m = 0; m < 4; ++m) { bf16_t* rowp = dst + (size_t)(row0 + ai * HALF + m * 16) * ld + col0;
#pragma unroll
                for (int bj = 0; bj < 2; ++bj) { f32x4 v0 = acc[ai][bj][m][0], v1 = acc[ai][bj][m][1];
                    if (KIND != 0) {
#pragma unroll
                        for (int e = 0; e < 4; ++e) { const float s0 = sigm(v0[e]), s1 = sigm(v1[e]); v0[e] = KIND == 1 ? v0[e] * s0 : s0; v1[e] = KIND == 1 ? v1[e] * s1 : s1; } }
                    *(u32x4*)(rowp + bj * HALF) = pack8(v0, v1); } }
    }
    __device__ __forceinline__ void operator()(const f32x4 (&acc)[2][2][4][2], const Unit& u, int wr, int wc, int fr, int fq) const {
        const int pn = u.pn; int row0 = u.pm * BM + wr * 64 + fr; asm volatile("" : "+v"(row0));
        if (pn >= 8 && pn < 16) {
            const bool isq = pn < 12; const float* gg = isq ? qg : kg; bf16_t* dst = isq ? Q : Kb; const float sc = isq ? 0.125f * LOG2E : 1.f;
            const int head = (pn - (isq ? 8 : 12)) * 4 + wc;
            f32x4 gv[2][2];
#pragma unroll
            for (int bj = 0; bj < 2; ++bj)
#pragma unroll
                for (int n = 0; n < 2; ++n) gv[bj][n] = *(const f32x4*)(gg + 32 * bj + 8 * fq + 4 * n) * sc;
#pragma unroll
            for (int ai = 0; ai < 2; ++ai)
#pragma unroll
                for (int m = 0; m < 4; ++m) {
                    float ss = 0.f;
#pragma unroll
                    for (int bj = 0; bj < 2; ++bj)
#pragma unroll
                        for (int n = 0; n < 2; ++n) { const f32x4 x = acc[ai][bj][m][n]; ss += (x[0] * x[0] + x[1] * x[1]) + (x[2] * x[2] + x[3] * x[3]); }
                    ss += __shfl_xor(ss, 16); ss += __shfl_xor(ss, 32);
                    const float rinv = __builtin_amdgcn_rsqf(ss * (1.f / 64.f) + 1e-6f);
                    bf16_t* rowp = dst + (size_t)(row0 + ai * HALF + m * 16) * 1024 + head * 64 + 8 * fq;
#pragma unroll
                    for (int bj = 0; bj < 2; ++bj) *(u32x4*)(rowp + 32 * bj) = pack8(acc[ai][bj][m][0] * rinv * gv[bj][0], acc[ai][bj][m][1] * rinv * gv[bj][1]);
                }
        } else if (pn < 4) {
#pragma unroll
            for (int ai = 0; ai < 2; ++ai)
#pragma unroll
                for (int m = 0; m < 4; ++m) { const int r = row0 + ai * HALF + m * 16;
#pragma unroll
                    for (int bj = 0; bj < 2; ++bj) { const int c = pn * BM + bj * HALF + wc * 32 + 8 * fq, gidx = c >> 4, h0 = c & 15;
                        *(u32x4*)(UEXT + ((size_t)(gidx * 512 + (r >> 5)) * 768 + (r & 31) * 16 + h0)) = pack8(acc[ai][bj][m][0], acc[ai][bj][m][1]); } }
        } else if (pn < 8) { plain<1>(acc, ZS, 1024, (pn - 4) * BM, row0, wc, fq); }
        else if (pn < 20) { plain<0>(acc, V, 1024, (pn - 16) * BM, row0, wc, fq); }
        else if (pn < 24) { plain<1>(acc, ZA, 1024, (pn - 20) * BM, row0, wc, fq); }
        else if (pn < 32) { gate8(acc, GS, (pn - 24) * BM, row0, wc, fq); }
        else { gate8(acc, GA, (pn - 32) * BM, row0, wc, fq); }
    }
};
struct EpiE {
    static constexpr bool PERM = false, MIDK = false;
    float* E;
    __device__ __forceinline__ void operator()(const f32x4 (&acc)[2][2][4][2], const Unit& u, int wr, int wc, int fr, int fq) const {
        int row0 = u.pm * BM + wr * 64 + fr; asm volatile("" : "+v"(row0)); const int col0 = wc * 32 + 4 * fq;
#pragma unroll
        for (int ai = 0; ai < 2; ++ai)
#pragma unroll
            for (int m = 0; m < 4; ++m) { float* rowp = E + (size_t)(row0 + ai * HALF + m * 16) * 256 + col0;
#pragma unroll
                for (int bj = 0; bj < 2; ++bj)
#pragma unroll
                    for (int n = 0; n < 2; ++n) *(f32x4*)(rowp + bj * HALF + n * 16) = acc[ai][bj][m][n]; }
    }
};
struct EpiY {
    static constexpr bool PERM = true, MIDK = false;
    bf16_t* Y;
    __device__ __forceinline__ void operator()(const f32x4 (&acc)[2][2][4][2], const Unit& u, int wr, int wc, int fr, int fq) const {
        const int gidx = u.pm >> 1; int chunk0 = (u.pm & 1) * BM + wr * 64 + fr; asm volatile("" : "+v"(chunk0));
#pragma unroll
        for (int ai = 0; ai < 2; ++ai)
#pragma unroll
            for (int m = 0; m < 4; ++m) { const int chunk = chunk0 + ai * HALF + m * 16;
#pragma unroll
                for (int bj = 0; bj < 2; ++bj) { const int nc = (u.pn & 1) * BM + bj * HALF + wc * 32 + 8 * fq, i = nc >> 4, h0 = nc & 15;
                    f32x4 v0 = acc[ai][bj][m][0], v1 = acc[ai][bj][m][1];
#pragma unroll
                    for (int e = 0; e < 4; ++e) { v0[e] = gelu_tanh(v0[e]); v1[e] = gelu_tanh(v1[e]); }
                    *(u32x4*)(Y + (size_t)(chunk * 32 + i) * 1024 + gidx * 16 + h0) = pack8(v0, v1); } }
    }
};
struct EpiGlu {
    static constexpr bool PERM = true, MIDK = false;
    const bf16_t *Y, *ZS; const float* bias; bf16_t* ACAT;
    __device__ __forceinline__ void operator()(const f32x4 (&acc)[2][2][4][2], const Unit& u, int wr, int wc, int fr, int fq) const {
        int row0 = u.pm * BM + wr * 64 + fr; asm volatile("" : "+v"(row0)); const int col0 = u.pn * BM + wc * 32 + 8 * fq;
        f32x4 bv[2][2];
#pragma unroll
        for (int bj = 0; bj < 2; ++bj) { bv[bj][0] = *(const f32x4*)(bias + col0 + bj * HALF); bv[bj][1] = *(const f32x4*)(bias + col0 + bj * HALF + 4); }
#pragma unroll
        for (int ai = 0; ai < 2; ++ai) {
            u32x4 yw[4][2], zw[4][2];
#pragma unroll
            for (int m = 0; m < 4; ++m) { const size_t r = (size_t)(row0 + ai * HALF + m * 16);
#pragma unroll
                for (int bj = 0; bj < 2; ++bj) { yw[m][bj] = *(const u32x4*)(Y + r * 1024 + col0 + bj * HALF); zw[m][bj] = *(const u32x4*)(ZS + r * 1024 + col0 + bj * HALF); } }
#pragma unroll
            for (int m = 0; m < 4; ++m) { const size_t r = (size_t)(row0 + ai * HALF + m * 16);
#pragma unroll
                for (int bj = 0; bj < 2; ++bj) { const f32x4 b0 = bv[bj][0], b1 = bv[bj][1];
                    f32x4 y0, y1, z0, z1; unpack8(yw[m][bj], y0, y1); unpack8(zw[m][bj], z0, z1);
                    f32x4 v0 = acc[ai][bj][m][0] + b0, v1 = acc[ai][bj][m][1] + b1;
#pragma unroll
                    for (int e = 0; e < 4; ++e) { v0[e] = y0[e] * sigm(v0[e]) * z0[e]; v1[e] = y1[e] * sigm(v1[e]) * z1[e]; }
                    *(u32x4*)(ACAT + r * 2048 + col0 + bj * HALF) = pack8(v0, v1); } }
            asm volatile("" ::: "memory"); }
    }
};
struct EpiMerge {
    static constexpr bool PERM = true, MIDK = true;
    const unsigned char *GS, *GA; bf16_t* MB;
    __device__ __forceinline__ static void ub8(const u32x2 w, f32x4& a, f32x4& b) {
        a = (f32x4){(float)(w.x & 0xffu), (float)((w.x >> 8) & 0xffu), (float)((w.x >> 16) & 0xffu), (float)(w.x >> 24)};
        b = (f32x4){(float)(w.y & 0xffu), (float)((w.y >> 8) & 0xffu), (float)((w.y >> 16) & 0xffu), (float)(w.y >> 24)}; }
    __device__ __forceinline__ void mid(f32x4 (&acc)[2][2][4][2], const Unit& u, int wr, int wc, int fr, int fq) const {
        int row0 = u.pm * BM + wr * 64 + fr; asm volatile("" : "+v"(row0)); const int col0 = u.pn * BM + wc * 32 + 8 * fq;
#pragma unroll
        for (int ai = 0; ai < 2; ++ai) {
            u32x2 sw[4][2], aw[4][2];
#pragma unroll
            for (int m = 0; m < 4; ++m) { const size_t r = (size_t)(row0 + ai * HALF + m * 16);
#pragma unroll
                for (int bj = 0; bj < 2; ++bj) { sw[m][bj] = *(const u32x2*)(GS + r * 2048 + col0 + bj * HALF); aw[m][bj] = *(const u32x2*)(GA + r * 2048 + col0 + bj * HALF); } }
#pragma unroll
            for (int m = 0; m < 4; ++m)
#pragma unroll
                for (int bj = 0; bj < 2; ++bj) { f32x4 s0, s1, a0, a1; ub8(sw[m][bj], s0, s1); ub8(aw[m][bj], a0, a1);
#pragma unroll
                    for (int e = 0; e < 4; ++e) { acc[ai][bj][m][0][e] *= s0[e] * __builtin_amdgcn_rcpf(a0[e]); acc[ai][bj][m][1][e] *= s1[e] * __builtin_amdgcn_rcpf(a1[e]); } }
            asm volatile("" ::: "memory"); }
    }
    __device__ __forceinline__ void operator()(const f32x4 (&acc)[2][2][4][2], const Unit& u, int wr, int wc, int fr, int fq) const {
        int row0 = u.pm * BM + wr * 64 + fr; asm volatile("" : "+v"(row0)); const int col0 = u.pn * BM + wc * 32 + 8 * fq;
        u32x2 aw[2][4][2];
#pragma unroll
        for (int ai = 0; ai < 2; ++ai)
#pragma unroll
            for (int m = 0; m < 4; ++m) { const size_t r = (size_t)(row0 + ai * HALF + m * 16);
#pragma unroll
                for (int bj = 0; bj < 2; ++bj) aw[ai][m][bj] = *(const u32x2*)(GA + r * 2048 + col0 + bj * HALF); }
#pragma unroll
        for (int ai = 0; ai < 2; ++ai)
#pragma unroll
            for (int m = 0; m < 4; ++m) { const size_t r = (size_t)(row0 + ai * HALF + m * 16);
#pragma unroll
                for (int bj = 0; bj < 2; ++bj) { f32x4 a0, a1; ub8(aw[ai][m][bj], a0, a1);
                    *(u32x4*)(MB + r * 2048 + col0 + bj * HALF) = pack8(acc[ai][bj][m][0] * a0 * (1.f / 255.f), acc[ai][bj][m][1] * a1 * (1.f / 255.f)); } }
    }
};
struct EpiOut {
    static constexpr bool PERM = false, MIDK = false;
    const float* X; float* O;
    __device__ __forceinline__ void operator()(const f32x4 (&acc)[2][2][4][2], const Unit& u, int wr, int wc, int fr, int fq) const {
        int row0 = u.pm * BM + wr * 64 + fr; asm volatile("" : "+v"(row0)); const int col0 = u.pn * BM + wc * 32 + 4 * fq;
#pragma unroll
        for (int ai = 0; ai < 2; ++ai) {
            f32x4 xv[4][2][2];
#pragma unroll
            for (int m = 0; m < 4; ++m) { const size_t off = (size_t)(row0 + ai * HALF + m * 16) * 2048 + col0;
#pragma unroll
                for (int bj = 0; bj < 2; ++bj)
#pragma unroll
                    for (int n = 0; n < 2; ++n) xv[m][bj][n] = *(const f32x4*)(X + off + bj * HALF + n * 16); }
#pragma unroll
            for (int m = 0; m < 4; ++m) { const size_t off = (size_t)(row0 + ai * HALF + m * 16) * 2048 + col0;
#pragma unroll
                for (int bj = 0; bj < 2; ++bj)
#pragma unroll
                    for (int n = 0; n < 2; ++n) *(f32x4*)(O + off + bj * HALF + n * 16) = xv[m][bj][n] + acc[ai][bj][m][n]; }
            asm volatile("" ::: "memory"); }
    }
};
}
namespace nat {
typedef unsigned short bf16_t;
typedef short bf16x8 __attribute__((ext_vector_type(8)));
typedef short s16x4 __attribute__((ext_vector_type(4)));
typedef float f32x4 __attribute__((ext_vector_type(4)));
typedef unsigned u32x4 __attribute__((ext_vector_type(4)));
typedef unsigned u32x2 __attribute__((ext_vector_type(2)));
#define NAT_LAS __attribute__((address_space(3)))
constexpr int SLOTB = 8192, KIMG = 0, VIMG = 9 * SLOTB, BIAS_OFF = 18 * SLOTB;
__device__ __forceinline__ s16x4 vtr(unsigned addr) { return __builtin_bit_cast(s16x4, __builtin_amdgcn_ds_read_tr16_b64_v4i16((NAT_LAS s16x4*)addr)); }
__device__ __forceinline__ void glds16(const void* gsrc, unsigned lds_dst) { unsigned keep;
    asm volatile("s_mov_b32 %0, m0\n\ts_mov_b32 m0, %2\n\ts_nop 0\n\tglobal_load_lds_dwordx4 %1, off\n\ts_mov_b32 m0, %0" : "=&s"(keep) : "v"(gsrc), "s"(lds_dst) : "memory"); }
#define NAT_BAR() asm volatile("s_barrier" ::: "memory")
#define NAT_WAITV_BAR(N) asm volatile("s_waitcnt vmcnt(" #N ")\n\ts_barrier" ::: "memory")
__device__ __forceinline__ int clampi(int v, int lo, int hi) { return v < lo ? lo : (v > hi ? hi : v); }

__device__ __forceinline__ void attn_phase(NAT_LAS unsigned char* lds, const bf16_t* Q, const bf16_t* K, const bf16_t* V, const bf16_t* ZA, bf16_t* ACAT,
                                           const float* rel_bias, int rps  , int vcu, int G, const int tid) {
    const int lane = tid & 63, wid = __builtin_amdgcn_readfirstlane(tid >> 6), fr = lane & 15, fq = lane >> 4;
    const int rsel = wid >> 2, qb = wid & 3;
    const int c0 = 16 * qb, w0 = (qb == 0) ? 0 : (qb == 1) ? 8 : (qb == 2) ? 24 : 32;
    NAT_LAS float* biasL = (NAT_LAS float*)(lds + BIAS_OFF);
    const unsigned ldsbase = (unsigned)(size_t)lds;
    const int dcol = lane >> 3, dpos = lane & 7;
    int koff[2][2];
#pragma unroll
    for (int hf = 0; hf < 2; ++hf)
#pragma unroll
        for (int ks = 0; ks < 2; ++ks) { const int col = w0 + 16 * hf + fr; koff[hf][ks] = col * 128 + 16 * ((ks * 4 + fq) ^ ((col >> 1) & 7)); }
    const int vcol = w0 + 4 * fq + (fr >> 2), vx = (vcol >> 1) & 3, vlane = vcol * 128 + 16 * ((fr & 3) >> 1) + 8 * (fr & 1);
    bool selhi[4]; int dcs[4]; unsigned mlo[2], mhi[2];
    { const int cq = c0 + fr; int cs = cq - 8; cs = cs < 0 ? 0 : (cs > 48 ? 48 : cs);
#pragma unroll
      for (int j = 0; j < 4; ++j) { const int clo = w0 + 4 * fq + j; selhi[j] = clo < cs; const int ck = selhi[j] ? clo + 16 : clo; int dc = ck - cq + 15; dc = dc < 0 ? 0 : (dc > 30 ? 30 : dc); dcs[j] = dc; }
#pragma unroll
      for (int q = 0; q < 2; ++q) { mlo[q] = (selhi[2 * q] ? 0u : 0xffffu) | (selhi[2 * q + 1] ? 0u : 0xffff0000u); mhi[q] = ~mlo[q]; } }
    for (int bt = vcu; bt < 256; bt += G) {
        const int h = bt >> 4, rp0 = (bt & 15) * 8;
        const int seq = (2 * rp0) / rps, rl0 = 2 * rp0 - seq * rps, srow = seq * rps;
        const bf16_t* Kh = K + (size_t)srow * 64 * 1024 + h * 64; const bf16_t* Vh = V + (size_t)srow * 64 * 1024 + h * 64;
        {
            const int kr0 = clampi(rl0 - 4, 0, rps - 8), hi = clampi(rl0 - 3, 0, rps - 8) + 8, nr = hi - kr0;
            for (int j = wid; j < nr * 16; j += 8) { const int row = kr0 + (j >> 4), isv = (j >> 3) & 1, c8 = j & 7, col = c8 * 8 + dcol, slot = row % 9;
                const int gch = isv ? (dpos ^ (((col >> 1) & 3) << 1)) : (dpos ^ ((col >> 1) & 7));
                const bf16_t* src = (isv ? Vh : Kh) + (size_t)(row * 64 + col) * 1024 + gch * 8;
                glds16(src, (unsigned)__builtin_amdgcn_readfirstlane((int)(ldsbase + (isv ? VIMG : KIMG) + slot * SLOTB + c8 * 1024))); }
            if (tid < 465) biasL[tid] = rel_bias[h * 465 + tid] * 1.4426950408889634f;
        }
        bf16x8 qn[2];
        { const int qtok = (srow + rl0 + rsel) * 64 + c0 + fr;
#pragma unroll
          for (int ks = 0; ks < 2; ++ks) qn[ks] = *(const bf16x8*)(Q + (size_t)qtok * 1024 + h * 64 + ks * 32 + fq * 8); }
        asm volatile("" :: "v"(qn[0]), "v"(qn[1]));
        asm volatile("s_waitcnt vmcnt(0) lgkmcnt(0)\n\ts_barrier" ::: "memory");
#pragma nounroll
        for (int i = 0; i < 8; ++i) {
            const int rl = rl0 + 2 * i;
            const int kr0 = clampi(rl - 4, 0, rps - 8), kr1 = clampi(rl - 3, 0, rps - 8), hi = kr1 + 8;
            const int hin = clampi(rl - 1, 0, rps - 8) + 8;
            const int r = rl + rsel, krow0 = rsel ? kr1 : kr0;
            const int qtok = (srow + r) * 64 + c0 + fr;
            bf16x8 qf[2]; qf[0] = qn[0]; qf[1] = qn[1];
            u32x2 zw[4];
            { const bf16_t* zp = ZA + (size_t)qtok * 1024 + h * 64 + 4 * fq;
#pragma unroll
              for (int nt = 0; nt < 4; ++nt) zw[nt] = *(const u32x2*)(zp + 16 * nt);
              const int qtn = i < 7 ? qtok + 128 : qtok;
#pragma unroll
              for (int ks = 0; ks < 2; ++ks) qn[ks] = *(const bf16x8*)(Q + (size_t)qtn * 1024 + h * 64 + ks * 32 + fq * 8); }
            f32x4 acc[16];
            { int slot = krow0 % 9;
#pragma unroll
              for (int n2 = 0; n2 < 8; ++n2) { const NAT_LAS unsigned char* kp = lds + KIMG + slot * SLOTB;
#pragma unroll
                  for (int hf = 0; hf < 2; ++hf) { const int n = 2 * n2 + hf;
                      const bf16x8 k0 = *(const NAT_LAS bf16x8*)(kp + koff[hf][0]), k1 = *(const NAT_LAS bf16x8*)(kp + koff[hf][1]);
                      acc[n] = __builtin_amdgcn_mfma_f32_16x16x32_bf16(k0, qf[0], (f32x4){0.f, 0.f, 0.f, 0.f}, 0, 0, 0);
                      acc[n] = __builtin_amdgcn_mfma_f32_16x16x32_bf16(k1, qf[1], acc[n], 0, 0, 0); }
                  slot = slot == 8 ? 0 : slot + 1; } }
            asm volatile("s_waitcnt lgkmcnt(0)\n\ts_barrier" ::: "memory");
            if (i < 7) { int row = hi + rsel; row = row > hin - 1 ? hin - 1 : row; const int slot = row % 9;
#pragma unroll
                for (int e = 0; e < 2; ++e) { const int c8 = qb * 2 + e, col = c8 * 8 + dcol, gch = dpos ^ ((col >> 1) & 7);
                    glds16(Kh + (size_t)(row * 64 + col) * 1024 + gch * 8, (unsigned)__builtin_amdgcn_readfirstlane((int)(ldsbase + KIMG + slot * SLOTB + c8 * 1024))); } }
            float sc[8][4];
            { float bvv[8][4];
#pragma unroll
              for (int n2 = 0; n2 < 8; ++n2) { const NAT_LAS float* brow = biasL + (krow0 + n2 - r + 7) * 31;
#pragma unroll
                  for (int j = 0; j < 4; ++j) bvv[n2][j] = brow[dcs[j]]; }
              asm volatile("s_waitcnt lgkmcnt(0)" ::: "memory");
#pragma unroll
              for (int n2 = 0; n2 < 8; ++n2)
#pragma unroll
                  for (int j = 0; j < 4; ++j) sc[n2][j] = (selhi[j] ? acc[2 * n2 + 1][j] : acc[2 * n2][j]) + bvv[n2][j]; }
            float mx = sc[0][0];
#pragma unroll
            for (int n2 = 0; n2 < 8; ++n2)
#pragma unroll
                for (int j = 0; j < 4; ++j) mx = fmaxf(mx, sc[n2][j]);
            mx = fmaxf(mx, __shfl_xor(mx, 16)); mx = fmaxf(mx, __shfl_xor(mx, 32));
            float l0 = 0.f, l1 = 0.f;
#pragma unroll
            for (int n2 = 0; n2 < 8; ++n2) {
#pragma unroll
                for (int j = 0; j < 4; ++j) sc[n2][j] = __builtin_amdgcn_exp2f(sc[n2][j] - mx);
                l0 += sc[n2][0] + sc[n2][1]; l1 += sc[n2][2] + sc[n2][3]; }
            float l = l0 + l1;
            l += __shfl_xor(l, 16); l += __shfl_xor(l, 32);
            const float linv = __builtin_amdgcn_rcpf(l);
            bf16x8 pf[8];
#pragma unroll
            for (int s8 = 0; s8 < 8; ++s8) { const unsigned w0p = pg8::cvt_pk_bf16(sc[s8][0], sc[s8][1]), w1p = pg8::cvt_pk_bf16(sc[s8][2], sc[s8][3]);
                u32x4 w; w.x = w0p & mlo[0]; w.y = w1p & mlo[1]; w.z = w0p & mhi[0]; w.w = w1p & mhi[1]; pf[s8] = __builtin_bit_cast(bf16x8, w); }
            asm volatile("s_waitcnt vmcnt(2) lgkmcnt(0)\n\ts_barrier" ::: "memory");
            f32x4 o[4];
#pragma unroll
            for (int nt = 0; nt < 4; ++nt) o[nt] = (f32x4){0.f, 0.f, 0.f, 0.f};
            { int slot = krow0 % 9;
#pragma unroll
              for (int s8 = 0; s8 < 8; ++s8) { const unsigned vb = ldsbase + VIMG + slot * SLOTB + vlane;
#pragma unroll
                  for (int nt = 0; nt < 4; ++nt) {
                      const s16x4 lo = vtr(vb + (unsigned)(32 * (nt ^ vx)));
                      const s16x4 hi2 = vtr(vb + (unsigned)(2048 + 32 * (nt ^ vx)));
                      const bf16x8 vf = (bf16x8){lo[0], lo[1], lo[2], lo[3], hi2[0], hi2[1], hi2[2], hi2[3]};
                      o[nt] = __builtin_amdgcn_mfma_f32_16x16x32_bf16(vf, pf[s8], o[nt], 0, 0, 0); }
                  slot = slot == 8 ? 0 : slot + 1; } }
            asm volatile("" :: "v"(zw[0]), "v"(zw[1]), "v"(zw[2]), "v"(zw[3]), "v"(qn[0]), "v"(qn[1]));
            asm volatile("s_waitcnt vmcnt(0) lgkmcnt(0)\n\ts_barrier" ::: "memory");
            if (i < 7) { int row = hi + rsel; row = row > hin - 1 ? hin - 1 : row; const int slot = row % 9;
#pragma unroll
                for (int e = 0; e < 2; ++e) { const int c8 = qb * 2 + e, col = c8 * 8 + dcol, gch = dpos ^ (((col >> 1) & 3) << 1);
                    glds16(Vh + (size_t)(row * 64 + col) * 1024 + gch * 8, (unsigned)__builtin_amdgcn_readfirstlane((int)(ldsbase + VIMG + slot * SLOTB + c8 * 1024))); } }
            { bf16_t* op = ACAT + (size_t)qtok * 2048 + 1024 + h * 64 + 4 * fq;
#pragma unroll
              for (int nt = 0; nt < 4; ++nt) { u32x2 w; w.x = pg8::cvt_pk_bf16(o[nt][0] * linv * pg8::bf_lo(zw[nt].x), o[nt][1] * linv * pg8::bf_hi(zw[nt].x));
                  w.y = pg8::cvt_pk_bf16(o[nt][2] * linv * pg8::bf_lo(zw[nt].y), o[nt][3] * linv * pg8::bf_hi(zw[nt].y));
                  *(u32x2*)(op + 16 * nt) = w; } }
        }
        asm volatile("s_waitcnt vmcnt(0) lgkmcnt(0)\n\ts_barrier" ::: "memory");
    }
}
}
namespace misc {
typedef unsigned short bf16_t;
typedef float f32x4 __attribute__((ext_vector_type(4)));
typedef float f32x2 __attribute__((ext_vector_type(2)));
typedef unsigned u32x4 __attribute__((ext_vector_type(4)));
typedef unsigned u32x2 __attribute__((ext_vector_type(2)));
#define MISC_LAS __attribute__((address_space(3)))
#define LDS_WAIT() asm volatile("s_waitcnt lgkmcnt(0)" ::: "memory")
__device__ __forceinline__ unsigned f2bf(float f) { unsigned u = __builtin_bit_cast(unsigned, f); return (u + 0x7fffu + ((u >> 16) & 1u)) >> 16; }
__device__ __forceinline__ unsigned pk2(float lo, float hi) { return f2bf(lo) | (f2bf(hi) << 16); }
__device__ __forceinline__ float wave_sum(float v) {
#pragma unroll
    for (int o = 1; o < 64; o <<= 1) v += __shfl_xor(v, o);
    return v;
}
__device__ __forceinline__ void transpose_item(const float* W, int N, bf16_t* WT, int ldt, int koff, int drow, MISC_LAS float* scr, int k0, int n0, int lane) {
    float v[32];
#pragma unroll
    for (int i = 0; i < 32; ++i) { const int kk = 2 * i + (lane >> 5); v[i] = W[(size_t)(k0 + kk) * N + n0 + (lane & 31)]; }
#pragma unroll
    for (int i = 0; i < 32; ++i) { const int kk = 2 * i + (lane >> 5); scr[kk * 33 + (lane & 31)] = v[i]; }
    LDS_WAIT(); asm volatile("" ::: "memory");
    const int c = lane & 7;
#pragma unroll
    for (int j = 0; j < 4; ++j) { const int n = (lane >> 3) + 8 * j; const MISC_LAS float* s = scr + (8 * c) * 33 + n;
        u32x4 o; o.x = pk2(s[0 * 33], s[1 * 33]); o.y = pk2(s[2 * 33], s[3 * 33]); o.z = pk2(s[4 * 33], s[5 * 33]); o.w = pk2(s[6 * 33], s[7 * 33]);
        *(u32x4*)(WT + (size_t)(drow + n) * ldt + koff + k0 + 8 * c) = o; }
    LDS_WAIT(); asm volatile("" ::: "memory");
}
__device__ __forceinline__ void rms_rows(const float* x, const float* gam, bf16_t* o, int m0, int stride, int nrows, int lane) {
    const f32x4* gr = (const f32x4*)gam + lane; f32x4 gg[8];
#pragma unroll
    for (int j = 0; j < 8; ++j) gg[j] = gr[64 * j];
    if (m0 >= nrows) return;
    f32x4 v[8];
    { const f32x4* xr = (const f32x4*)(x + (size_t)m0 * 2048) + lane;
#pragma unroll
      for (int j = 0; j < 8; ++j) v[j] = xr[64 * j]; }
    for (int m = m0; m < nrows; m += stride) {
        float s = 0.f;
#pragma unroll
        for (int j = 0; j < 8; ++j) s += (v[j].x * v[j].x + v[j].y * v[j].y) + (v[j].z * v[j].z + v[j].w * v[j].w);
        const float rs = __builtin_amdgcn_rsqf(wave_sum(s) * (1.f / 2048.f) + 1e-6f);
        u32x2 w[8];
#pragma unroll
        for (int j = 0; j < 8; ++j) { w[j].x = pk2(v[j].x * rs * gg[j].x, v[j].y * rs * gg[j].y); w[j].y = pk2(v[j].z * rs * gg[j].z, v[j].w * rs * gg[j].w); }
        const int mn = m + stride;
        if (mn < nrows) { const f32x4* xr = (const f32x4*)(x + (size_t)mn * 2048) + lane;
#pragma unroll
            for (int j = 0; j < 8; ++j) v[j] = xr[64 * j]; }
        u32x2* o8 = (u32x2*)(o + (size_t)m * 2048) + lane;
#pragma unroll
        for (int j = 0; j < 8; ++j) o8[64 * j] = w[j];
    }
}
__device__ __forceinline__ float exp_small(float x) {
    float t = 1.f, s = 1.f;
#pragma nounroll
    for (int k = 1; k <= 11; ++k) { t *= x * __builtin_amdgcn_rcpf((float)k); s += t; }
    return s;
}
__device__ __forceinline__ float exp_f(float x) {
    float r = exp_small(x * 0.0625f);
    r *= r; r *= r; r *= r; r *= r; return r;
}
__device__ __forceinline__ void sincos_f(float a, float& s, float& c) {
    const float k = __builtin_rintf(a * 0.15915494309189535f);
    float r = __builtin_fmaf(-k, 6.28318548202514648f, a); r = __builtin_fmaf(-k, -1.7484556000744883e-07f, r); r *= 0.25f;
    const float r2 = r * r; float ts = r, tc = 1.f, ss = r, cc = 1.f;
#pragma nounroll
    for (int i = 1; i <= 7; ++i) { const float e = (float)(2 * i); tc *= -r2 * __builtin_amdgcn_rcpf((e - 1.f) * e); ts *= -r2 * __builtin_amdgcn_rcpf(e * (e + 1.f)); cc += tc; ss += ts; }
#pragma nounroll
    for (int i = 0; i < 2; ++i) { const float c2 = cc * cc - ss * ss, s2 = 2.f * ss * cc; cc = c2; ss = s2; }
    s = ss; c = cc;
}
constexpr int SM_POW = 0;
constexpr int SM_FC = SM_POW + 2 * 33 * 65 * 2;
constexpr int SM_BRE = SM_FC + 256;
constexpr int SM_BIM = SM_BRE + 2048;
constexpr int SM_CC = SM_BIM + 2048;
constexpr int SM_TB = SM_CC + 2 * 16 * 65 * 2;
constexpr int TBS = 264;
constexpr int SM_END = SM_TB + 63 * TBS / 2;
static_assert(SM_END * 4 <= 140 * 1024, "SSM builder LDS");

__device__ __forceinline__ void ssm_build(MISC_LAS float* L, int g, const float* a_re, const float* a_im, const float* log_dt, const float* b_re, const float* b_im,
                                          const float* c_re, const float* c_im, const float* dsk, bf16_t* SSMY, bf16_t* SSME, float* AT, int tid, const int stop_at = 9) {
    MISC_LAS f32x2* POW = (MISC_LAS f32x2*)(L + SM_POW); MISC_LAS f32x2* FC = (MISC_LAS f32x2*)(L + SM_FC);
    MISC_LAS float* BRE = L + SM_BRE; MISC_LAS float* BIM = L + SM_BIM; MISC_LAS f32x2* CC = (MISC_LAS f32x2*)(L + SM_CC); MISC_LAS bf16_t* TB = (MISC_LAS bf16_t*)(L + SM_TB);
    if (tid < 128) { const int d = tid >> 6, p = tid & 63;
        float lre = a_re[(d * 64 + g) * 64 + p]; lre = lre < -1e-4f ? lre : -1e-4f; const float lim = a_im[(d * 64 + g) * 64 + p];
        const float dt = exp_f(log_dt[d * 64 + g]);
        const float mag = exp_f(lre * dt); float sn, cs; sincos_f(lim * dt, sn, cs);
        const float zr = mag * cs, zi = mag * sn, rden = 1.f / (lre * lre + lim * lim);
        FC[d * 64 + p] = (f32x2){((zr - 1.f) * lre + zi * lim) * rden, (zi * lre - (zr - 1.f) * lim) * rden};
        float pr = 1.f, pi = 0.f;
#pragma nounroll
        for (int j = 0; j <= 32; ++j) { POW[(d * 33 + j) * 65 + p] = (f32x2){pr, pi}; const float nr = pr * zr - pi * zi, ni = pr * zi + pi * zr; pr = nr; pi = ni; }
        const f32x2 a32 = POW[(d * 33 + 32) * 65 + p]; *(f32x2*)(AT + ((g * 2 + d) * 64 + p) * 2) = a32;
    }
    __syncthreads();
    if (stop_at == 1) return;
    { float brv[4], biv[4], crv[4], civ[4];
#pragma unroll
      for (int it = 0; it < 4; ++it) { const int idx = tid + 512 * it;
          { const int d = idx >> 10, p = (idx >> 4) & 63, h = idx & 15; const size_t gi = ((size_t)(d * 64 + g) * 64 + p) * 16 + h; brv[it] = b_re[gi]; biv[it] = b_im[gi]; }
          { const int d = idx >> 10, hp = (idx >> 6) & 15, p = idx & 63; const size_t gi = ((size_t)(d * 64 + g) * 16 + hp) * 64 + p; crv[it] = c_re[gi]; civ[it] = c_im[gi]; } }
#pragma unroll
      for (int it = 0; it < 4; ++it) { const int idx = tid + 512 * it;
          { const int d = idx >> 10, p = (idx >> 4) & 63; const f32x2 f = FC[d * 64 + p]; BRE[idx] = f.x * brv[it] - f.y * biv[it]; BIM[idx] = f.x * biv[it] + f.y * brv[it]; }
          { const int d = idx >> 10, hp = (idx >> 6) & 15, p = idx & 63; CC[(d * 16 + hp) * 65 + p] = (f32x2){crv[it], civ[it]}; } } }
    __syncthreads();
    { const int j = (tid >> 4) & 31, hp = tid & 15; float a[2][16];
#pragma unroll
      for (int d = 0; d < 2; ++d) {
#pragma unroll
        for (int h = 0; h < 16; ++h) a[d][h] = 0.f;
        for (int p = 0; p < 64; ++p) { const f32x2 c = CC[(d * 16 + hp) * 65 + p], w = POW[(d * 33 + j) * 65 + p]; const float cpr = c.x * w.x - c.y * w.y, cpi = c.x * w.y + c.y * w.x;
            const MISC_LAS f32x4* br = (const MISC_LAS f32x4*)(BRE + (d * 64 + p) * 16); const MISC_LAS f32x4* bi = (const MISC_LAS f32x4*)(BIM + (d * 64 + p) * 16);
#pragma unroll
            for (int q = 0; q < 4; ++q) { const f32x4 r4 = br[q], i4 = bi[q];
#pragma unroll
                for (int e = 0; e < 4; ++e) a[d][4 * q + e] += cpr * r4[e] - cpi * i4[e]; } } }
      if (j == 0) { const float dd = dsk[g * 16 + hp];
#pragma unroll
          for (int h = 0; h < 16; h += 2) *(MISC_LAS unsigned*)(TB + 31 * TBS + hp * 16 + h) = pk2(a[0][h] + a[1][h] + (h == hp ? dd : 0.f), a[0][h + 1] + a[1][h + 1] + (h + 1 == hp ? dd : 0.f));
      } else {
#pragma unroll
          for (int h = 0; h < 16; h += 2) { *(MISC_LAS unsigned*)(TB + (31 + j) * TBS + hp * 16 + h) = pk2(a[0][h], a[0][h + 1]); *(MISC_LAS unsigned*)(TB + (31 - j) * TBS + hp * 16 + h) = pk2(a[1][h], a[1][h + 1]); } }
    }
    __syncthreads();
    if (stop_at == 2) return;
    bf16_t* Yg = SSMY + (size_t)g * 512 * 768;
    for (int idx = tid; idx < 512 * 96; idx += 512) { const int n = idx / 96, kc = idx - n * 96, i = n >> 4, hp = n & 15; float v[8];
        if (kc < 64) { const int j = kc >> 1, h0 = (kc & 1) * 8;
            *(u32x4*)(Yg + (size_t)n * 768 + kc * 8) = *(const MISC_LAS u32x4*)(TB + (31 + i - j) * TBS + hp * 16 + h0); continue;
        } else { const int kk = (kc - 64) * 8, d = kk >> 7, ri = (kk >> 6) & 1, p0 = kk & 63, jj = d == 0 ? i + 1 : 32 - i;
#pragma unroll
            for (int e = 0; e < 8; ++e) { const f32x2 c = CC[(d * 16 + hp) * 65 + p0 + e], w = POW[(d * 33 + jj) * 65 + p0 + e]; v[e] = ri ? -(c.x * w.y + c.y * w.x) : (c.x * w.x - c.y * w.y); } }
        u32x4 o; o.x = pk2(v[0], v[1]); o.y = pk2(v[2], v[3]); o.z = pk2(v[4], v[5]); o.w = pk2(v[6], v[7]);
        *(u32x4*)(Yg + (size_t)n * 768 + kc * 8) = o; }
    bf16_t* Eg = SSME + (size_t)g * 256 * 512;
    for (int idx = tid; idx < 256 * 64; idx += 512) { const int n = idx >> 6, kc = idx & 63, d = n >> 7, ri = (n >> 6) & 1, p = n & 63, j = kc >> 1, h0 = (kc & 1) * 8, jj = d == 0 ? 31 - j : j;
        const f32x2 w = POW[(d * 33 + jj) * 65 + p]; float v[8];
#pragma unroll
        for (int e = 0; e < 8; ++e) { const float br = BRE[(d * 64 + p) * 16 + h0 + e], bi = BIM[(d * 64 + p) * 16 + h0 + e]; v[e] = ri ? (w.x * bi + w.y * br) : (w.x * br - w.y * bi); }
        u32x4 o; o.x = pk2(v[0], v[1]); o.y = pk2(v[2], v[3]); o.z = pk2(v[4], v[5]); o.w = pk2(v[6], v[7]);
        *(u32x4*)(Eg + (size_t)n * 512 + kc * 8) = o; }
    __syncthreads();
}
__device__ __forceinline__ void rec_one(const float* __restrict__ E, bf16_t* __restrict__ UEXT, const float* __restrict__ AT, int seq, int g, int d, int nc, int lane) {
    const f32x2 at = *(const f32x2*)(AT + ((g * 2 + d) * 64 + lane) * 2);
    float sr = 0.f, si = 0.f;
    const int cb = seq * nc;
#pragma unroll 8
    for (int q = 0; q < nc; ++q) { const int c = cb + (d == 0 ? q : nc - 1 - q);
        const float er = E[((size_t)(g * 512 + c)) * 256 + d * 128 + lane], ei = E[((size_t)(g * 512 + c)) * 256 + d * 128 + 64 + lane];
        bf16_t* up = UEXT + ((size_t)(g * 512 + c)) * 768 + 512 + d * 128 + lane;
        up[0] = (bf16_t)f2bf(sr); up[64] = (bf16_t)f2bf(si);
        const float nr = at.x * sr - at.y * si + er, ni = at.x * si + at.y * sr + ei; sr = nr; si = ni; }
}
__device__ __forceinline__ void rec_phase(const float* __restrict__ E, bf16_t* __restrict__ UEXT, const float* __restrict__ AT, int nseq, int nc, int gw, int NGW, int lane) {
    for (int task = gw; task < nseq * 128; task += NGW) rec_one(E, UEXT, AT, task >> 7, (task >> 1) & 63, task & 1, nc, lane);
}
}
#define XB_TMO      128
#define XB_XCNT(j)  (256  + 64 * (j))
#define XB_XSUB(j)  (1280 + 64 * (j))
#define XB_XGEN(j)  (2304 + 64 * (j))
#define XB_TOP      3328
#define XB_TOPGEN   3392
#define XCD_BAR_WORDS 3456
#define XB_SPIN_CAP (1u << 18)
#define XB_LAS __attribute__((address_space(3)))
__device__ __forceinline__ unsigned xb_ld(unsigned* p)              { return __hip_atomic_load(p, __ATOMIC_RELAXED, __HIP_MEMORY_SCOPE_AGENT); }
__device__ __forceinline__ unsigned xb_add(unsigned* p, unsigned v) { return __hip_atomic_fetch_add(p, v, __ATOMIC_RELAXED, __HIP_MEMORY_SCOPE_AGENT); }
__device__ __forceinline__ unsigned xb_xcc_id() { return (unsigned)__builtin_amdgcn_s_getreg((3 << 11) | 20) & 0xFu; }
#define XB_SPIN(cond, bar) do { unsigned _sp = 0; while (cond) { __builtin_amdgcn_s_sleep(1); \
    if ((++_sp & 255u) == 0u) { if (xb_ld(&(bar)[XB_TMO])) break; if (_sp > XB_SPIN_CAP) { atomicAdd(&(bar)[XB_TMO], 1u); break; } } } } while (0)
struct XcdBarrier { unsigned* bar; unsigned x; volatile XB_LAS unsigned* st; };
__device__ __forceinline__ XcdBarrier xcd_barrier_post(unsigned* bar, volatile XB_LAS unsigned* st) {
    XcdBarrier b; b.bar = bar; b.x = xb_xcc_id(); b.st = st;
    if (threadIdx.x == 0) (void)xb_add(&bar[XB_XCNT(b.x)], 1u);
    return b;
}
__device__ __forceinline__ void xcd_barrier_complete(unsigned* bar, unsigned x, unsigned& nloc, unsigned& nx) {
    const unsigned G = gridDim.x * gridDim.y * gridDim.z;
    unsigned sum, cnt, mine, sp = 0u;
    for (;;) {
        sum = 0u; cnt = 0u; mine = 0u;
#pragma unroll
        for (unsigned j = 0; j < 16; ++j) { const unsigned c = xb_ld(&bar[XB_XCNT(j)]); sum += c; cnt += (c > 0u) ? 1u : 0u; mine = (j == x) ? c : mine; }
        if (sum == G) break;
        __builtin_amdgcn_s_sleep(1);
        if ((++sp & 255u) == 0u) { if (xb_ld(&bar[XB_TMO])) break; if (sp > XB_SPIN_CAP) { atomicAdd(&bar[XB_TMO], 1u); break; } }
    }
    nloc = mine > 0u ? mine : 1u; nx = cnt > 0u ? cnt : 1u;
}
__device__ __forceinline__ void xcd_barrier(const XcdBarrier& b) {
    asm volatile("s_waitcnt vmcnt(0)" ::: "memory");
    __syncthreads();
    if (threadIdx.x == 0) {
        unsigned* bar = b.bar;
        __builtin_amdgcn_s_waitcnt(0);
        unsigned nloc = b.st[0], nx = b.st[1];
        if (nloc == 0u) { xcd_barrier_complete(bar, b.x, nloc, nx); b.st[0] = nloc; b.st[1] = nx; }
        const unsigned old = xb_add(&bar[XB_XSUB(b.x)], 1u);
        const unsigned gen = old / nloc;
        if (old + 1u == (gen + 1u) * nloc) {
            __builtin_amdgcn_fence(__ATOMIC_RELEASE, "agent");
            asm volatile("s_waitcnt vmcnt(0)" ::: "memory");
            const unsigned og = xb_add(&bar[XB_TOP], 1u);
            const unsigned tg = og / nx;
            if (og + 1u == (tg + 1u) * nx) xb_add(&bar[XB_TOPGEN], 1u);
            else XB_SPIN(xb_ld(&bar[XB_TOPGEN]) == tg, bar);
            __builtin_amdgcn_fence(__ATOMIC_ACQUIRE, "agent");
            xb_add(&bar[XB_XGEN(b.x)], 1u);
            asm volatile("s_waitcnt vmcnt(0)" ::: "memory");
        } else {
            XB_SPIN(xb_ld(&bar[XB_XGEN(b.x)]) == gen, bar);
            __builtin_amdgcn_fence(__ATOMIC_ACQUIRE, "agent");
            asm volatile("s_waitcnt vmcnt(0)" ::: "memory");
        }
    }
    __syncthreads();
}
#ifndef PH_MASK
#define PH_MASK 0xff
#endif
#define HAS(k) (((PH_MASK) >> (k)) & 1)
#ifndef SYNC_REPS
#define SYNC_REPS 1
#endif
#ifndef DUP_SKIP_SSM
#define DUP_SKIP_SSM 0
#endif
#ifndef G1_WGM
#define G1_WGM 8
#endif
#ifndef G1_ALIGN
#define G1_ALIGN true
#endif
#ifndef G1_SP2
#define G1_SP2 true
#endif
#ifndef DUP_MASK
#define DUP_MASK 0
#endif
#ifndef MK_MULTI
#define MK_MULTI 0
#endif
typedef unsigned short bf16;
constexpr size_t MiB = 1u << 20;
constexpr int MP = 16384;
constexpr size_t WS_WIN = 0, WS_WGLU = 40 * MiB, WS_WMRG = 42 * MiB, WS_WOUT = 50 * MiB, WS_SSMY = 58 * MiB, WS_SSME = 106 * MiB, WS_AT = 122 * MiB,
                 WS_H = 123 * MiB  , WS_UEXT = 187 * MiB  , WS_ZS = 235 * MiB, WS_Q = 267 * MiB, WS_K = 299 * MiB, WS_V = 331 * MiB,
                 WS_ZA = 363 * MiB, WS_Y = 395 * MiB, WS_E = 427 * MiB, WS_END = 459 * MiB;
constexpr int LDS_BYTES = 147456 + 2048 + 256;
constexpr size_t WS_BAR = WS_END, WS_BAR_BYTES = 16384;
constexpr int N_PHASES = 15;
extern "C" __device__ void __ockl_grid_sync(void);

constexpr int I_IN = 32 * 320, I_GLU = 16 * 32, I_BS = 16 * 64, I_OUT = 32 * 64, NITEMS = I_IN + I_GLU + 2 * I_BS + I_OUT;
__device__ __forceinline__ void weight_item(int r, const float* w_in, const float* w_glu, const float* w_bs, const float* w_ba, const float* w_out,
                                            unsigned short* WIN, unsigned short* WGLU, unsigned short* WMRG, unsigned short* WOUT, MISC_LAS float* scr, int lane) {
    if (r < I_IN) { const int kb = r / 320, nb = r % 320, n0 = nb * 32; int drow = n0;
        if (n0 >= 2048 && n0 < 4096) drow = (n0 & ~255) + 128 * ((n0 >> 5) & 1) + 32 * ((n0 >> 6) & 3);
        misc::transpose_item(w_in, 10240, WIN, 2048, 0, drow, scr, kb * 64, n0, lane); return; } r -= I_IN;
    if (r < I_GLU) { misc::transpose_item(w_glu, 1024, WGLU, 1024, 0, (r % 32) * 32, scr, (r / 32) * 64, (r % 32) * 32, lane); return; } r -= I_GLU;
    if (r < I_BS) { misc::transpose_item(w_bs, 2048, WMRG, 2048, 0, (r % 64) * 32, scr, (r / 64) * 64, (r % 64) * 32, lane); return; } r -= I_BS;
    if (r < I_BS) { misc::transpose_item(w_ba, 2048, WMRG, 2048, 1024, (r % 64) * 32, scr, (r / 64) * 64, (r % 64) * 32, lane); return; } r -= I_BS;
    misc::transpose_item(w_out, 2048, WOUT, 2048, 0, (r % 64) * 32, scr, (r / 64) * 64, (r % 64) * 32, lane);
}

struct Args { const float* in[20]; float* out; unsigned char* ws; int ph_lo, ph_hi; };

__global__ void __launch_bounds__(512, 2) hybrid_fwd(Args args) {
    extern __shared__ __attribute__((aligned(16))) unsigned char lds_raw[];
    PG8_LAS unsigned char* lds = (PG8_LAS unsigned char*)lds_raw;
#if !MK_MULTI
    { volatile XB_LAS unsigned* st0 = (volatile XB_LAS unsigned*)((PG8_LAS unsigned char*)lds_raw + (LDS_BYTES - 64)); if (threadIdx.x < 2) st0[threadIdx.x] = 0u; }
    __syncthreads();
    XcdBarrier xbar; xbar.bar = (unsigned*)(args.ws + WS_BAR); xbar.x = xb_xcc_id(); xbar.st = (volatile XB_LAS unsigned*)((PG8_LAS unsigned char*)lds_raw + (LDS_BYTES - 64));
    if (args.ph_lo == 0 && blockIdx.x == 0) { for (int w = threadIdx.x; w < XCD_BAR_WORDS; w += 512) xbar.bar[w] = 0u; }
#endif
    const int G = gridDim.x, bx = blockIdx.x, vcu = (G % 8 == 0) ? (bx % 8) * (G / 8) + bx / 8 : bx;
    bool rep = false, posted = false;
#pragma nounroll
    for (int ph = args.ph_lo; ph < args.ph_hi; ) {
    if (!MK_MULTI && G == 256 && ph != 0 && ((ph - 1) % 7) == 2) { ++ph; continue; }
    int tid = threadIdx.x; asm volatile("" : "+v"(tid));
    size_t zoff = 0; asm volatile("" : "+s"(zoff));
    unsigned char* ws = args.ws + zoff; float* outb = args.out + zoff;
    const int lane = tid & 63, wave = __builtin_amdgcn_readfirstlane(tid >> 6);
    bf16* WIN = (bf16*)(ws + WS_WIN); bf16* WGLU = (bf16*)(ws + WS_WGLU); bf16* WMRG = (bf16*)(ws + WS_WMRG); bf16* WOUT = (bf16*)(ws + WS_WOUT);
    bf16* SSMY = (bf16*)(ws + WS_SSMY); bf16* SSME = (bf16*)(ws + WS_SSME); float* AT = (float*)(ws + WS_AT);
    bf16* HB = (bf16*)(ws + WS_H); bf16* ACAT = HB; bf16* UEXT = (bf16*)(ws + WS_UEXT); bf16* MBUF = UEXT; bf16* ZS = (bf16*)(ws + WS_ZS);
    bf16* QB = (bf16*)(ws + WS_Q); bf16* KB = (bf16*)(ws + WS_K); bf16* VB = (bf16*)(ws + WS_V); bf16* ZA = (bf16*)(ws + WS_ZA); bf16* YB = (bf16*)(ws + WS_Y);
    float* EB = (float*)(ws + WS_E);
        if (ph == 0) { if (HAS(0)) {
            const int nssm = G > 64 ? 64 : 0;
            if (bx < nssm) {
                for (int g = bx; g < 64 && !(DUP_SKIP_SSM == 1 && rep); g += nssm)
                    misc::ssm_build((MISC_LAS float*)lds, g, args.in[4], args.in[5], args.in[6], args.in[7], args.in[8], args.in[9], args.in[10], args.in[11], SSMY, SSME, AT, tid, (DUP_SKIP_SSM > 1 && rep) ? DUP_SKIP_SSM - 1 : 9);
            } else {
                MISC_LAS float* scr = (MISC_LAS float*)(lds + wave * 16384);
                const int gw = (bx - nssm) * 8 + wave, NGW = (G - nssm) * 8;
                const int nearly = (G == 256) ? I_IN : NITEMS;
                for (int it = gw; it < nearly; it += NGW) weight_item(it, args.in[3], args.in[12], args.in[17], args.in[18], args.in[19], WIN, WGLU, WMRG, WOUT, scr, lane);
                misc::rms_rows(args.in[0], args.in[2], HB, gw, NGW, MP, lane);
                { bf16* HB1 = (bf16*)((unsigned char*)outb + 192 * MiB);
                  misc::rms_rows(args.in[1], args.in[2], HB1, gw, NGW, MP, lane); }
            }
            }
            __syncthreads();
        } else {
            const int p = (ph - 1) / 7, s = (ph - 1) % 7;
            const float* xp = args.in[p]; float* outp = outb + (size_t)p * MP * 2048;
            unsigned char* GS = (unsigned char*)outp; unsigned char* GA = GS + (size_t)MP * 2048;
            if (s == 0) { if (HAS(1)) {
                pg8::Gemm g{p == 0 ? HB : (bf16*)((unsigned char*)outb + 192 * MiB), WIN, 2048, 2048, 2048}; pg8::StaticOrder S; S.init(MP, 10240, G, bx, G1_WGM);
                pg8::EpiProj E{UEXT, ZS, QB, KB, VB, ZA, GS, GA, args.in[14], args.in[15]};
                pg8::gemm_phase<pg8::EpiProj, pg8::StaticOrder, G1_ALIGN, G1_SP2>(lds, g, S, E, tid);
            } } else if (s == 1) { if (HAS(2)) {
                nat::attn_phase(lds, QB, KB, VB, ZA, ACAT, args.in[16], p == 0 ? 32 : 128, vcu, G, tid);
                pg8::Gemm g{UEXT, SSME, 768, 512, 512}; pg8::GroupOrder S; S.init(64, 2, 1, G, bx);
                pg8::EpiE E{EB};
                pg8::gemm_phase<pg8::EpiE, pg8::GroupOrder, true, true>(lds, g, S, E, tid);
                if (G == 256 && bx >= 128 && p == 0) {
                    MISC_LAS float* scr = (MISC_LAS float*)(lds + wave * 16384);
                    for (int it = I_IN + (bx - 128) * 8 + wave; it < NITEMS; it += 1024) weight_item(it, args.in[3], args.in[12], args.in[17], args.in[18], args.in[19], WIN, WGLU, WMRG, WOUT, scr, lane);
                }
                if (G == 256 && bx < 128) {
                    asm volatile("s_waitcnt vmcnt(0)" ::: "memory"); __syncthreads();
                    const int nc = p == 0 ? 64 : 256, nloc = 256 / nc;
                    if (wave < 2 * nloc) misc::rec_one(EB, UEXT, AT, (bx & 1) * nloc + (wave >> 1), bx >> 1, wave & 1, nc, lane);
                }
            } } else if (s == 2) { if (HAS(3)) {
                misc::rec_phase(EB, UEXT, AT, p == 0 ? 8 : 2, p == 0 ? 64 : 256, vcu * 8 + wave, G * 8, lane);
            } } else if (s == 3) { if (HAS(4)) {
                pg8::Gemm g{UEXT, SSMY, 768, 768, 768}; pg8::GroupOrder S; S.init(64, 2, 2, G, bx);
                pg8::EpiY E{YB};
                pg8::gemm_phase<pg8::EpiY, pg8::GroupOrder, true, true>(lds, g, S, E, tid);
            } } else if (s == 4) { if (HAS(5)) {
                pg8::Gemm g{YB, WGLU, 1024, 1024, 1024}; pg8::StaticOrder S; S.init(MP, 1024, G, bx);
                pg8::EpiGlu E{YB, ZS, args.in[13], ACAT};
                pg8::gemm_phase<pg8::EpiGlu, pg8::StaticOrder, true, true>(lds, g, S, E, tid);
            } } else if (s == 5) { if (HAS(6)) {
                pg8::Gemm g{ACAT, WMRG, 2048, 2048, 2048}; pg8::StaticOrder S; S.init(MP, 2048, G, bx);
                pg8::EpiMerge E{GS, GA, MBUF};
                pg8::gemm_phase<pg8::EpiMerge, pg8::StaticOrder, true, true>(lds, g, S, E, tid);
            } } else { if (HAS(7)) {
                pg8::Gemm g{MBUF, WOUT, 2048, 2048, 2048}; pg8::StaticOrder S; S.init(MP, 2048, G, bx);
                pg8::EpiOut E{xp, outp};
                pg8::gemm_phase<pg8::EpiOut, pg8::StaticOrder, true, true>(lds, g, S, E, tid);
            } }
            __syncthreads();
        }
        { const int kbit = ph == 0 ? 0 : ((ph - 1) % 7) + 1; const bool again = ((DUP_MASK >> kbit) & 1) && !rep;
          if (again) rep = true; else { rep = false; ++ph; }
#if !MK_MULTI
          if (ph < args.ph_hi) { if (!posted) { __ockl_grid_sync(); if (threadIdx.x == 0) (void)xb_add(&xbar.bar[XB_XCNT(xbar.x)], 1u); posted = true; } else xcd_barrier(xbar); }
#endif
        }
    }
}

#ifdef STOP_PH
__global__ void dump_k(const unsigned short* src, float* out, size_t n) {
    for (size_t i = (size_t)blockIdx.x * blockDim.x + threadIdx.x; i < n; i += (size_t)gridDim.x * blockDim.x) { float acc = 0.f;
        for (int w = 0; w < 4; ++w) { unsigned v = src[(size_t)w * n + i]; if ((v & 0x7f80u) == 0x7f80u) v = 0; acc += __uint_as_float(v << 16); }
        out[i] = acc; }
}
#endif
extern "C" void kernel_launch(void* const* d_in, const int* in_sizes, int n_in, void* d_out, int out_size, void* d_ws, size_t ws_size, hipStream_t stream) {
    static int grid = 0;
    if (grid == 0) {
        if (n_in != 20 || in_sizes[0] != MP * 2048 || in_sizes[1] != MP * 2048 || out_size != 2 * MP * 2048 || ws_size < WS_END + WS_BAR_BYTES) {
            fprintf(stderr, "kernel_launch: unexpected shapes / workspace (n_in %d, ws %zu)\n", n_in, ws_size); grid = -1; return; }
        int dev = 0, cus = 0, per_cu = 0;
        if (hipGetDevice(&dev) != hipSuccess || hipDeviceGetAttribute(&cus, hipDeviceAttributeMultiprocessorCount, dev) != hipSuccess) { grid = -1; return; }
        if (hipFuncSetAttribute((const void*)hybrid_fwd, hipFuncAttributeMaxDynamicSharedMemorySize, LDS_BYTES) != hipSuccess) { fprintf(stderr, "kernel_launch: hipFuncSetAttribute failed\n"); grid = -1; return; }
        if (hipOccupancyMaxActiveBlocksPerMultiprocessor(&per_cu, (const void*)hybrid_fwd, 512, LDS_BYTES) != hipSuccess || per_cu < 1) per_cu = 1;
        (void)hipGetLastError();
        grid = cus * per_cu;
        fprintf(stderr, "kernel_launch: grid %d (cus %d x %d), ws %zu\n", grid, cus, per_cu, ws_size);
    }
    if (grid < 0) return;
#ifdef MK_MEMSET
#if MK_MEMSET == 1
    (void)hipMemsetAsync(d_ws, 0xAA, WS_END, stream);
    (void)hipMemsetAsync(d_out, 0xAA, (size_t)out_size * 4, stream);
#elif MK_MEMSET == 2
    (void)hipMemsetAsync((char*)d_ws + WS_END, 0xAA, 64, stream);
#elif MK_MEMSET == 3
    (void)hipMemsetAsync(d_ws, 0xAA, WS_END, stream);
#elif MK_MEMSET == 4
    (void)hipMemsetAsync(d_out, 0xAA, (size_t)out_size * 4, stream);
#endif
#endif
    Args a{};
    for (int i = 0; i < 20; ++i) a.in[i] = (const float*)d_in[i];
    a.out = (float*)d_out; a.ws = (unsigned char*)d_ws;
#if MK_MULTI
#ifdef STOP_PH
    for (int ph = 0; ph <= STOP_PH; ++ph) { a.ph_lo = ph; a.ph_hi = ph + 1; hipLaunchKernelGGL(hybrid_fwd, dim3(grid), dim3(512), LDS_BYTES, stream, a); }
    hipLaunchKernelGGL(dump_k, dim3(2048), dim3(256), 0, stream, (const unsigned short*)d_ws, (float*)d_out, (size_t)out_size);
#else
    for (int ph = 0; ph < N_PHASES; ++ph) { a.ph_lo = ph; a.ph_hi = ph + 1; hipLaunchKernelGGL(hybrid_fwd, dim3(grid), dim3(512), LDS_BYTES, stream, a); }
#endif
#else
    a.ph_lo = 0; a.ph_hi = N_PHASES;
    void* kargs[] = {&a};
    const hipError_t e = hipLaunchCooperativeKernel((const void*)hybrid_fwd, dim3(grid), dim3(512), kargs, LDS_BYTES, stream);
    if (e != hipSuccess) fprintf(stderr, "kernel_launch: cooperative launch failed: %s (grid %d)\n", hipGetErrorString(e), grid);
#endif
}
```

```cpp
#define MK_MULTI 0
#include <hip/hip_runtime.h>
#include <cstdio>
#include <cstdint>
#include <cmath>
namespace pg8 {
#define PG8_LAS __attribute__((address_space(3)))
typedef unsigned short bf16_t;
typedef short bf16x8 __attribute__((ext_vector_type(8)));
typedef float f32x4 __attribute__((ext_vector_type(4)));
typedef float f32x2 __attribute__((ext_vector_type(2)));
typedef unsigned u32x4 __attribute__((ext_vector_type(4)));
typedef unsigned u32x2 __attribute__((ext_vector_type(2)));
constexpr int BM = 256, BK = 64, HALF = 128, HTB = HALF * BK * 2  , STAGE_BYTES = 8 * HTB, NXCD = 8, WGM = 8;

__host__ __device__ __forceinline__ int lds_byte(int r, int c) { const int st = (r >> 4) * 2 + (c >> 5), rr = r & 15, cc = c & 31, ob = rr * 64 + cc * 2; return st * 1024 + (ob ^ (((ob >> 9) & 1) << 5)); }
__host__ __device__ __forceinline__ void stage_rc(int b, int& R, int& C) { const int st = b / 1024, sb = b % 1024, swz = sb ^ (((sb >> 9) & 1) << 5); R = (st >> 1) * 16 + swz / 64; C = (st & 1) * 32 + (swz % 64) / 2; }
__host__ __device__ __forceinline__ int perm32(int rho) { const int n = rho >> 4, i = rho & 15; return 8 * (i >> 2) + 4 * n + (i & 3); }

struct Unit { int pm, pn; };
struct Gemm { const bf16_t* A; const bf16_t* Bt; int lda, ldb, K; };

struct StaticOrder {
    int nM, nN, nwg, G, c, wgm;
    __host__ __device__ void init(int M, int N, int G_, int c_, int wgm_ = WGM) { nM = M / BM; nN = N / BM; nwg = nM * nN; G = G_; c = c_; wgm = wgm_; }
    __host__ __device__ bool next(int i, Unit& u) const {
        const long L = (long)i * G + c; if (L >= nwg) return false;
        int wgid = (int)L; { const int q = nwg / NXCD, r = nwg % NXCD, xcd = wgid % NXCD, off = wgid / NXCD; wgid = (xcd < r ? xcd * (q + 1) : r * (q + 1) + (xcd - r) * q) + off; }
        const int nig = wgm * nN, gid = wgid / nig, fm = gid * wgm, gsz = (nM - fm) < wgm ? (nM - fm) : wgm;
        u.pm = fm + ((wgid % nig) % gsz); u.pn = (wgid % nig) / gsz; return true;
    }
};
struct RangeOrder {
    StaticOrder S; int i0, n;
    __host__ __device__ bool next(int i, Unit& u) const { if (i >= n) return false; return S.next(i0 + i, u); }
};
struct GroupOrder {
    int rt, ct, total, G, c;
    __host__ __device__ void init(int nG, int rt_, int ct_, int G_, int c_) { rt = rt_; ct = ct_; total = nG * rt_ * ct_; G = G_; c = c_; }
    __host__ __device__ bool next(int i, Unit& u) const {
        const int L = i * G + c; if (L >= total) return false;
        const int per = rt * ct, g = L / per, r = L % per; u.pm = g * rt + r % rt; u.pn = g * ct + r / rt; return true;
    }
};

typedef __bf16 bf16x2_t __attribute__((ext_vector_type(2)));
__device__ __forceinline__ unsigned cvt_pk_bf16(float lo, float hi) { const f32x2 v = {lo, hi}; const bf16x2_t b = __builtin_convertvector(v, bf16x2_t); return __builtin_bit_cast(unsigned, b); }
__device__ __forceinline__ float bf_lo(unsigned w) { return __uint_as_float(w << 16); }
__device__ __forceinline__ float bf_hi(unsigned w) { return __uint_as_float(w & 0xffff0000u); }

template <class Epi, class Sched, bool ALIGN_EPI = false, bool SP2 = false>
__device__ __forceinline__ void gemm_phase(PG8_LAS unsigned char* lds, const Gemm g, const Sched& S, const Epi& E, const int tid) {
    const int wid = __builtin_amdgcn_readfirstlane(tid >> 6), lane = tid & 63, wr = wid >> 2, wc = wid & 3, fr = lane & 15, fq = lane >> 4;
    const int K = g.K, nt = K / BK;
    unsigned voffA[2], voffB[2];
#pragma unroll
    for (int i = 0; i < 2; ++i) { int R, C; stage_rc(tid * 16 + i * 8192, R, C); const int Rb = Epi::PERM ? ((R & ~31) + perm32(R & 31)) : R;
        voffA[i] = (unsigned)(R * g.lda + C) * 2u; voffB[i] = (unsigned)(Rb * g.ldb + C) * 2u; }
    const size_t kstep = (size_t)(BK * 2);
    const size_t hstepA = (size_t)HALF * g.lda * 2, hstepB = (size_t)HALF * g.ldb * 2;
    const size_t tstepA = 2 * hstepA, tstepB = 2 * hstepB;
    const unsigned ldsw = (unsigned)wid * 1024u;
    const int aoff = lds_byte(wr * 64 + fr, fq * 8), boff = lds_byte(wc * 32 + fr, fq * 8);
#define PG8_SA(b, h) (((b) * 2 + (h)) * HTB)
#define PG8_SB(b, h) ((4 + (b) * 2 + (h)) * HTB)
#define PG8_STAGE(bufoff, gbase, voff) do { _Pragma("unroll") for (int _i = 0; _i < 2; ++_i) \
        __builtin_amdgcn_global_load_lds((const unsigned*)((const char*)(gbase) + (voff)[_i]), (PG8_LAS unsigned*)(lds + (bufoff) + ldsw + _i * 8192), 16, 0, 0); } while (0)
#define PG8_LDA(dst, b, h) do { _Pragma("unroll") for (int m = 0; m < 4; ++m) _Pragma("unroll") for (int k = 0; k < 2; ++k) dst[m][k] = *(const PG8_LAS bf16x8*)(lds + PG8_SA(b, h) + aoff + m * 2048 + k * 1024); } while (0)
#define PG8_LDB(dst, b, h) do { _Pragma("unroll") for (int n = 0; n < 2; ++n) _Pragma("unroll") for (int k = 0; k < 2; ++k) dst[n][k] = *(const PG8_LAS bf16x8*)(lds + PG8_SB(b, h) + boff + n * 2048 + k * 1024); } while (0)
#define PG8_MMA(ai, bj, At, Bt) do { __builtin_amdgcn_s_setprio(1); _Pragma("unroll") for (int m = 0; m < 4; ++m) _Pragma("unroll") for (int n = 0; n < 2; ++n) _Pragma("unroll") for (int k = 0; k < 2; ++k) \
        acc[ai][bj][m][n] = __builtin_amdgcn_mfma_f32_16x16x32_bf16(Bt[n][k], At[m][k], acc[ai][bj][m][n], 0, 0, 0); __builtin_amdgcn_s_setprio(0); } while (0)
#define PG8_WAIT_V(n) asm volatile("s_waitcnt vmcnt(" #n ")" ::: "memory")
#define PG8_WAIT_L(n) asm volatile("s_waitcnt lgkmcnt(" #n ")" ::: "memory")
#define PG8_BAR __builtin_amdgcn_s_barrier()
#define PG8_SCHED __builtin_amdgcn_sched_barrier(0)
    Unit cur, nxt; int ui = 0;
    if (!S.next(0, cur)) return;
    f32x4 acc[2][2][4][2];
#pragma unroll
    for (int a = 0; a < 2; ++a)
#pragma unroll
        for (int b = 0; b < 2; ++b)
#pragma unroll
            for (int m = 0; m < 4; ++m)
#pragma unroll
                for (int n = 0; n < 2; ++n) acc[a][b][m][n] = (f32x4){0.f, 0.f, 0.f, 0.f};
    bf16x8 At[4][2], B0[2][2], B1[2][2];
    const char* cA = (const char*)g.A + (size_t)cur.pm * tstepA; const char* cB = (const char*)g.Bt + (size_t)cur.pn * tstepB;
    if constexpr (SP2) {
        PG8_STAGE(PG8_SB(0, 0), cB, voffB); PG8_STAGE(PG8_SB(0, 1), cB + hstepB, voffB); PG8_STAGE(PG8_SA(0, 0), cA, voffA); PG8_STAGE(PG8_SA(0, 1), cA + hstepA, voffA);
        if (wr == 1) PG8_BAR;
        PG8_WAIT_V(2); PG8_BAR;
        PG8_STAGE(PG8_SB(1, 0), cB + kstep, voffB); PG8_STAGE(PG8_SA(1, 0), cA + kstep, voffA); PG8_STAGE(PG8_SB(1, 1), cB + hstepB + kstep, voffB);
        PG8_WAIT_V(6); PG8_BAR;
    } else {
        PG8_STAGE(PG8_SB(0, 0), cB, voffB); PG8_STAGE(PG8_SA(0, 0), cA, voffA); PG8_STAGE(PG8_SB(0, 1), cB + hstepB, voffB); PG8_STAGE(PG8_SA(0, 1), cA + hstepA, voffA);
        if (wr == 1) PG8_BAR;
        PG8_WAIT_V(4); PG8_BAR;
        PG8_STAGE(PG8_SB(1, 0), cB + kstep, voffB); PG8_STAGE(PG8_SA(1, 0), cA + kstep, voffA); PG8_STAGE(PG8_SB(1, 1), cB + hstepB + kstep, voffB);
        PG8_WAIT_V(6); PG8_BAR;
    }
    for (;;) {
        const bool has_next = S.next(ui + 1, nxt);
        const char* nA = has_next ? (const char*)g.A + (size_t)nxt.pm * tstepA : cA; const char* nB = has_next ? (const char*)g.Bt + (size_t)nxt.pn * tstepB : cB;
        for (int t = 0; t < nt; t += 2) {
            const bool last = (t == nt - 2);
            const char* a1 = cA + (size_t)(t + 1) * kstep;
            const char* a2 = last ? nA : cA + (size_t)(t + 2) * kstep; const char* b2 = last ? nB : cB + (size_t)(t + 2) * kstep;
            const char* a3 = a2 + kstep; const char* b3 = b2 + kstep;
            if constexpr (Epi::MIDK) { if (t == (nt >> 1)) E.mid(acc, cur, wr, wc, fr, fq); }
            if constexpr (SP2) {
            PG8_LDB(B0, 0, 0); PG8_LDB(B1, 0, 1); PG8_SCHED; PG8_LDA(At, 0, 0); PG8_STAGE(PG8_SA(1, 1), a1 + hstepA, voffA);
            PG8_WAIT_V(8); PG8_WAIT_L(0); PG8_BAR; PG8_MMA(0, 0, At, B0); PG8_MMA(0, 1, At, B1); PG8_BAR; PG8_SCHED;
            PG8_LDA(At, 0, 1); PG8_STAGE(PG8_SB(0, 0), b2, voffB); PG8_STAGE(PG8_SB(0, 1), b2 + hstepB, voffB); PG8_STAGE(PG8_SA(0, 0), a2, voffA);
            PG8_WAIT_V(8); PG8_WAIT_L(0); PG8_BAR; PG8_MMA(1, 0, At, B0); PG8_MMA(1, 1, At, B1); PG8_BAR; PG8_SCHED;
            PG8_LDB(B0, 1, 0); PG8_LDB(B1, 1, 1); PG8_SCHED; PG8_LDA(At, 1, 0); PG8_STAGE(PG8_SA(0, 1), a2 + hstepA, voffA);
            PG8_WAIT_V(8); PG8_WAIT_L(0); PG8_BAR; PG8_MMA(0, 0, At, B0); PG8_MMA(0, 1, At, B1); PG8_BAR; PG8_SCHED;
            PG8_LDA(At, 1, 1); PG8_STAGE(PG8_SB(1, 0), b3, voffB); PG8_STAGE(PG8_SB(1, 1), b3 + hstepB, voffB); PG8_STAGE(PG8_SA(1, 0), a3, voffA);
            PG8_WAIT_V(8); PG8_WAIT_L(0); PG8_BAR; PG8_MMA(1, 0, At, B0); PG8_MMA(1, 1, At, B1); PG8_BAR; PG8_SCHED;
            } else {
            PG8_LDB(B0, 0, 0); PG8_SCHED; PG8_LDA(At, 0, 0); PG8_STAGE(PG8_SA(1, 1), a1 + hstepA, voffA);
            PG8_WAIT_L(8); PG8_BAR; PG8_WAIT_L(0); PG8_MMA(0, 0, At, B0); PG8_BAR; PG8_SCHED;
            PG8_LDB(B1, 0, 1); PG8_STAGE(PG8_SB(0, 0), b2, voffB);
            PG8_BAR; PG8_WAIT_L(0); PG8_MMA(0, 1, At, B1); PG8_BAR;
            PG8_LDA(At, 0, 1); PG8_STAGE(PG8_SA(0, 0), a2, voffA);
            PG8_BAR; PG8_WAIT_L(0); PG8_MMA(1, 0, At, B0); PG8_BAR; PG8_SCHED;
            PG8_STAGE(PG8_SB(0, 1), b2 + hstepB, voffB);
            PG8_WAIT_V(6); PG8_BAR; PG8_MMA(1, 1, At, B1); PG8_BAR;
            PG8_LDB(B0, 1, 0); PG8_SCHED; PG8_LDA(At, 1, 0); PG8_STAGE(PG8_SA(0, 1), a2 + hstepA, voffA);
            PG8_WAIT_L(8); PG8_BAR; PG8_WAIT_L(0); PG8_MMA(0, 0, At, B0); PG8_BAR; PG8_SCHED;
            PG8_LDB(B1, 1, 1); PG8_STAGE(PG8_SB(1, 0), b3, voffB);
            PG8_BAR; PG8_WAIT_L(0); PG8_MMA(0, 1, At, B1); PG8_BAR;
            PG8_LDA(At, 1, 1); PG8_STAGE(PG8_SA(1, 0), a3, voffA);
            PG8_BAR; PG8_WAIT_L(0); PG8_MMA(1, 0, At, B0); PG8_BAR; PG8_SCHED;
            PG8_STAGE(PG8_SB(1, 1), b3 + hstepB, voffB);
            PG8_WAIT_V(6); PG8_BAR; PG8_MMA(1, 1, At, B1); PG8_BAR;
            }
        }
        if constexpr (ALIGN_EPI) { if (wr == 0) PG8_BAR; }
        E(acc, cur, wr, wc, fr, fq);
        if (!has_next) break;
#pragma unroll
        for (int a = 0; a < 2; ++a)
#pragma unroll
            for (int b = 0; b < 2; ++b)
#pragma unroll
                for (int m = 0; m < 4; ++m)
#pragma unroll
                    for (int n = 0; n < 2; ++n) acc[a][b][m][n] = (f32x4){0.f, 0.f, 0.f, 0.f};
        cur = nxt; cA = nA; cB = nB; ++ui;
        if constexpr (ALIGN_EPI) { if (wr == 1) PG8_BAR; }
    }
    PG8_WAIT_V(0);
    if constexpr (!ALIGN_EPI) { if (wr == 0) PG8_BAR; }
    PG8_BAR;
#undef PG8_SA
#undef PG8_SB
#undef PG8_STAGE
#undef PG8_LDA
#undef PG8_LDB
#undef PG8_MMA
#undef PG8_WAIT_V
#undef PG8_WAIT_L
#undef PG8_BAR
#undef PG8_SCHED
}
}
namespace pg8 {
constexpr float LOG2E = 1.4426950408889634f;
__device__ __forceinline__ float sigm(float x) { return __builtin_amdgcn_rcpf(1.f + __expf(-x)); }
__device__ __forceinline__ float gelu_tanh(float x) { const float in = 0.7978845608028654f * (x + 0.044715f * x * x * x); return x * sigm(2.f * in); }
__device__ __forceinline__ u32x4 pack8(const f32x4 a, const f32x4 b) { u32x4 w; w.x = cvt_pk_bf16(a[0], a[1]); w.y = cvt_pk_bf16(a[2], a[3]); w.z = cvt_pk_bf16(b[0], b[1]); w.w = cvt_pk_bf16(b[2], b[3]); return w; }
__device__ __forceinline__ void unpack8(const u32x4 w, f32x4& a, f32x4& b) { a = (f32x4){bf_lo(w.x), bf_hi(w.x), bf_lo(w.y), bf_hi(w.y)}; b = (f32x4){bf_lo(w.z), bf_hi(w.z), bf_lo(w.w), bf_hi(w.w)}; }

struct EpiProj {
    static constexpr bool PERM = true, MIDK = false;
    bf16_t *UEXT, *ZS, *Q, *Kb, *V, *ZA; unsigned char *GS, *GA; const float *qg, *kg;
    __device__ __forceinline__ static void gate8(const f32x4 (&acc)[2][2][4][2], unsigned char* dst, const int colt, const int row0, const int wc, const int fq) {
        const int col0 = colt + wc * 32 + 8 * fq;
#pragma unroll
        for (int ai = 0; ai < 2; ++ai)
#pragma unroll
            for (int m = 0; m < 4; ++m) { unsigned char* rowp = dst + (size_t)(row0 + ai * HALF + m * 16) * 2048 + col0;
#pragma unroll
                for (int bj = 0; bj < 2; ++bj) { u32x2 w = {0u, 0u};
#pragma unroll
                    for (int e = 0; e < 4; ++e) { w.x = __builtin_amdgcn_cvt_pk_u8_f32(fmaxf(sigm(acc[ai][bj][m][0][e]) * 255.f, 1.f), e, w.x);
                                                  w.y = __builtin_amdgcn_cvt_pk_u8_f32(fmaxf(sigm(acc[ai][bj][m][1][e]) * 255.f, 1.f), e, w.y); }
                    *(u32x2*)(rowp + bj * HALF) = w; } }
    }
    template <int KIND  > __device__ __forceinline__ static void plain(const f32x4 (&acc)[2][2][4][2], bf16_t* dst, const int ld, const int colt, const int row0, const int wc, const int fq) {
        const int col0 = colt + wc * 32 + 8 * fq;
#pragma unroll
        for (int ai = 0; ai < 2; ++ai)
#pragma unroll
            for (int m = 0; m < 4; ++m) { bf16_t* rowp = dst + (size_t)(row0 + ai * HALF + m * 16) * ld + col0;
#pragma unroll
                for (int bj = 0; bj < 2; ++bj) { f32x4 v0 = acc[ai][bj][m][0], v1 = acc[ai][bj][m][1];
                    if (KIND != 0) {
#pragma unroll
                        for (int e = 0; e < 4; ++e) { const float s0 = sigm(v0[e]), s1 = sigm(v1[e]); v0[e] = KIND == 1 ? v0[e] * s0 : s0; v1[e] = KIND == 1 ? v1[e] * s1 : s1; } }
                    *(u32x4*)(rowp + bj * HALF) = pack8(v0, v1); } }
    }
    __device__ __forceinline__ void operator()(const f32x4 (&acc)[2][2][4][2], const Unit& u, int wr, int wc, int fr, int fq) const {
        const int pn = u.pn; int row0 = u.pm * BM + wr * 64 + fr; asm volatile("" : "+v"(row0));
        if (pn >= 8 && pn < 16) {
            const bool isq = pn < 12; const float* gg = isq ? qg : kg; bf16_t* dst = isq ? Q : Kb; const float sc = isq ? 0.125f * LOG2E : 1.f;
            const int head = (pn - (isq ? 8 : 12)) * 4 + wc;
            f32x4 gv[2][2];
#pragma unroll
            for (int bj = 0; bj < 2; ++bj)
#pragma unroll
                for (int n = 0; n < 2; ++n) gv[bj][n] = *(const f32x4*)(gg + 32 * bj + 8 * fq + 4 * n) * sc;
#pragma unroll
            for (int ai = 0; ai < 2; ++ai)
#pragma unroll
                for (int m = 0; m < 4; ++m) {
                    float ss = 0.f;
#pragma unroll
                    for (int bj = 0; bj < 2; ++bj)
#pragma unroll
                        for (int n = 0; n < 2; ++n) { const f32x4 x = acc[ai][bj][m][n]; ss += (x[0] * x[0] + x[1] * x[1]) + (x[2] * x[2] + x[3] * x[3]); }
                    ss += __shfl_xor(ss, 16); ss += __shfl_xor(ss, 32);
                    const float rinv = __builtin_amdgcn_rsqf(ss * (1.f / 64.f) + 1e-6f);
                    bf16_t* rowp = dst + (size_t)(row0 + ai * HALF + m * 16) * 1024 + head * 64 + 8 * fq;
#pragma unroll
                    for (int bj = 0; bj < 2; ++bj) *(u32x4*)(rowp + 32 * bj) = pack8(acc[ai][bj][m][0] * rinv * gv[bj][0], acc[ai][bj][m][1] * rinv * gv[bj][1]);
                }
        } else if (pn < 4) {
#pragma unroll
            for (int ai = 0; ai < 2; ++ai)
#pragma unroll
                for (int m = 0; m < 4; ++m) { const int r = row0 + ai * HALF + m * 16;
#pragma unroll
                    for (int bj = 0; bj < 2; ++bj) { const int c = pn * BM + bj * HALF + wc * 32 + 8 * fq, gidx = c >> 4, h0 = c & 15;
                        *(u32x4*)(UEXT + ((size_t)(gidx * 512 + (r >> 5)) * 768 + (r & 31) * 16 + h0)) = pack8(acc[ai][bj][m][0], acc[ai][bj][m][1]); } }
        } else if (pn < 8) { plain<1>(acc, ZS, 1024, (pn - 4) * BM, row0, wc, fq); }
        else if (pn < 20) { plain<0>(acc, V, 1024, (pn - 16) * BM, row0, wc, fq); }
        else if (pn < 24) { plain<1>(acc, ZA, 1024, (pn - 20) * BM, row0, wc, fq); }
        else if (pn < 32) { gate8(acc, GS, (pn - 24) * BM, row0, wc, fq); }
        else { gate8(acc, GA, (pn - 32) * BM, row0, wc, fq); }
    }
};
struct EpiE {
    static constexpr bool PERM = false, MIDK = false;
    float* E;
    __device__ __forceinline__ void operator()(const f32x4 (&acc)[2][2][4][2], const Unit& u, int wr, int wc, int fr, int fq) const {
        int row0 = u.pm * BM + wr * 64 + fr; asm volatile("" : "+v"(row0)); const int col0 = wc * 32 + 4 * fq;
#pragma unroll
        for (int ai = 0; ai < 2; ++ai)
#pragma unroll
            for (int m = 0; m < 4; ++m) { float* rowp = E + (size_t)(row0 + ai * HALF + m * 16) * 256 + col0;
#pragma unroll
                for (int bj = 0; bj < 2; ++bj)
#pragma unroll
                    for (int n = 0; n < 2; ++n) *(f32x4*)(rowp + bj * HALF + n * 16) = acc[ai][bj][m][n]; }
    }
};
struct EpiY {
    static constexpr bool PERM = true, MIDK = false;
    bf16_t* Y;
    __device__ __forceinline__ void operator()(const f32x4 (&acc)[2][2][4][2], const Unit& u, int wr, int wc, int fr, int fq) const {
        const int gidx = u.pm >> 1; int chunk0 = (u.pm & 1) * BM + wr * 64 + fr; asm volatile("" : "+v"(chunk0));
#pragma unroll
        for (int ai = 0; ai < 2; ++ai)
#pragma unroll
            for (int m = 0; m < 4; ++m) { const int chunk = chunk0 + ai * HALF + m * 16;
#pragma unroll
                for (int bj = 0; bj < 2; ++bj) { const int nc = (u.pn & 1) * BM + bj * HALF + wc * 32 + 8 * fq, i = nc >> 4, h0 = nc & 15;
                    f32x4 v0 = acc[ai][bj][m][0], v1 = acc[ai][bj][m][1];
#pragma unroll
                    for (int e = 0; e < 4; ++e) { v0[e] = gelu_tanh(v0[e]); v1[e] = gelu_tanh(v1[e]); }
                    *(u32x4*)(Y + (size_t)(chunk * 32 + i) * 1024 + gidx * 16 + h0) = pack8(v0, v1); } }
    }
};
struct EpiGlu {
    static constexpr bool PERM = true, MIDK = false;
    const bf16_t *Y, *ZS; const float* bias; bf16_t* ACAT;
    __device__ __forceinline__ void operator()(const f32x4 (&acc)[2][2][4][2], const Unit& u, int wr, int wc, int fr, int fq) const {
        int row0 = u.pm * BM + wr * 64 + fr; asm volatile("" : "+v"(row0)); const int col0 = u.pn * BM + wc * 32 + 8 * fq;
        f32x4 bv[2][2];
#pragma unroll
        for (int bj = 0; bj < 2; ++bj) { bv[bj][0] = *(const f32x4*)(bias + col0 + bj * HALF); bv[bj][1] = *(const f32x4*)(bias + col0 + bj * HALF + 4); }
#pragma unroll
        for (int ai = 0; ai < 2; ++ai) {
            u32x4 yw[4][2], zw[4][2];
#pragma unroll
            for (int m = 0; m < 4; ++m) { const size_t r = (size_t)(row0 + ai * HALF + m * 16);
#pragma unroll
                for (int bj = 0; bj < 2; ++bj) { yw[m][bj] = *(const u32x4*)(Y + r * 1024 + col0 + bj * HALF); zw[m][bj] = *(const u32x4*)(ZS + r * 1024 + col0 + bj * HALF); } }
#pragma unroll
            for (int m = 0; m < 4; ++m) { const size_t r = (size_t)(row0 + ai * HALF + m * 16);
#pragma unroll
                for (int bj = 0; bj < 2; ++bj) { const f32x4 b0 = bv[bj][0], b1 = bv[bj][1];
                    f32x4 y0, y1, z0, z1; unpack8(yw[m][bj], y0, y1); unpack8(zw[m][bj], z0, z1);
                    f32x4 v0 = acc[ai][bj][m][0] + b0, v1 = acc[ai][bj][m][1] + b1;
#pragma unroll
                    for (int e = 0; e < 4; ++e) { v0[e] = y0[e] * sigm(v0[e]) * z0[e]; v1[e] = y1[e] * sigm(v1[e]) * z1[e]; }
                    *(u32x4*)(ACAT + r * 2048 + col0 + bj * HALF) = pack8(v0, v1); } }
            asm volatile("" ::: "memory"); }
    }
};
struct EpiMerge {
    static constexpr bool PERM = true, MIDK = true;
    const unsigned char *GS, *GA; bf16_t* MB;
    __device__ __forceinline__ static void ub8(const u32x2 w, f32x4& a, f32x4& b) {
        a = (f32x4){(float)(w.x & 0xffu), (float)((w.x >> 8) & 0xffu), (float)((w.x >> 16) & 0xffu), (float)(w.x >> 24)};
        b = (f32x4){(float)(w.y & 0xffu), (float)((w.y >> 8) & 0xffu), (float)((w.y >> 16) & 0xffu), (float)(w.y >> 24)}; }
    __device__ __forceinline__ void mid(f32x4 (&acc)[2][2][4][2], const Unit& u, int wr, int wc, int fr, int fq) const {
        int row0 = u.pm * BM + wr * 64 + fr; asm volatile("" : "+v"(row0)); const int col0 = u.pn * BM + wc * 32 + 8 * fq;
        u32x2 sw[2][4][2], aw[2][4][2];
#pragma unroll
        for (int ai = 0; ai < 2; ++ai)
#pragma unroll
            for (int m = 0; m < 4; ++m) { const size_t r = (size_t)(row0 + ai * HALF + m * 16);
#pragma unroll
                for (int bj = 0; bj < 2; ++bj) { sw[ai][m][bj] = *(const u32x2*)(GS + r * 2048 + col0 + bj * HALF); aw[ai][m][bj] = *(const u32x2*)(GA + r * 2048 + col0 + bj * HALF); } }
#pragma unroll
        for (int ai = 0; ai < 2; ++ai)
#pragma unroll
            for (int m = 0; m < 4; ++m)
#pragma unroll
                for (int bj = 0; bj < 2; ++bj) { f32x4 s0, s1, a0, a1; ub8(sw[ai][m][bj], s0, s1); ub8(aw[ai][m][bj], a0, a1);
#pragma unroll
                    for (int e = 0; e < 4; ++e) { acc[ai][bj][m][0][e] *= s0[e] * __builtin_amdgcn_rcpf(a0[e]); acc[ai][bj][m][1][e] *= s1[e] * __builtin_amdgcn_rcpf(a1[e]); } }
    }
    __device__ __forceinline__ void operator()(const f32x4 (&acc)[2][2][4][2], const Unit& u, int wr, int wc, int fr, int fq) const {
        int row0 = u.pm * BM + wr * 64 + fr; asm volatile("" : "+v"(row0)); const int col0 = u.pn * BM + wc * 32 + 8 * fq;
        u32x2 aw[2][4][2];
#pragma unroll
        for (int ai = 0; ai < 2; ++ai)
#pragma unroll
            for (int m = 0; m < 4; ++m) { const size_t r = (size_t)(row0 + ai * HALF + m * 16);
#pragma unroll
                for (int bj = 0; bj < 2; ++bj) aw[ai][m][bj] = *(const u32x2*)(GA + r * 2048 + col0 + bj * HALF); }
#pragma unroll
        for (int ai = 0; ai < 2; ++ai)
#pragma unroll
            for (int m = 0; m < 4; ++m) { const size_t r = (size_t)(row0 + ai * HALF + m * 16);
#pragma unroll
                for (int bj = 0; bj < 2; ++bj) { f32x4 a0, a1; ub8(aw[ai][m][bj], a0, a1);
                    *(u32x4*)(MB + r * 2048 + col0 + bj * HALF) = pack8(acc[ai][bj][m][0] * a0 * (1.f / 255.f), acc[ai][bj][m][1] * a1 * (1.f / 255.f)); } }
    }
};
struct EpiOut {
    static constexpr bool PERM = false, MIDK = false;
    const float* X; float* O;
    __device__ __forceinline__ void operator()(const f32x4 (&acc)[2][2][4][2], const Unit& u, int wr, int wc, int fr, int fq) const {
        int row0 = u.pm * BM + wr * 64 + fr; asm volatile("" : "+v"(row0)); const int col0 = u.pn * BM + wc * 32 + 4 * fq;
#pragma unroll
        for (int ai = 0; ai < 2; ++ai) {
            f32x4 xv[4][2][2];
#pragma unroll
            for (int m = 0; m < 4; ++m) { const size_t off = (size_t)(row0 + ai * HALF + m * 16) * 2048 + col0;
#pragma unroll
                for (int bj = 0; bj < 2; ++bj)
#pragma unroll
                    for (int n = 0; n < 2; ++n) xv[m][bj][n] = *(const f32x4*)(X + off + bj * HALF + n * 16); }
#pragma unroll
            for (int m = 0; m < 4; ++m) { const size_t off = (size_t)(row0 + ai * HALF + m * 16) * 2048 + col0;
#pragma unroll
                for (int bj = 0; bj < 2; ++bj)
#pragma unroll
                    for (int n = 0; n < 2; ++n) *(f32x4*)(O + off + bj * HALF + n * 16) = xv[m][bj][n] + acc[ai][bj][m][n]; }
            asm volatile("" ::: "memory"); }
    }
};
}
namespace nat {
typedef unsigned short bf16_t;
typedef short bf16x8 __attribute__((ext_vector_type(8)));
typedef short s16x4 __attribute__((ext_vector_type(4)));
typedef float f32x4 __attribute__((ext_vector_type(4)));
typedef unsigned u32x4 __attribute__((ext_vector_type(4)));
typedef unsigned u32x2 __attribute__((ext_vector_type(2)));
#define NAT_LAS __attribute__((address_space(3)))
constexpr int SLOTB = 8192, KIMG = 0, VIMG = 9 * SLOTB, BIAS_OFF = 18 * SLOTB;
__device__ __forceinline__ s16x4 vtr(unsigned addr) { return __builtin_bit_cast(s16x4, __builtin_amdgcn_ds_read_tr16_b64_v4i16((NAT_LAS s16x4*)addr)); }
__device__ __forceinline__ void glds16(const void* gsrc, unsigned lds_dst) { unsigned keep;
    asm volatile("s_mov_b32 %0, m0\n\ts_mov_b32 m0, %2\n\ts_nop 0\n\tglobal_load_lds_dwordx4 %1, off\n\ts_mov_b32 m0, %0" : "=&s"(keep) : "v"(gsrc), "s"(lds_dst) : "memory"); }
#define NAT_BAR() asm volatile("s_barrier" ::: "memory")
#define NAT_WAITV_BAR(N) asm volatile("s_waitcnt vmcnt(" #N ")\n\ts_barrier" ::: "memory")
__device__ __forceinline__ int clampi(int v, int lo, int hi) { return v < lo ? lo : (v > hi ? hi : v); }

__device__ __forceinline__ void attn_phase(NAT_LAS unsigned char* lds, const bf16_t* Q, const bf16_t* K, const bf16_t* V, const bf16_t* ZA, bf16_t* ACAT,
                                           const float* rel_bias, int rps  , int vcu, int G, const int tid) {
    const int lane = tid & 63, wid = __builtin_amdgcn_readfirstlane(tid >> 6), fr = lane & 15, fq = lane >> 4;
    const int rsel = wid >> 2, qb = wid & 3;
    const int c0 = 16 * qb, w0 = (qb == 0) ? 0 : (qb == 1) ? 8 : (qb == 2) ? 24 : 32;
    NAT_LAS float* biasL = (NAT_LAS float*)(lds + BIAS_OFF);
    const unsigned ldsbase = (unsigned)(size_t)lds;
    const int dcol = lane >> 3, dpos = lane & 7;
    int koff[2][2];
#pragma unroll
    for (int hf = 0; hf < 2; ++hf)
#pragma unroll
        for (int ks = 0; ks < 2; ++ks) { const int col = w0 + 16 * hf + fr; koff[hf][ks] = col * 128 + 16 * ((ks * 4 + fq) ^ ((col >> 1) & 7)); }
    const int vcol = w0 + 4 * fq + (fr >> 2), vx = (vcol >> 1) & 3, vlane = vcol * 128 + 16 * ((fr & 3) >> 1) + 8 * (fr & 1);
    bool selhi[4]; int dcs[4]; unsigned mlo[2], mhi[2];
    { const int cq = c0 + fr; int cs = cq - 8; cs = cs < 0 ? 0 : (cs > 48 ? 48 : cs);
#pragma unroll
      for (int j = 0; j < 4; ++j) { const int clo = w0 + 4 * fq + j; selhi[j] = clo < cs; const int ck = selhi[j] ? clo + 16 : clo; int dc = ck - cq + 15; dc = dc < 0 ? 0 : (dc > 30 ? 30 : dc); dcs[j] = dc; }
#pragma unroll
      for (int q = 0; q < 2; ++q) { mlo[q] = (selhi[2 * q] ? 0u : 0xffffu) | (selhi[2 * q + 1] ? 0u : 0xffff0000u); mhi[q] = ~mlo[q]; } }
    for (int bt = vcu; bt < 256; bt += G) {
        const int h = bt >> 4, rp0 = (bt & 15) * 8;
        const int seq = (2 * rp0) / rps, rl0 = 2 * rp0 - seq * rps, srow = seq * rps;
        const bf16_t* Kh = K + (size_t)srow * 64 * 1024 + h * 64; const bf16_t* Vh = V + (size_t)srow * 64 * 1024 + h * 64;
        {
            const int kr0 = clampi(rl0 - 4, 0, rps - 8), hi = clampi(rl0 - 3, 0, rps - 8) + 8, nr = hi - kr0;
            for (int j = wid; j < nr * 16; j += 8) { const int row = kr0 + (j >> 4), isv = (j >> 3) & 1, c8 = j & 7, col = c8 * 8 + dcol, slot = row % 9;
                const int gch = isv ? (dpos ^ (((col >> 1) & 3) << 1)) : (dpos ^ ((col >> 1) & 7));
                const bf16_t* src = (isv ? Vh : Kh) + (size_t)(row * 64 + col) * 1024 + gch * 8;
                glds16(src, (unsigned)__builtin_amdgcn_readfirstlane((int)(ldsbase + (isv ? VIMG : KIMG) + slot * SLOTB + c8 * 1024))); }
            if (tid < 465) biasL[tid] = rel_bias[h * 465 + tid] * 1.4426950408889634f;
        }
        bf16x8 qn[2];
        { const int qtok = (srow + rl0 + rsel) * 64 + c0 + fr;
#pragma unroll
          for (int ks = 0; ks < 2; ++ks) qn[ks] = *(const bf16x8*)(Q + (size_t)qtok * 1024 + h * 64 + ks * 32 + fq * 8); }
        asm volatile("" :: "v"(qn[0]), "v"(qn[1]));
        asm volatile("s_waitcnt vmcnt(0) lgkmcnt(0)\n\ts_barrier" ::: "memory");
#pragma nounroll
        for (int i = 0; i < 8; ++i) {
            const int rl = rl0 + 2 * i;
            const int kr0 = clampi(rl - 4, 0, rps - 8), kr1 = clampi(rl - 3, 0, rps - 8), hi = kr1 + 8;
            const int hin = clampi(rl - 1, 0, rps - 8) + 8;
            const int r = rl + rsel, krow0 = rsel ? kr1 : kr0;
            const int qtok = (srow + r) * 64 + c0 + fr;
            bf16x8 qf[2]; qf[0] = qn[0]; qf[1] = qn[1];
            u32x2 zw[4];
            { const bf16_t* zp = ZA + (size_t)qtok * 1024 + h * 64 + 4 * fq;
#pragma unroll
              for (int nt = 0; nt < 4; ++nt) zw[nt] = *(const u32x2*)(zp + 16 * nt);
              const int qtn = i < 7 ? qtok + 128 : qtok;
#pragma unroll
              for (int ks = 0; ks < 2; ++ks) qn[ks] = *(const bf16x8*)(Q + (size_t)qtn * 1024 + h * 64 + ks * 32 + fq * 8); }
            f32x4 acc[16];
            { int slot = krow0 % 9;
#pragma unroll
              for (int n2 = 0; n2 < 8; ++n2) { const NAT_LAS unsigned char* kp = lds + KIMG + slot * SLOTB;
#pragma unroll
                  for (int hf = 0; hf < 2; ++hf) { const int n = 2 * n2 + hf;
                      const bf16x8 k0 = *(const NAT_LAS bf16x8*)(kp + koff[hf][0]), k1 = *(const NAT_LAS bf16x8*)(kp + koff[hf][1]);
                      acc[n] = __builtin_amdgcn_mfma_f32_16x16x32_bf16(k0, qf[0], (f32x4){0.f, 0.f, 0.f, 0.f}, 0, 0, 0);
                      acc[n] = __builtin_amdgcn_mfma_f32_16x16x32_bf16(k1, qf[1], acc[n], 0, 0, 0); }
                  slot = slot == 8 ? 0 : slot + 1; } }
            asm volatile("s_waitcnt lgkmcnt(0)\n\ts_barrier" ::: "memory");
            if (i < 7) { int row = hi + rsel; row = row > hin - 1 ? hin - 1 : row; const int slot = row % 9;
#pragma unroll
                for (int e = 0; e < 2; ++e) { const int c8 = qb * 2 + e, col = c8 * 8 + dcol, gch = dpos ^ ((col >> 1) & 7);
                    glds16(Kh + (size_t)(row * 64 + col) * 1024 + gch * 8, (unsigned)__builtin_amdgcn_readfirstlane((int)(ldsbase + KIMG + slot * SLOTB + c8 * 1024))); } }
            float sc[8][4];
            { float bvv[8][4];
#pragma unroll
              for (int n2 = 0; n2 < 8; ++n2) { const NAT_LAS float* brow = biasL + (krow0 + n2 - r + 7) * 31;
#pragma unroll
                  for (int j = 0; j < 4; ++j) bvv[n2][j] = brow[dcs[j]]; }
              asm volatile("s_waitcnt lgkmcnt(0)" ::: "memory");
#pragma unroll
              for (int n2 = 0; n2 < 8; ++n2)
#pragma unroll
                  for (int j = 0; j < 4; ++j) sc[n2][j] = (selhi[j] ? acc[2 * n2 + 1][j] : acc[2 * n2][j]) + bvv[n2][j]; }
            float mx = sc[0][0];
#pragma unroll
            for (int n2 = 0; n2 < 8; ++n2)
#pragma unroll
                for (int j = 0; j < 4; ++j) mx = fmaxf(mx, sc[n2][j]);
            mx = fmaxf(mx, __shfl_xor(mx, 16)); mx = fmaxf(mx, __shfl_xor(mx, 32));
            float l0 = 0.f, l1 = 0.f;
#pragma unroll
            for (int n2 = 0; n2 < 8; ++n2) {
#pragma unroll
                for (int j = 0; j < 4; ++j) sc[n2][j] = __builtin_amdgcn_exp2f(sc[n2][j] - mx);
                l0 += sc[n2][0] + sc[n2][1]; l1 += sc[n2][2] + sc[n2][3]; }
            float l = l0 + l1;
            l += __shfl_xor(l, 16); l += __shfl_xor(l, 32);
            const float linv = __builtin_amdgcn_rcpf(l);
            bf16x8 pf[8];
#pragma unroll
            for (int s8 = 0; s8 < 8; ++s8) { const unsigned w0p = pg8::cvt_pk_bf16(sc[s8][0], sc[s8][1]), w1p = pg8::cvt_pk_bf16(sc[s8][2], sc[s8][3]);
                u32x4 w; w.x = w0p & mlo[0]; w.y = w1p & mlo[1]; w.z = w0p & mhi[0]; w.w = w1p & mhi[1]; pf[s8] = __builtin_bit_cast(bf16x8, w); }
            asm volatile("s_waitcnt vmcnt(2) lgkmcnt(0)\n\ts_barrier" ::: "memory");
            f32x4 o[4];
#pragma unroll
            for (int nt = 0; nt < 4; ++nt) o[nt] = (f32x4){0.f, 0.f, 0.f, 0.f};
            { int slot = krow0 % 9;
#pragma unroll
              for (int s8 = 0; s8 < 8; ++s8) { const unsigned vb = ldsbase + VIMG + slot * SLOTB + vlane;
#pragma unroll
                  for (int nt = 0; nt < 4; ++nt) {
                      const s16x4 lo = vtr(vb + (unsigned)(32 * (nt ^ vx)));
                      const s16x4 hi2 = vtr(vb + (unsigned)(2048 + 32 * (nt ^ vx)));
                      const bf16x8 vf = (bf16x8){lo[0], lo[1], lo[2], lo[3], hi2[0], hi2[1], hi2[2], hi2[3]};
                      o[nt] = __builtin_amdgcn_mfma_f32_16x16x32_bf16(vf, pf[s8], o[nt], 0, 0, 0); }
                  slot = slot == 8 ? 0 : slot + 1; } }
            asm volatile("" :: "v"(zw[0]), "v"(zw[1]), "v"(zw[2]), "v"(zw[3]), "v"(qn[0]), "v"(qn[1]));
            asm volatile("s_waitcnt vmcnt(0) lgkmcnt(0)\n\ts_barrier" ::: "memory");
            if (i < 7) { int row = hi + rsel; row = row > hin - 1 ? hin - 1 : row; const int slot = row % 9;
#pragma unroll
                for (int e = 0; e < 2; ++e) { const int c8 = qb * 2 + e, col = c8 * 8 + dcol, gch = dpos ^ (((col >> 1) & 3) << 1);
                    glds16(Vh + (size_t)(row * 64 + col) * 1024 + gch * 8, (unsigned)__builtin_amdgcn_readfirstlane((int)(ldsbase + VIMG + slot * SLOTB + c8 * 1024))); } }
            { bf16_t* op = ACAT + (size_t)qtok * 2048 + 1024 + h * 64 + 4 * fq;
#pragma unroll
              for (int nt = 0; nt < 4; ++nt) { u32x2 w; w.x = pg8::cvt_pk_bf16(o[nt][0] * linv * pg8::bf_lo(zw[nt].x), o[nt][1] * linv * pg8::bf_hi(zw[nt].x));
                  w.y = pg8::cvt_pk_bf16(o[nt][2] * linv * pg8::bf_lo(zw[nt].y), o[nt][3] * linv * pg8::bf_hi(zw[nt].y));
                  *(u32x2*)(op + 16 * nt) = w; } }
        }
        asm volatile("s_waitcnt vmcnt(0) lgkmcnt(0)\n\ts_barrier" ::: "memory");
    }
}
}
namespace misc {
typedef unsigned short bf16_t;
typedef float f32x4 __attribute__((ext_vector_type(4)));
typedef float f32x2 __attribute__((ext_vector_type(2)));
typedef unsigned u32x4 __attribute__((ext_vector_type(4)));
typedef unsigned u32x2 __attribute__((ext_vector_type(2)));
#define MISC_LAS __attribute__((address_space(3)))
#define LDS_WAIT() asm volatile("s_waitcnt lgkmcnt(0)" ::: "memory")
__device__ __forceinline__ unsigned f2bf(float f) { unsigned u = __builtin_bit_cast(unsigned, f); return (u + 0x7fffu + ((u >> 16) & 1u)) >> 16; }
__device__ __forceinline__ unsigned pk2(float lo, float hi) { return f2bf(lo) | (f2bf(hi) << 16); }
__device__ __forceinline__ float wave_sum(float v) {
#pragma unroll
    for (int o = 1; o < 64; o <<= 1) v += __shfl_xor(v, o);
    return v;
}
__device__ __forceinline__ void transpose_item(const float* W, int N, bf16_t* WT, int ldt, int koff, int drow, MISC_LAS float* scr, int k0, int n0, int lane) {
    float v[32];
#pragma unroll
    for (int i = 0; i < 32; ++i) { const int kk = 2 * i + (lane >> 5); v[i] = W[(size_t)(k0 + kk) * N + n0 + (lane & 31)]; }
#pragma unroll
    for (int i = 0; i < 32; ++i) { const int kk = 2 * i + (lane >> 5); scr[kk * 33 + (lane & 31)] = v[i]; }
    LDS_WAIT(); asm volatile("" ::: "memory");
    const int c = lane & 7;
#pragma unroll
    for (int j = 0; j < 4; ++j) { const int n = (lane >> 3) + 8 * j; const MISC_LAS float* s = scr + (8 * c) * 33 + n;
        u32x4 o; o.x = pk2(s[0 * 33], s[1 * 33]); o.y = pk2(s[2 * 33], s[3 * 33]); o.z = pk2(s[4 * 33], s[5 * 33]); o.w = pk2(s[6 * 33], s[7 * 33]);
        *(u32x4*)(WT + (size_t)(drow + n) * ldt + koff + k0 + 8 * c) = o; }
    LDS_WAIT(); asm volatile("" ::: "memory");
}
__device__ __forceinline__ void rms_rows(const float* x, const float* gam, bf16_t* o, int m0, int stride, int nrows, int lane) {
    const f32x4* gr = (const f32x4*)gam + lane; f32x4 gg[8];
#pragma unroll
    for (int j = 0; j < 8; ++j) gg[j] = gr[64 * j];
    if (m0 >= nrows) return;
    f32x4 v[8];
    { const f32x4* xr = (const f32x4*)(x + (size_t)m0 * 2048) + lane;
#pragma unroll
      for (int j = 0; j < 8; ++j) v[j] = xr[64 * j]; }
    for (int m = m0; m < nrows; m += stride) {
        float s = 0.f;
#pragma unroll
        for (int j = 0; j < 8; ++j) s += (v[j].x * v[j].x + v[j].y * v[j].y) + (v[j].z * v[j].z + v[j].w * v[j].w);
        const float rs = __builtin_amdgcn_rsqf(wave_sum(s) * (1.f / 2048.f) + 1e-6f);
        u32x2 w[8];
#pragma unroll
        for (int j = 0; j < 8; ++j) { w[j].x = pk2(v[j].x * rs * gg[j].x, v[j].y * rs * gg[j].y); w[j].y = pk2(v[j].z * rs * gg[j].z, v[j].w * rs * gg[j].w); }
        const int mn = m + stride;
        if (mn < nrows) { const f32x4* xr = (const f32x4*)(x + (size_t)mn * 2048) + lane;
#pragma unroll
            for (int j = 0; j < 8; ++j) v[j] = xr[64 * j]; }
        u32x2* o8 = (u32x2*)(o + (size_t)m * 2048) + lane;
#pragma unroll
        for (int j = 0; j < 8; ++j) o8[64 * j] = w[j];
    }
}
__device__ __forceinline__ float exp_small(float x) {
    float t = 1.f, s = 1.f;
#pragma nounroll
    for (int k = 1; k <= 11; ++k) { t *= x * __builtin_amdgcn_rcpf((float)k); s += t; }
    return s;
}
__device__ __forceinline__ float exp_f(float x) {
    float r = exp_small(x * 0.0625f);
    r *= r; r *= r; r *= r; r *= r; return r;
}
__device__ __forceinline__ void sincos_f(float a, float& s, float& c) {
    const float k = __builtin_rintf(a * 0.15915494309189535f);
    float r = __builtin_fmaf(-k, 6.28318548202514648f, a); r = __builtin_fmaf(-k, -1.7484556000744883e-07f, r); r *= 0.25f;
    const float r2 = r * r; float ts = r, tc = 1.f, ss = r, cc = 1.f;
#pragma nounroll
    for (int i = 1; i <= 7; ++i) { const float e = (float)(2 * i); tc *= -r2 * __builtin_amdgcn_rcpf((e - 1.f) * e); ts *= -r2 * __builtin_amdgcn_rcpf(e * (e + 1.f)); cc += tc; ss += ts; }
#pragma nounroll
    for (int i = 0; i < 2; ++i) { const float c2 = cc * cc - ss * ss, s2 = 2.f * ss * cc; cc = c2; ss = s2; }
    s = ss; c = cc;
}
constexpr int SM_POW = 0;
constexpr int SM_FC = SM_POW + 2 * 33 * 65 * 2;
constexpr int SM_BRE = SM_FC + 256;
constexpr int SM_BIM = SM_BRE + 2048;
constexpr int SM_CC = SM_BIM + 2048;
constexpr int SM_TB = SM_CC + 2 * 16 * 65 * 2;
constexpr int TBS = 264;
constexpr int SM_END = SM_TB + 63 * TBS / 2;
static_assert(SM_END * 4 <= 140 * 1024, "SSM builder LDS");

__device__ __forceinline__ void ssm_build(MISC_LAS float* L, int g, const float* a_re, const float* a_im, const float* log_dt, const float* b_re, const float* b_im,
                                          const float* c_re, const float* c_im, const float* dsk, bf16_t* SSMY, bf16_t* SSME, float* AT, int tid, const int stop_at = 9) {
    MISC_LAS f32x2* POW = (MISC_LAS f32x2*)(L + SM_POW); MISC_LAS f32x2* FC = (MISC_LAS f32x2*)(L + SM_FC);
    MISC_LAS float* BRE = L + SM_BRE; MISC_LAS float* BIM = L + SM_BIM; MISC_LAS f32x2* CC = (MISC_LAS f32x2*)(L + SM_CC); MISC_LAS bf16_t* TB = (MISC_LAS bf16_t*)(L + SM_TB);
    if (tid < 128) { const int d = tid >> 6, p = tid & 63;
        float lre = a_re[(d * 64 + g) * 64 + p]; lre = lre < -1e-4f ? lre : -1e-4f; const float lim = a_im[(d * 64 + g) * 64 + p];
        const float dt = exp_f(log_dt[d * 64 + g]);
        const float mag = exp_f(lre * dt); float sn, cs; sincos_f(lim * dt, sn, cs);
        const float zr = mag * cs, zi = mag * sn, rden = 1.f / (lre * lre + lim * lim);
        FC[d * 64 + p] = (f32x2){((zr - 1.f) * lre + zi * lim) * rden, (zi * lre - (zr - 1.f) * lim) * rden};
        float pr = 1.f, pi = 0.f;
#pragma nounroll
        for (int j = 0; j <= 32; ++j) { POW[(d * 33 + j) * 65 + p] = (f32x2){pr, pi}; const float nr = pr * zr - pi * zi, ni = pr * zi + pi * zr; pr = nr; pi = ni; }
        const f32x2 a32 = POW[(d * 33 + 32) * 65 + p]; *(f32x2*)(AT + ((g * 2 + d) * 64 + p) * 2) = a32;
    }
    __syncthreads();
    if (stop_at == 1) return;
    { float brv[4], biv[4], crv[4], civ[4];
#pragma unroll
      for (int it = 0; it < 4; ++it) { const int idx = tid + 512 * it;
          { const int d = idx >> 10, p = (idx >> 4) & 63, h = idx & 15; const size_t gi = ((size_t)(d * 64 + g) * 64 + p) * 16 + h; brv[it] = b_re[gi]; biv[it] = b_im[gi]; }
          { const int d = idx >> 10, hp = (idx >> 6) & 15, p = idx & 63; const size_t gi = ((size_t)(d * 64 + g) * 16 + hp) * 64 + p; crv[it] = c_re[gi]; civ[it] = c_im[gi]; } }
#pragma unroll
      for (int it = 0; it < 4; ++it) { const int idx = tid + 512 * it;
          { const int d = idx >> 10, p = (idx >> 4) & 63; const f32x2 f = FC[d * 64 + p]; BRE[idx] = f.x * brv[it] - f.y * biv[it]; BIM[idx] = f.x * biv[it] + f.y * brv[it]; }
          { const int d = idx >> 10, hp = (idx >> 6) & 15, p = idx & 63; CC[(d * 16 + hp) * 65 + p] = (f32x2){crv[it], civ[it]}; } } }
    __syncthreads();
    { const int j = (tid >> 4) & 31, hp = tid & 15; float a[2][16];
#pragma unroll
      for (int d = 0; d < 2; ++d) {
#pragma unroll
        for (int h = 0; h < 16; ++h) a[d][h] = 0.f;
        for (int p = 0; p < 64; ++p) { const f32x2 c = CC[(d * 16 + hp) * 65 + p], w = POW[(d * 33 + j) * 65 + p]; const float cpr = c.x * w.x - c.y * w.y, cpi = c.x * w.y + c.y * w.x;
            const MISC_LAS f32x4* br = (const MISC_LAS f32x4*)(BRE + (d * 64 + p) * 16); const MISC_LAS f32x4* bi = (const MISC_LAS f32x4*)(BIM + (d * 64 + p) * 16);
#pragma unroll
            for (int q = 0; q < 4; ++q) { const f32x4 r4 = br[q], i4 = bi[q];
#pragma unroll
                for (int e = 0; e < 4; ++e) a[d][4 * q + e] += cpr * r4[e] - cpi * i4[e]; } } }
      if (j == 0) { const float dd = dsk[g * 16 + hp];
#pragma unroll
          for (int h = 0; h < 16; h += 2) *(MISC_LAS unsigned*)(TB + 31 * TBS + hp * 16 + h) = pk2(a[0][h] + a[1][h] + (h == hp ? dd : 0.f), a[0][h + 1] + a[1][h + 1] + (h + 1 == hp ? dd : 0.f));
      } else {
#pragma unroll
          for (int h = 0; h < 16; h += 2) { *(MISC_LAS unsigned*)(TB + (31 + j) * TBS + hp * 16 + h) = pk2(a[0][h], a[0][h + 1]); *(MISC_LAS unsigned*)(TB + (31 - j) * TBS + hp * 16 + h) = pk2(a[1][h], a[1][h + 1]); } }
    }
    __syncthreads();
    if (stop_at == 2) return;
    bf16_t* Yg = SSMY + (size_t)g * 512 * 768;
    for (int idx = tid; idx < 512 * 96; idx += 512) { const int n = idx / 96, kc = idx - n * 96, i = n >> 4, hp = n & 15; float v[8];
        if (kc < 64) { const int j = kc >> 1, h0 = (kc & 1) * 8;
            *(u32x4*)(Yg + (size_t)n * 768 + kc * 8) = *(const MISC_LAS u32x4*)(TB + (31 + i - j) * TBS + hp * 16 + h0); continue;
        } else { const int kk = (kc - 64) * 8, d = kk >> 7, ri = (kk >> 6) & 1, p0 = kk & 63, jj = d == 0 ? i + 1 : 32 - i;
#pragma unroll
            for (int e = 0; e < 8; ++e) { const f32x2 c = CC[(d * 16 + hp) * 65 + p0 + e], w = POW[(d * 33 + jj) * 65 + p0 + e]; v[e] = ri ? -(c.x * w.y + c.y * w.x) : (c.x * w.x - c.y * w.y); } }
        u32x4 o; o.x = pk2(v[0], v[1]); o.y = pk2(v[2], v[3]); o.z = pk2(v[4], v[5]); o.w = pk2(v[6], v[7]);
        *(u32x4*)(Yg + (size_t)n * 768 + kc * 8) = o; }
    bf16_t* Eg = SSME + (size_t)g * 256 * 512;
    for (int idx = tid; idx < 256 * 64; idx += 512) { const int n = idx >> 6, kc = idx & 63, d = n >> 7, ri = (n >> 6) & 1, p = n & 63, j = kc >> 1, h0 = (kc & 1) * 8, jj = d == 0 ? 31 - j : j;
        const f32x2 w = POW[(d * 33 + jj) * 65 + p]; float v[8];
#pragma unroll
        for (int e = 0; e < 8; ++e) { const float br = BRE[(d * 64 + p) * 16 + h0 + e], bi = BIM[(d * 64 + p) * 16 + h0 + e]; v[e] = ri ? (w.x * bi + w.y * br) : (w.x * br - w.y * bi); }
        u32x4 o; o.x = pk2(v[0], v[1]); o.y = pk2(v[2], v[3]); o.z = pk2(v[4], v[5]); o.w = pk2(v[6], v[7]);
        *(u32x4*)(Eg + (size_t)n * 512 + kc * 8) = o; }
    __syncthreads();
}
__device__ __forceinline__ void rec_one(const float* __restrict__ E, bf16_t* __restrict__ UEXT, const float* __restrict__ AT, int seq, int g, int d, int nc, int lane) {
    const f32x2 at = *(const f32x2*)(AT + ((g * 2 + d) * 64 + lane) * 2);
    float sr = 0.f, si = 0.f;
    const int cb = seq * nc;
#pragma unroll 8
    for (int q = 0; q < nc; ++q) { const int c = cb + (d == 0 ? q : nc - 1 - q);
        const float er = E[((size_t)(g * 512 + c)) * 256 + d * 128 + lane], ei = E[((size_t)(g * 512 + c)) * 256 + d * 128 + 64 + lane];
        bf16_t* up = UEXT + ((size_t)(g * 512 + c)) * 768 + 512 + d * 128 + lane;
        up[0] = (bf16_t)f2bf(sr); up[64] = (bf16_t)f2bf(si);
        const float nr = at.x * sr - at.y * si + er, ni = at.x * si + at.y * sr + ei; sr = nr; si = ni; }
}
__device__ __forceinline__ void rec_phase(const float* __restrict__ E, bf16_t* __restrict__ UEXT, const float* __restrict__ AT, int nseq, int nc, int gw, int NGW, int lane) {
    for (int task = gw; task < nseq * 128; task += NGW) rec_one(E, UEXT, AT, task >> 7, (task >> 1) & 63, task & 1, nc, lane);
}
}
#define XB_TMO      128
#define XB_XCNT(j)  (256  + 64 * (j))
#define XB_XSUB(j)  (1280 + 64 * (j))
#define XB_XGEN(j)  (2304 + 64 * (j))
#define XB_TOP      3328
#define XB_TOPGEN   3392
#define XCD_BAR_WORDS 3456
#define XB_SPIN_CAP (1u << 18)
#define XB_LAS __attribute__((address_space(3)))
__device__ __forceinline__ unsigned xb_ld(unsigned* p)              { return __hip_atomic_load(p, __ATOMIC_RELAXED, __HIP_MEMORY_SCOPE_AGENT); }
__device__ __forceinline__ unsigned xb_add(unsigned* p, unsigned v) { return __hip_atomic_fetch_add(p, v, __ATOMIC_RELAXED, __HIP_MEMORY_SCOPE_AGENT); }
__device__ __forceinline__ unsigned xb_xcc_id() { return (unsigned)__builtin_amdgcn_s_getreg((3 << 11) | 20) & 0xFu; }
#define XB_SPIN(cond, bar) do { unsigned _sp = 0; while (cond) { __builtin_amdgcn_s_sleep(1); \
    if ((++_sp & 255u) == 0u) { if (xb_ld(&(bar)[XB_TMO])) break; if (_sp > XB_SPIN_CAP) { atomicAdd(&(bar)[XB_TMO], 1u); break; } } } } while (0)
struct XcdBarrier { unsigned* bar; unsigned x; volatile XB_LAS unsigned* st; };
__device__ __forceinline__ XcdBarrier xcd_barrier_post(unsigned* bar, volatile XB_LAS unsigned* st) {
    XcdBarrier b; b.bar = bar; b.x = xb_xcc_id(); b.st = st;
    if (threadIdx.x == 0) (void)xb_add(&bar[XB_XCNT(b.x)], 1u);
    return b;
}
__device__ __forceinline__ void xcd_barrier_complete(unsigned* bar, unsigned x, unsigned& nloc, unsigned& nx) {
    const unsigned G = gridDim.x * gridDim.y * gridDim.z;
    unsigned sum, cnt, mine, sp = 0u;
    for (;;) {
        sum = 0u; cnt = 0u; mine = 0u;
#pragma unroll
        for (unsigned j = 0; j < 16; ++j) { const unsigned c = xb_ld(&bar[XB_XCNT(j)]); sum += c; cnt += (c > 0u) ? 1u : 0u; mine = (j == x) ? c : mine; }
        if (sum == G) break;
        __builtin_amdgcn_s_sleep(1);
        if ((++sp & 255u) == 0u) { if (xb_ld(&bar[XB_TMO])) break; if (sp > XB_SPIN_CAP) { atomicAdd(&bar[XB_TMO], 1u); break; } }
    }
    nloc = mine > 0u ? mine : 1u; nx = cnt > 0u ? cnt : 1u;
}
__device__ __forceinline__ void xcd_barrier(const XcdBarrier& b) {
    asm volatile("s_waitcnt vmcnt(0)" ::: "memory");
    __syncthreads();
    if (threadIdx.x == 0) {
        unsigned* bar = b.bar;
        __builtin_amdgcn_s_waitcnt(0);
        unsigned nloc = b.st[0], nx = b.st[1];
        if (nloc == 0u) { xcd_barrier_complete(bar, b.x, nloc, nx); b.st[0] = nloc; b.st[1] = nx; }
        const unsigned old = xb_add(&bar[XB_XSUB(b.x)], 1u);
        const unsigned gen = old / nloc;
        if (old + 1u == (gen + 1u) * nloc) {
            __builtin_amdgcn_fence(__ATOMIC_RELEASE, "agent");
            asm volatile("s_waitcnt vmcnt(0)" ::: "memory");
            const unsigned og = xb_add(&bar[XB_TOP], 1u);
            const unsigned tg = og / nx;
            if (og + 1u == (tg + 1u) * nx) xb_add(&bar[XB_TOPGEN], 1u);
            else XB_SPIN(xb_ld(&bar[XB_TOPGEN]) == tg, bar);
            __builtin_amdgcn_fence(__ATOMIC_ACQUIRE, "agent");
            xb_add(&bar[XB_XGEN(b.x)], 1u);
            asm volatile("s_waitcnt vmcnt(0)" ::: "memory");
        } else {
            XB_SPIN(xb_ld(&bar[XB_XGEN(b.x)]) == gen, bar);
            __builtin_amdgcn_fence(__ATOMIC_ACQUIRE, "agent");
            asm volatile("s_waitcnt vmcnt(0)" ::: "memory");
        }
    }
    __syncthreads();
}
#ifndef PH_MASK
#define PH_MASK 0xff
#endif
#define HAS(k) (((PH_MASK) >> (k)) & 1)
#ifndef SYNC_REPS
#define SYNC_REPS 1
#endif
#ifndef DUP_SKIP_SSM
#define DUP_SKIP_SSM 0
#endif
#ifndef G1_WGM
#define G1_WGM 8
#endif
#ifndef G1_ALIGN
#define G1_ALIGN true
#endif
#ifndef G1_SP2
#define G1_SP2 true
#endif
#ifndef DUP_MASK
#define DUP_MASK 0
#endif
#ifndef MK_MULTI
#define MK_MULTI 0
#endif
typedef unsigned short bf16;
constexpr size_t MiB = 1u << 20;
constexpr int MP = 16384;
constexpr size_t WS_WIN = 0, WS_WGLU = 40 * MiB, WS_WMRG = 42 * MiB, WS_WOUT = 50 * MiB, WS_SSMY = 58 * MiB, WS_SSME = 106 * MiB, WS_AT = 122 * MiB,
                 WS_H = 123 * MiB  , WS_UEXT = 187 * MiB  , WS_ZS = 235 * MiB, WS_Q = 267 * MiB, WS_K = 299 * MiB, WS_V = 331 * MiB,
                 WS_ZA = 363 * MiB, WS_Y = 395 * MiB, WS_E = 427 * MiB, WS_END = 459 * MiB;
constexpr int LDS_BYTES = 147456 + 2048 + 256;
constexpr size_t WS_BAR = WS_END, WS_BAR_BYTES = 16384;
constexpr int N_PHASES = 15;
extern "C" __device__ void __ockl_grid_sync(void);

constexpr int I_IN = 32 * 320, I_GLU = 16 * 32, I_BS = 16 * 64, I_OUT = 32 * 64, NITEMS = I_IN + I_GLU + 2 * I_BS + I_OUT;
__device__ __forceinline__ void weight_item(int r, const float* w_in, const float* w_glu, const float* w_bs, const float* w_ba, const float* w_out,
                                            unsigned short* WIN, unsigned short* WGLU, unsigned short* WMRG, unsigned short* WOUT, MISC_LAS float* scr, int lane) {
    if (r < I_IN) { const int kb = r / 320, nb = r % 320, n0 = nb * 32; int drow = n0;
        if (n0 >= 2048 && n0 < 4096) drow = (n0 & ~255) + 128 * ((n0 >> 5) & 1) + 32 * ((n0 >> 6) & 3);
        misc::transpose_item(w_in, 10240, WIN, 2048, 0, drow, scr, kb * 64, n0, lane); return; } r -= I_IN;
    if (r < I_GLU) { misc::transpose_item(w_glu, 1024, WGLU, 1024, 0, (r % 32) * 32, scr, (r / 32) * 64, (r % 32) * 32, lane); return; } r -= I_GLU;
    if (r < I_BS) { misc::transpose_item(w_bs, 2048, WMRG, 2048, 0, (r % 64) * 32, scr, (r / 64) * 64, (r % 64) * 32, lane); return; } r -= I_BS;
    if (r < I_BS) { misc::transpose_item(w_ba, 2048, WMRG, 2048, 1024, (r % 64) * 32, scr, (r / 64) * 64, (r % 64) * 32, lane); return; } r -= I_BS;
    misc::transpose_item(w_out, 2048, WOUT, 2048, 0, (r % 64) * 32, scr, (r / 64) * 64, (r % 64) * 32, lane);
}

struct Args { const float* in[20]; float* out; unsigned char* ws; int ph_lo, ph_hi; };

__global__ void __launch_bounds__(512, 2) hybrid_fwd(Args args) {
    extern __shared__ __attribute__((aligned(16))) unsigned char lds_raw[];
    PG8_LAS unsigned char* lds = (PG8_LAS unsigned char*)lds_raw;
#if !MK_MULTI
    { volatile XB_LAS unsigned* st0 = (volatile XB_LAS unsigned*)((PG8_LAS unsigned char*)lds_raw + (LDS_BYTES - 64)); if (threadIdx.x < 2) st0[threadIdx.x] = 0u; }
    __syncthreads();
    XcdBarrier xbar; xbar.bar = (unsigned*)(args.ws + WS_BAR); xbar.x = xb_xcc_id(); xbar.st = (volatile XB_LAS unsigned*)((PG8_LAS unsigned char*)lds_raw + (LDS_BYTES - 64));
    if (args.ph_lo == 0 && blockIdx.x == 0) { for (int w = threadIdx.x; w < XCD_BAR_WORDS; w += 512) xbar.bar[w] = 0u; }
#endif
    const int G = gridDim.x, bx = blockIdx.x, vcu = (G % 8 == 0) ? (bx % 8) * (G / 8) + bx / 8 : bx;
    bool rep = false, posted = false;
#pragma nounroll
    for (int ph = args.ph_lo; ph < args.ph_hi; ) {
    if (!MK_MULTI && G == 256 && ph != 0 && ((ph - 1) % 7) == 2) { ++ph; continue; }
    int tid = threadIdx.x; asm volatile("" : "+v"(tid));
    size_t zoff = 0; asm volatile("" : "+s"(zoff));
    unsigned char* ws = args.ws + zoff; float* outb = args.out + zoff;
    const int lane = tid & 63, wave = __builtin_amdgcn_readfirstlane(tid >> 6);
    bf16* WIN = (bf16*)(ws + WS_WIN); bf16* WGLU = (bf16*)(ws + WS_WGLU); bf16* WMRG = (bf16*)(ws + WS_WMRG); bf16* WOUT = (bf16*)(ws + WS_WOUT);
    bf16* SSMY = (bf16*)(ws + WS_SSMY); bf16* SSME = (bf16*)(ws + WS_SSME); float* AT = (float*)(ws + WS_AT);
    bf16* HB = (bf16*)(ws + WS_H); bf16* ACAT = HB; bf16* UEXT = (bf16*)(ws + WS_UEXT); bf16* MBUF = UEXT; bf16* ZS = (bf16*)(ws + WS_ZS);
    bf16* QB = (bf16*)(ws + WS_Q); bf16* KB = (bf16*)(ws + WS_K); bf16* VB = (bf16*)(ws + WS_V); bf16* ZA = (bf16*)(ws + WS_ZA); bf16* YB = (bf16*)(ws + WS_Y);
    float* EB = (float*)(ws + WS_E);
        if (ph == 0) { if (HAS(0)) {
            const int nssm = G > 64 ? 64 : 0;
            if (bx < nssm) {
                for (int g = bx; g < 64 && !(DUP_SKIP_SSM == 1 && rep); g += nssm)
                    misc::ssm_build((MISC_LAS float*)lds, g, args.in[4], args.in[5], args.in[6], args.in[7], args.in[8], args.in[9], args.in[10], args.in[11], SSMY, SSME, AT, tid, (DUP_SKIP_SSM > 1 && rep) ? DUP_SKIP_SSM - 1 : 9);
            } else {
                MISC_LAS float* scr = (MISC_LAS float*)(lds + wave * 16384);
                const int gw = (bx - nssm) * 8 + wave, NGW = (G - nssm) * 8;
                const int nearly = (G == 256) ? I_IN : NITEMS;
                for (int it = gw; it < nearly; it += NGW) weight_item(it, args.in[3], args.in[12], args.in[17], args.in[18], args.in[19], WIN, WGLU, WMRG, WOUT, scr, lane);
                misc::rms_rows(args.in[0], args.in[2], HB, gw, NGW, MP, lane);
                { bf16* HB1 = (bf16*)((unsigned char*)outb + 192 * MiB);
                  misc::rms_rows(args.in[1], args.in[2], HB1, gw, NGW, MP, lane); }
            }
            }
            __syncthreads();
        } else {
            const int p = (ph - 1) / 7, s = (ph - 1) % 7;
            const float* xp = args.in[p]; float* outp = outb + (size_t)p * MP * 2048;
            unsigned char* GS = (unsigned char*)outp; unsigned char* GA = GS + (size_t)MP * 2048;
            if (s == 0) { if (HAS(1)) {
                pg8::Gemm g{p == 0 ? HB : (bf16*)((unsigned char*)outb + 192 * MiB), WIN, 2048, 2048, 2048}; pg8::StaticOrder S; S.init(MP, 10240, G, bx, G1_WGM);
                pg8::EpiProj E{UEXT, ZS, QB, KB, VB, ZA, GS, GA, args.in[14], args.in[15]};
                pg8::gemm_phase<pg8::EpiProj, pg8::StaticOrder, G1_ALIGN, G1_SP2>(lds, g, S, E, tid);
            } } else if (s == 1) { if (HAS(2)) {
                nat::attn_phase(lds, QB, KB, VB, ZA, ACAT, args.in[16], p == 0 ? 32 : 128, vcu, G, tid);
                pg8::Gemm g{UEXT, SSME, 768, 512, 512}; pg8::GroupOrder S; S.init(64, 2, 1, G, bx);
                pg8::EpiE E{EB};
                pg8::gemm_phase<pg8::EpiE, pg8::GroupOrder, true, true>(lds, g, S, E, tid);
                if (G == 256 && bx >= 128 && p == 0) {
                    MISC_LAS float* scr = (MISC_LAS float*)(lds + wave * 16384);
                    for (int it = I_IN + (bx - 128) * 8 + wave; it < NITEMS; it += 1024) weight_item(it, args.in[3], args.in[12], args.in[17], args.in[18], args.in[19], WIN, WGLU, WMRG, WOUT, scr, lane);
                }
                if (G == 256 && bx < 128) {
                    asm volatile("s_waitcnt vmcnt(0)" ::: "memory"); __syncthreads();
                    const int nc = p == 0 ? 64 : 256, nloc = 256 / nc;
                    if (wave < 2 * nloc) misc::rec_one(EB, UEXT, AT, (bx & 1) * nloc + (wave >> 1), bx >> 1, wave & 1, nc, lane);
                }
            } } else if (s == 2) { if (HAS(3)) {
                misc::rec_phase(EB, UEXT, AT, p == 0 ? 8 : 2, p == 0 ? 64 : 256, vcu * 8 + wave, G * 8, lane);
            } } else if (s == 3) { if (HAS(4)) {
                pg8::Gemm g{UEXT, SSMY, 768, 768, 768}; pg8::GroupOrder S; S.init(64, 2, 2, G, bx);
                pg8::EpiY E{YB};
                pg8::gemm_phase<pg8::EpiY, pg8::GroupOrder, true, true>(lds, g, S, E, tid);
            } } else if (s == 4) { if (HAS(5)) {
                pg8::Gemm g{YB, WGLU, 1024, 1024, 1024}; pg8::StaticOrder S; S.init(MP, 1024, G, bx);
                pg8::EpiGlu E{YB, ZS, args.in[13], ACAT};
                pg8::gemm_phase<pg8::EpiGlu, pg8::StaticOrder, true, true>(lds, g, S, E, tid);
            } } else if (s == 5) { if (HAS(6)) {
                pg8::Gemm g{ACAT, WMRG, 2048, 2048, 2048}; pg8::StaticOrder S; S.init(MP, 2048, G, bx);
                pg8::EpiMerge E{GS, GA, MBUF};
                pg8::gemm_phase<pg8::EpiMerge, pg8::StaticOrder, true, true>(lds, g, S, E, tid);
            } } else { if (HAS(7)) {
                pg8::Gemm g{MBUF, WOUT, 2048, 2048, 2048}; pg8::StaticOrder S; S.init(MP, 2048, G, bx);
                pg8::EpiOut E{xp, outp};
                pg8::gemm_phase<pg8::EpiOut, pg8::StaticOrder, true, true>(lds, g, S, E, tid);
            } }
            __syncthreads();
        }
        { const int kbit = ph == 0 ? 0 : ((ph - 1) % 7) + 1; const bool again = ((DUP_MASK >> kbit) & 1) && !rep;
          if (again) rep = true; else { rep = false; ++ph; }
#if !MK_MULTI
          if (ph < args.ph_hi) { if (!posted) { __ockl_grid_sync(); if (threadIdx.x == 0) (void)xb_add(&xbar.bar[XB_XCNT(xbar.x)], 1u); posted = true; } else xcd_barrier(xbar); }
#endif
        }
    }
}

#ifdef STOP_PH
__global__ void dump_k(const unsigned short* src, float* out, size_t n) {
    for (size_t i = (size_t)blockIdx.x * blockDim.x + threadIdx.x; i < n; i += (size_t)gridDim.x * blockDim.x) { float acc = 0.f;
        for (int w = 0; w < 4; ++w) { unsigned v = src[(size_t)w * n + i]; if ((v & 0x7f80u) == 0x7f80u) v = 0; acc += __uint_as_float(v << 16); }
        out[i] = acc; }
}
#endif
extern "C" void kernel_launch(void* const* d_in, const int* in_sizes, int n_in, void* d_out, int out_size, void* d_ws, size_t ws_size, hipStream_t stream) {
    static int grid = 0;
    if (grid == 0) {
        if (n_in != 20 || in_sizes[0] != MP * 2048 || in_sizes[1] != MP * 2048 || out_size != 2 * MP * 2048 || ws_size < WS_END + WS_BAR_BYTES) {
            fprintf(stderr, "kernel_launch: unexpected shapes / workspace (n_in %d, ws %zu)\n", n_in, ws_size); grid = -1; return; }
        int dev = 0, cus = 0, per_cu = 0;
        if (hipGetDevice(&dev) != hipSuccess || hipDeviceGetAttribute(&cus, hipDeviceAttributeMultiprocessorCount, dev) != hipSuccess) { grid = -1; return; }
        if (hipFuncSetAttribute((const void*)hybrid_fwd, hipFuncAttributeMaxDynamicSharedMemorySize, LDS_BYTES) != hipSuccess) { fprintf(stderr, "kernel_launch: hipFuncSetAttribute failed\n"); grid = -1; return; }
        if (hipOccupancyMaxActiveBlocksPerMultiprocessor(&per_cu, (const void*)hybrid_fwd, 512, LDS_BYTES) != hipSuccess || per_cu < 1) per_cu = 1;
        (void)hipGetLastError();
        grid = cus * per_cu;
        fprintf(stderr, "kernel_launch: grid %d (cus %d x %d), ws %zu\n", grid, cus, per_cu, ws_size);
    }
    if (grid < 0) return;
#ifdef MK_MEMSET
#if MK_MEMSET == 1
    (void)hipMemsetAsync(d_ws, 0xAA, WS_END, stream);
    (void)hipMemsetAsync(d_out, 0xAA, (size_t)out_size * 4, stream);
#elif MK_MEMSET == 2
    (void)hipMemsetAsync((char*)d_ws + WS_END, 0xAA, 64, stream);
#elif MK_MEMSET == 3
    (void)hipMemsetAsync(d_ws, 0xAA, WS_END, stream);
#elif MK_MEMSET == 4
    (void)hipMemsetAsync(d_out, 0xAA, (size_t)out_size * 4, stream);
#endif
#endif
    Args a{};
    for (int i = 0; i < 20; ++i) a.in[i] = (const float*)d_in[i];
    a.out = (float*)d_out; a.ws = (unsigned char*)d_ws;
#if MK_MULTI
#ifdef STOP_PH
    for (int ph = 0; ph <= STOP_PH; ++ph) { a.ph_lo = ph; a.ph_hi = ph + 1; hipLaunchKernelGGL(hybrid_fwd, dim3(grid), dim3(512), LDS_BYTES, stream, a); }
    hipLaunchKernelGGL(dump_k, dim3(2048), dim3(256), 0, stream, (const unsigned short*)d_ws, (float*)d_out, (size_t)out_size);
#else
    for (int ph = 0; ph < N_PHASES; ++ph) { a.ph_lo = ph; a.ph_hi = ph + 1; hipLaunchKernelGGL(hybrid_fwd, dim3(grid), dim3(512), LDS_BYTES, stream, a); }
#endif
#else
    a.ph_lo = 0; a.ph_hi = N_PHASES;
    void* kargs[] = {&a};
    const hipError_t e = hipLaunchCooperativeKernel((const void*)hybrid_fwd, dim3(grid), dim3(512), kargs, LDS_BYTES, stream);
    if (e != hipSuccess) fprintf(stderr, "kernel_launch: cooperative launch failed: %s (grid %d)\n", hipGetErrorString(e), grid);
#endif
}
```

```cpp
#define MK_MULTI 0
#include <hip/hip_runtime.h>
#include <cstdio>
#include <cstdint>
#include <cmath>
namespace pg8 {
#define PG8_LAS __attribute__((address_space(3)))
typedef unsigned short bf16_t;
typedef short bf16x8 __attribute__((ext_vector_type(8)));
typedef float f32x4 __attribute__((ext_vector_type(4)));
typedef float f32x2 __attribute__((ext_vector_type(2)));
typedef unsigned u32x4 __attribute__((ext_vector_type(4)));
typedef unsigned u32x2 __attribute__((ext_vector_type(2)));
constexpr int BM = 256, BK = 64, HALF = 128, HTB = HALF * BK * 2  , STAGE_BYTES = 8 * HTB, NXCD = 8, WGM = 8;

__host__ __device__ __forceinline__ int lds_byte(int r, int c) { const int st = (r >> 4) * 2 + (c >> 5), rr = r & 15, cc = c & 31, ob = rr * 64 + cc * 2; return st * 1024 + (ob ^ (((ob >> 9) & 1) << 5)); }
__host__ __device__ __forceinline__ void stage_rc(int b, int& R, int& C) { const int st = b / 1024, sb = b % 1024, swz = sb ^ (((sb >> 9) & 1) << 5); R = (st >> 1) * 16 + swz / 64; C = (st & 1) * 32 + (swz % 64) / 2; }
__host__ __device__ __forceinline__ int perm32(int rho) { const int n = rho >> 4, i = rho & 15; return 8 * (i >> 2) + 4 * n + (i & 3); }

struct Unit { int pm, pn; };
struct Gemm { const bf16_t* A; const bf16_t* Bt; int lda, ldb, K; };

struct StaticOrder {
    int nM, nN, nwg, G, c, wgm;
    __host__ __device__ void init(int M, int N, int G_, int c_, int wgm_ = WGM) { nM = M / BM; nN = N / BM; nwg = nM * nN; G = G_; c = c_; wgm = wgm_; }
    __host__ __device__ bool next(int i, Unit& u) const {
        const long L = (long)i * G + c; if (L >= nwg) return false;
        int wgid = (int)L; { const int q = nwg / NXCD, r = nwg % NXCD, xcd = wgid % NXCD, off = wgid / NXCD; wgid = (xcd < r ? xcd * (q + 1) : r * (q + 1) + (xcd - r) * q) + off; }
        const int nig = wgm * nN, gid = wgid / nig, fm = gid * wgm, gsz = (nM - fm) < wgm ? (nM - fm) : wgm;
        u.pm = fm + ((wgid % nig) % gsz); u.pn = (wgid % nig) / gsz; return true;
    }
};
struct RangeOrder {
    StaticOrder S; int i0, n;
    __host__ __device__ bool next(int i, Unit& u) const { if (i >= n) return false; return S.next(i0 + i, u); }
};
struct GroupOrder {
    int rt, ct, total, G, c;
    __host__ __device__ void init(int nG, int rt_, int ct_, int G_, int c_) { rt = rt_; ct = ct_; total = nG * rt_ * ct_; G = G_; c = c_; }
    __host__ __device__ bool next(int i, Unit& u) const {
        const int L = i * G + c; if (L >= total) return false;
        const int per = rt * ct, g = L / per, r = L % per; u.pm = g * rt + r % rt; u.pn = g * ct + r / rt; return true;
    }
};

typedef __bf16 bf16x2_t __attribute__((ext_vector_type(2)));
__device__ __forceinline__ unsigned cvt_pk_bf16(float lo, float hi) { const f32x2 v = {lo, hi}; const bf16x2_t b = __builtin_convertvector(v, bf16x2_t); return __builtin_bit_cast(unsigned, b); }
__device__ __forceinline__ float bf_lo(unsigned w) { return __uint_as_float(w << 16); }
__device__ __forceinline__ float bf_hi(unsigned w) { return __uint_as_float(w & 0xffff0000u); }

template <class Epi, class Sched, bool ALIGN_EPI = false, bool SP2 = false>
__device__ __forceinline__ void gemm_phase(PG8_LAS unsigned char* lds, const Gemm g, const Sched& S, const Epi& E, const int tid) {
    const int wid = __builtin_amdgcn_readfirstlane(tid >> 6), lane = tid & 63, wr = wid >> 2, wc = wid & 3, fr = lane & 15, fq = lane >> 4;
    const int K = g.K, nt = K / BK;
    unsigned voffA[2], voffB[2];
#pragma unroll
    for (int i = 0; i < 2; ++i) { int R, C; stage_rc(tid * 16 + i * 8192, R, C); const int Rb = Epi::PERM ? ((R & ~31) + perm32(R & 31)) : R;
        voffA[i] = (unsigned)(R * g.lda + C) * 2u; voffB[i] = (unsigned)(Rb * g.ldb + C) * 2u; }
    const size_t kstep = (size_t)(BK * 2);
    const size_t hstepA = (size_t)HALF * g.lda * 2, hstepB = (size_t)HALF * g.ldb * 2;
    const size_t tstepA = 2 * hstepA, tstepB = 2 * hstepB;
    const unsigned ldsw = (unsigned)wid * 1024u;
    const int aoff = lds_byte(wr * 64 + fr, fq * 8), boff = lds_byte(wc * 32 + fr, fq * 8);
#define PG8_SA(b, h) (((b) * 2 + (h)) * HTB)
#define PG8_SB(b, h) ((4 + (b) * 2 + (h)) * HTB)
#define PG8_STAGE(bufoff, gbase, voff) do { _Pragma("unroll") for (int _i = 0; _i < 2; ++_i) \
        __builtin_amdgcn_global_load_lds((const unsigned*)((const char*)(gbase) + (voff)[_i]), (PG8_LAS unsigned*)(lds + (bufoff) + ldsw + _i * 8192), 16, 0, 0); } while (0)
#define PG8_LDA(dst, b, h) do { _Pragma("unroll") for (int m = 0; m < 4; ++m) _Pragma("unroll") for (int k = 0; k < 2; ++k) dst[m][k] = *(const PG8_LAS bf16x8*)(lds + PG8_SA(b, h) + aoff + m * 2048 + k * 1024); } while (0)
#define PG8_LDB(dst, b, h) do { _Pragma("unroll") for (int n = 0; n < 2; ++n) _Pragma("unroll") for (int k = 0; k < 2; ++k) dst[n][k] = *(const PG8_LAS bf16x8*)(lds + PG8_SB(b, h) + boff + n * 2048 + k * 1024); } while (0)
#define PG8_MMA(ai, bj, At, Bt) do { __builtin_amdgcn_s_setprio(1); _Pragma("unroll") for (int m = 0; m < 4; ++m) _Pragma("unroll") for (int n = 0; n < 2; ++n) _Pragma("unroll") for (int k = 0; k < 2; ++k) \
        acc[ai][bj][m][n] = __builtin_amdgcn_mfma_f32_16x16x32_bf16(Bt[n][k], At[m][k], acc[ai][bj][m][n], 0, 0, 0); __builtin_amdgcn_s_setprio(0); } while (0)
#define PG8_WAIT_V(n) asm volatile("s_waitcnt vmcnt(" #n ")" ::: "memory")
#define PG8_WAIT_L(n) asm volatile("s_waitcnt lgkmcnt(" #n ")" ::: "memory")
#define PG8_BAR __builtin_amdgcn_s_barrier()
#define PG8_SCHED __builtin_amdgcn_sched_barrier(0)
    Unit cur, nxt; int ui = 0;
    if (!S.next(0, cur)) return;
    f32x4 acc[2][2][4][2];
#pragma unroll
    for (int a = 0; a < 2; ++a)
#pragma unroll
        for (int b = 0; b < 2; ++b)
#pragma unroll
            for (int m = 0; m < 4; ++m)
#pragma unroll
                for (int n = 0; n < 2; ++n) acc[a][b][m][n] = (f32x4){0.f, 0.f, 0.f, 0.f};
    bf16x8 At[4][2], B0[2][2], B1[2][2];
    const char* cA = (const char*)g.A + (size_t)cur.pm * tstepA; const char* cB = (const char*)g.Bt + (size_t)cur.pn * tstepB;
    if constexpr (SP2) {
        PG8_STAGE(PG8_SB(0, 0), cB, voffB); PG8_STAGE(PG8_SB(0, 1), cB + hstepB, voffB); PG8_STAGE(PG8_SA(0, 0), cA, voffA); PG8_STAGE(PG8_SA(0, 1), cA + hstepA, voffA);
        if (wr == 1) PG8_BAR;
        PG8_WAIT_V(2); PG8_BAR;
        PG8_STAGE(PG8_SB(1, 0), cB + kstep, voffB); PG8_STAGE(PG8_SA(1, 0), cA + kstep, voffA); PG8_STAGE(PG8_SB(1, 1), cB + hstepB + kstep, voffB);
        PG8_WAIT_V(6); PG8_BAR;
    } else {
        PG8_STAGE(PG8_SB(0, 0), cB, voffB); PG8_STAGE(PG8_SA(0, 0), cA, voffA); PG8_STAGE(PG8_SB(0, 1), cB + hstepB, voffB); PG8_STAGE(PG8_SA(0, 1), cA + hstepA, voffA);
        if (wr == 1) PG8_BAR;
        PG8_WAIT_V(4); PG8_BAR;
        PG8_STAGE(PG8_SB(1, 0), cB + kstep, voffB); PG8_STAGE(PG8_SA(1, 0), cA + kstep, voffA); PG8_STAGE(PG8_SB(1, 1), cB + hstepB + kstep, voffB);
        PG8_WAIT_V(6); PG8_BAR;
    }
    for (;;) {
        const bool has_next = S.next(ui + 1, nxt);
        const char* nA = has_next ? (const char*)g.A + (size_t)nxt.pm * tstepA : cA; const char* nB = has_next ? (const char*)g.Bt + (size_t)nxt.pn * tstepB : cB;
        for (int t = 0; t < nt; t += 2) {
            const bool last = (t == nt - 2);
            const char* a1 = cA + (size_t)(t + 1) * kstep;
            const char* a2 = last ? nA : cA + (size_t)(t + 2) * kstep; const char* b2 = last ? nB : cB + (size_t)(t + 2) * kstep;
            const char* a3 = a2 + kstep; const char* b3 = b2 + kstep;
            if constexpr (Epi::MIDK) { if (t == (nt >> 1)) E.mid(acc, cur, wr, wc, fr, fq); }
            if constexpr (SP2) {
            PG8_LDB(B0, 0, 0); PG8_LDB(B1, 0, 1); PG8_SCHED; PG8_LDA(At, 0, 0); PG8_STAGE(PG8_SA(1, 1), a1 + hstepA, voffA);
            PG8_WAIT_V(8); PG8_WAIT_L(0); PG8_BAR; PG8_MMA(0, 0, At, B0); PG8_MMA(0, 1, At, B1); PG8_BAR; PG8_SCHED;
            PG8_LDA(At, 0, 1); PG8_STAGE(PG8_SB(0, 0), b2, voffB); PG8_STAGE(PG8_SB(0, 1), b2 + hstepB, voffB); PG8_STAGE(PG8_SA(0, 0), a2, voffA);
            PG8_WAIT_V(8); PG8_WAIT_L(0); PG8_BAR; PG8_MMA(1, 0, At, B0); PG8_MMA(1, 1, At, B1); PG8_BAR; PG8_SCHED;
            PG8_LDB(B0, 1, 0); PG8_LDB(B1, 1, 1); PG8_SCHED; PG8_LDA(At, 1, 0); PG8_STAGE(PG8_SA(0, 1), a2 + hstepA, voffA);
            PG8_WAIT_V(8); PG8_WAIT_L(0); PG8_BAR; PG8_MMA(0, 0, At, B0); PG8_MMA(0, 1, At, B1); PG8_BAR; PG8_SCHED;
            PG8_LDA(At, 1, 1); PG8_STAGE(PG8_SB(1, 0), b3, voffB); PG8_STAGE(PG8_SB(1, 1), b3 + hstepB, voffB); PG8_STAGE(PG8_SA(1, 0), a3, voffA);
            PG8_WAIT_V(8); PG8_WAIT_L(0); PG8_BAR; PG8_MMA(1, 0, At, B0); PG8_MMA(1, 1, At, B1); PG8_BAR; PG8_SCHED;
            } else {
            PG8_LDB(B0, 0, 0); PG8_SCHED; PG8_LDA(At, 0, 0); PG8_STAGE(PG8_SA(1, 1), a1 + hstepA, voffA);
            PG8_WAIT_L(8); PG8_BAR; PG8_WAIT_L(0); PG8_MMA(0, 0, At, B0); PG8_BAR; PG8_SCHED;
            PG8_LDB(B1, 0, 1); PG8_STAGE(PG8_SB(0, 0), b2, voffB);
            PG8_BAR; PG8_WAIT_L(0); PG8_MMA(0, 1, At, B1); PG8_BAR;
            PG8_LDA(At, 0, 1); PG8_STAGE(PG8_SA(0, 0), a2, voffA);
            PG8_BAR; PG8_WAIT_L(0); PG8_MMA(1, 0, At, B0); PG8_BAR; PG8_SCHED;
            PG8_STAGE(PG8_SB(0, 1), b2 + hstepB, voffB);
            PG8_WAIT_V(6); PG8_BAR; PG8_MMA(1, 1, At, B1); PG8_BAR;
            PG8_LDB(B0, 1, 0); PG8_SCHED; PG8_LDA(At, 1, 0); PG8_STAGE(PG8_SA(0, 1), a2 + hstepA, voffA);
            PG8_WAIT_L(8); PG8_BAR; PG8_WAIT_L(0); PG8_MMA(0, 0, At, B0); PG8_BAR; PG8_SCHED;
            PG8_LDB(B1, 1, 1); PG8_STAGE(PG8_SB(1, 0), b3, voffB);
            PG8_BAR; PG8_WAIT_L(0); PG8_MMA(0, 1, At, B1); PG8_BAR;
            PG8_LDA(At, 1, 1); PG8_STAGE(PG8_SA(1, 0), a3, voffA);
            PG8_BAR; PG8_WAIT_L(0); PG8_MMA(1, 0, At, B0); PG8_BAR; PG8_SCHED;
            PG8_STAGE(PG8_SB(1, 1), b3 + hstepB, voffB);
            PG8_WAIT_V(6); PG8_BAR; PG8_MMA(1, 1, At, B1); PG8_BAR;
            }
        }
        if constexpr (ALIGN_EPI) { if (wr == 0) PG8_BAR; }
        E(acc, cur, wr, wc, fr, fq);
        if (!has_next) break;
#pragma unroll
        for (int a = 0; a < 2; ++a)
#pragma unroll
            for (int b = 0; b < 2; ++b)
#pragma unroll
                for (int m = 0; m < 4; ++m)
#pragma unroll
                    for (int n = 0; n < 2; ++n) acc[a][b][m][n] = (f32x4){0.f, 0.f, 0.f, 0.f};
        cur = nxt; cA = nA; cB = nB; ++ui;
        if constexpr (ALIGN_EPI) { if (wr == 1) PG8_BAR; }
    }
    PG8_WAIT_V(0);
    if constexpr (!ALIGN_EPI) { if (wr == 0) PG8_BAR; }
    PG8_BAR;
#undef PG8_SA
#undef PG8_SB
#undef PG8_STAGE
#undef PG8_LDA
#undef PG8_LDB
#undef PG8_MMA
#undef PG8_WAIT_V
#undef PG8_WAIT_L
#undef PG8_BAR
#undef PG8_SCHED
}
}
namespace pg8 {
constexpr float LOG2E = 1.4426950408889634f;
__device__ __forceinline__ float sigm(float x) { return __builtin_amdgcn_rcpf(1.f + __expf(-x)); }
__device__ __forceinline__ float gelu_tanh(float x) { const float in = 0.7978845608028654f * (x + 0.044715f * x * x * x); return x * sigm(2.f * in); }
__device__ __forceinline__ u32x4 pack8(const f32x4 a, const f32x4 b) { u32x4 w; w.x = cvt_pk_bf16(a[0], a[1]); w.y = cvt_pk_bf16(a[2], a[3]); w.z = cvt_pk_bf16(b[0], b[1]); w.w = cvt_pk_bf16(b[2], b[3]); return w; }
__device__ __forceinline__ void unpack8(const u32x4 w, f32x4& a, f32x4& b) { a = (f32x4){bf_lo(w.x), bf_hi(w.x), bf_lo(w.y), bf_hi(w.y)}; b = (f32x4){bf_lo(w.z), bf_hi(w.z), bf_lo(w.w), bf_hi(w.w)}; }

struct EpiProj {
    static constexpr bool PERM = true, MIDK = false;
    bf16_t *UEXT, *ZS, *Q, *Kb, *V, *ZA; unsigned char *GS, *GA; const float *qg, *kg;
    __device__ __forceinline__ static void gate8(const f32x4 (&acc)[2][2][4][2], unsigned char* dst, const int colt, const int row0, const int wc, const int fq) {
        const int col0 = colt + wc * 32 + 8 * fq;
#pragma unroll
        for (int ai = 0; ai < 2; ++ai)
#pragma unroll
            for (int m = 0; m < 4; ++m) { unsigned char* rowp = dst + (size_t)(row0 + ai * HALF + m * 16) * 2048 + col0;
#pragma unroll
                for (int bj = 0; bj < 2; ++bj) { u32x2 w = {0u, 0u};
#pragma unroll
                    for (int e = 0; e < 4; ++e) { w.x = __builtin_amdgcn_cvt_pk_u8_f32(fmaxf(sigm(acc[ai][bj][m][0][e]) * 255.f, 1.f), e, w.x);
                                                  w.y = __builtin_amdgcn_cvt_pk_u8_f32(fmaxf(sigm(acc[ai][bj][m][1][e]) * 255.f, 1.f), e, w.y); }
                    *(u32x2*)(rowp + bj * HALF) = w; } }
    }
    template <int KIND  > __device__ __forceinline__ static void plain(const f32x4 (&acc)[2][2][4][2], bf16_t* dst, const int ld, const int colt, const int row0, const int wc, const int fq) {
        const int col0 = colt + wc * 32 + 8 * fq;
#pragma unroll
        for (int ai = 0; ai < 2; ++ai)
#pragma unroll
            for (int m = 0; m < 4; ++m) { bf16_t* rowp = dst + (size_t)(row0 + ai * HALF + m * 16) * ld + col0;
#pragma unroll
                for (int bj = 0; bj < 2; ++bj) { f32x4 v0 = acc[ai][bj][m][0], v1 = acc[ai][bj][m][1];
                    if (KIND != 0) {
#pragma unroll
                        for (int e = 0; e < 4; ++e) { const float s0 = sigm(v0[e]), s1 = sigm(v1[e]); v0[e] = KIND == 1 ? v0[e] * s0 : s0; v1[e] = KIND == 1 ? v1[e] * s1 : s1; } }
                    *(u32x4*)(rowp + bj * HALF) = pack8(v0, v1); } }
    }
    __device__ __forceinline__ void operator()(const f32x4 (&acc)[2][2][4][2], const Unit& u, int wr, int wc, int fr, int fq) const {
        const int pn = u.pn; int row0 = u.pm * BM + wr * 64 + fr; asm volatile("" : "+v"(row0));
        if (pn >= 8 && pn < 16) {
            const bool isq = pn < 12; const float* gg = isq ? qg : kg; bf16_t* dst = isq ? Q : Kb; const float sc = isq ? 0.125f * LOG2E : 1.f;
            const int head = (pn - (isq ? 8 : 12)) * 4 + wc;
            f32x4 gv[2][2];
#pragma unroll
            for (int bj = 0; bj < 2; ++bj)
#pragma unroll
                for (int n = 0; n < 2; ++n) gv[bj][n] = *(const f32x4*)(gg + 32 * bj + 8 * fq + 4 * n) * sc;
#pragma unroll
            for (int ai = 0; ai < 2; ++ai)
#pragma unroll
                for (int m = 0; m < 4; ++m) {
                    float ss = 0.f;
#pragma unroll
                    for (int bj = 0; bj < 2; ++bj)
#pragma unroll
                        for (int n = 0; n < 2; ++n) { const f32x4 x = acc[ai][bj][m][n]; ss += (x[0] * x[0] + x[1] * x[1]) + (x[2] * x[2] + x[3] * x[3]); }
                    ss += __shfl_xor(ss, 16); ss += __shfl_xor(ss, 32);
                    const float rinv = __builtin_amdgcn_rsqf(ss * (1.f / 64.f) + 1e-6f);
                    bf16_t* rowp = dst + (size_t)(row0 + ai * HALF + m * 16) * 1024 + head * 64 + 8 * fq;
#pragma unroll
                    for (int bj = 0; bj < 2; ++bj) *(u32x4*)(rowp + 32 * bj) = pack8(acc[ai][bj][m][0] * rinv * gv[bj][0], acc[ai][bj][m][1] * rinv * gv[bj][1]);
                }
        } else if (pn < 4) {
#pragma unroll
            for (int ai = 0; ai < 2; ++ai)
#pragma unroll
                for (int m = 0; m < 4; ++m) { const int r = row0 + ai * HALF + m * 16;
#pragma unroll
                    for (int bj = 0; bj < 2; ++bj) { const int c = pn * BM + bj * HALF + wc * 32 + 8 * fq, gidx = c >> 4, h0 = c & 15;
                        *(u32x4*)(UEXT + ((size_t)(gidx * 512 + (r >> 5)) * 768 + (r & 31) * 16 + h0)) = pack8(acc[ai][bj][m][0], acc[ai][bj][m][1]); } }
        } else if (pn < 8) { plain<1>(acc, ZS, 1024, (pn - 4) * BM, row0, wc, fq); }
        else if (pn < 20) { plain<0>(acc, V, 1024, (pn - 16) * BM, row0, wc, fq); }
        else if (pn < 24) { plain<1>(acc, ZA, 1024, (pn - 20) * BM, row0, wc, fq); }
        else if (pn < 32) { gate8(acc, GS, (pn - 24) * BM, row0, wc, fq); }
        else { gate8(acc, GA, (pn - 32) * BM, row0, wc, fq); }
    }
};
struct EpiE {
    static constexpr bool PERM = false, MIDK = false;
    float* E;
    __device__ __forceinline__ void operator()(const f32x4 (&acc)[2][2][4][2], const Unit& u, int wr, int wc, int fr, int fq) const {
        int row0 = u.pm * BM + wr * 64 + fr; asm volatile("" : "+v"(row0)); const int col0 = wc * 32 + 4 * fq;
#pragma unroll
        for (int ai = 0; ai < 2; ++ai)
#pragma unroll
            for (int m = 0; m < 4; ++m) { float* rowp = E + (size_t)(row0 + ai * HALF + m * 16) * 256 + col0;
#pragma unroll
                for (int bj = 0; bj < 2; ++bj)
#pragma unroll
                    for (int n = 0; n < 2; ++n) *(f32x4*)(rowp + bj * HALF + n * 16) = acc[ai][bj][m][n]; }
    }
};
struct EpiY {
    static constexpr bool PERM = true, MIDK = false;
    bf16_t* Y;
    __device__ __forceinline__ void operator()(const f32x4 (&acc)[2][2][4][2], const Unit& u, int wr, int wc, int fr, int fq) const {
        const int gidx = u.pm >> 1; int chunk0 = (u.pm & 1) * BM + wr * 64 + fr; asm volatile("" : "+v"(chunk0));
#pragma unroll
        for (int ai = 0; ai < 2; ++ai)
#pragma unroll
            for (int m = 0; m < 4; ++m) { const int chunk = chunk0 + ai * HALF + m * 16;
#pragma unroll
                for (int bj = 0; bj < 2; ++bj) { const int nc = (u.pn & 1) * BM + bj * HALF + wc * 32 + 8 * fq, i = nc >> 4, h0 = nc & 15;
                    f32x4 v0 = acc[ai][bj][m][0], v1 = acc[ai][bj][m][1];
#pragma unroll
                    for (int e = 0; e < 4; ++e) { v0[e] = gelu_tanh(v0[e]); v1[e] = gelu_tanh(v1[e]); }
                    *(u32x4*)(Y + (size_t)(chunk * 32 + i) * 1024 + gidx * 16 + h0) = pack8(v0, v1); } }
    }
};
struct EpiGlu {
    static constexpr bool PERM = true, MIDK = false;
    const bf16_t *Y, *ZS; const float* bias; bf16_t* ACAT;
    __device__ __forceinline__ void operator()(const f32x4 (&acc)[2][2][4][2], const Unit& u, int wr, int wc, int fr, int fq) const {
        int row0 = u.pm * BM + wr * 64 + fr; asm volatile("" : "+v"(row0)); const int col0 = u.pn * BM + wc * 32 + 8 * fq;
        f32x4 bv[2][2];
#pragma unroll
        for (int bj = 0; bj < 2; ++bj) { bv[bj][0] = *(const f32x4*)(bias + col0 + bj * HALF); bv[bj][1] = *(const f32x4*)(bias + col0 + bj * HALF + 4); }
#pragma unroll
        for (int ai = 0; ai < 2; ++ai) {
            u32x4 yw[4][2], zw[4][2];
#pragma unroll
            for (int m = 0; m < 4; ++m) { const size_t r = (size_t)(row0 + ai * HALF + m * 16);
#pragma unroll
                for (int bj = 0; bj < 2; ++bj) { yw[m][bj] = *(const u32x4*)(Y + r * 1024 + col0 + bj * HALF); zw[m][bj] = *(const u32x4*)(ZS + r * 1024 + col0 + bj * HALF); } }
#pragma unroll
            for (int m = 0; m < 4; ++m) { const size_t r = (size_t)(row0 + ai * HALF + m * 16);
#pragma unroll
                for (int bj = 0; bj < 2; ++bj) { const f32x4 b0 = bv[bj][0], b1 = bv[bj][1];
                    f32x4 y0, y1, z0, z1; unpack8(yw[m][bj], y0, y1); unpack8(zw[m][bj], z0, z1);
                    f32x4 v0 = acc[ai][bj][m][0] + b0, v1 = acc[ai][bj][m][1] + b1;
#pragma unroll
                    for (int e = 0; e < 4; ++e) { v0[e] = y0[e] * sigm(v0[e]) * z0[e]; v1[e] = y1[e] * sigm(v1[e]) * z1[e]; }
                    *(u32x4*)(ACAT + r * 2048 + col0 + bj * HALF) = pack8(v0, v1); } }
            asm volatile("" ::: "memory"); }
    }
};
struct EpiMerge {
    static constexpr bool PERM = true, MIDK = true;
    const unsigned char *GS, *GA; bf16_t* MB;
    __device__ __forceinline__ static void ub8(const u32x2 w, f32x4& a, f32x4& b) {
        a = (f32x4){(float)(w.x & 0xffu), (float)((w.x >> 8) & 0xffu), (float)((w.x >> 16) & 0xffu), (float)(w.x >> 24)};
        b = (f32x4){(float)(w.y & 0xffu), (float)((w.y >> 8) & 0xffu), (float)((w.y >> 16) & 0xffu), (float)(w.y >> 24)}; }
    __device__ __forceinline__ void mid(f32x4 (&acc)[2][2][4][2], const Unit& u, int wr, int wc, int fr, int fq) const {
        int row0 = u.pm * BM + wr * 64 + fr; asm volatile("" : "+v"(row0)); const int col0 = u.pn * BM + wc * 32 + 8 * fq;
        u32x2 sw[2][4][2], aw[2][4][2];
#pragma unroll
        for (int ai = 0; ai < 2; ++ai)
#pragma unroll
            for (int m = 0; m < 4; ++m) { const size_t r = (size_t)(row0 + ai * HALF + m * 16);
#pragma unroll
                for (int bj = 0; bj < 2; ++bj) { sw[ai][m][bj] = *(const u32x2*)(GS + r * 2048 + col0 + bj * HALF); aw[ai][m][bj] = *(const u32x2*)(GA + r * 2048 + col0 + bj * HALF); } }
#pragma unroll
        for (int ai = 0; ai < 2; ++ai)
#pragma unroll
            for (int m = 0; m < 4; ++m)
#pragma unroll
                for (int bj = 0; bj < 2; ++bj) { f32x4 s0, s1, a0, a1; ub8(sw[ai][m][bj], s0, s1); ub8(aw[ai][m][bj], a0, a1);
#pragma unroll
                    for (int e = 0; e < 4; ++e) { acc[ai][bj][m][0][e] *= s0[e] * __builtin_amdgcn_rcpf(a0[e]); acc[ai][bj][m][1][e] *= s1[e] * __builtin_amdgcn_rcpf(a1[e]); } }
    }
    __device__ __forceinline__ void operator()(const f32x4 (&acc)[2][2][4][2], const Unit& u, int wr, int wc, int fr, int fq) const {
        int row0 = u.pm * BM + wr * 64 + fr; asm volatile("" : "+v"(row0)); const int col0 = u.pn * BM + wc * 32 + 8 * fq;
        u32x2 aw[2][4][2];
#pragma unroll
        for (int ai = 0; ai < 2; ++ai)
#pragma unroll
            for (int m = 0; m < 4; ++m) { const size_t r = (size_t)(row0 + ai * HALF + m * 16);
#pragma unroll
                for (int bj = 0; bj < 2; ++bj) aw[ai][m][bj] = *(const u32x2*)(GA + r * 2048 + col0 + bj * HALF); }
#pragma unroll
        for (int ai = 0; ai < 2; ++ai)
#pragma unroll
            for (int m = 0; m < 4; ++m) { const size_t r = (size_t)(row0 + ai * HALF + m * 16);
#pragma unroll
                for (int bj = 0; bj < 2; ++bj) { f32x4 a0, a1; ub8(aw[ai][m][bj], a0, a1);
                    *(u32x4*)(MB + r * 2048 + col0 + bj * HALF) = pack8(acc[ai][bj][m][0] * a0 * (1.f / 255.f), acc[ai][bj][m][1] * a1 * (1.f / 255.f)); } }
    }
};
struct EpiOut {
    static constexpr bool PERM = false, MIDK = false;
    const float* X; float* O;
    __device__ __forceinline__ void operator()(const f32x4 (&acc)[2][2][4][2], const Unit& u, int wr, int wc, int fr, int fq) const {
        int row0 = u.pm * BM + wr * 64 + fr; asm volatile("" : "+v"(row0)); const int col0 = u.pn * BM + wc * 32 + 4 * fq;
#pragma unroll
        for (int ai = 0; ai < 2; ++ai) {
            f32x4 xv[4][2][2];
#pragma unroll
            for (int m = 0; m < 4; ++m) { const size_t off = (size_t)(row0 + ai * HALF + m * 16) * 2048 + col0;
#pragma unroll
                for (int bj = 0; bj < 2; ++bj)
#pragma unroll
                    for (int n = 0; n < 2; ++n) xv[m][bj][n] = *(const f32x4*)(X + off + bj * HALF + n * 16); }
#pragma unroll
            for (int m = 0; m < 4; ++m) { const size_t off = (size_t)(row0 + ai * HALF + m * 16) * 2048 + col0;
#pragma unroll
                for (int bj = 0; bj < 2; ++bj)
#pragma unroll
                    for (int n = 0; n < 2; ++n) *(f32x4*)(O + off + bj * HALF + n * 16) = xv[m][bj][n] + acc[ai][bj][m][n]; }
            asm volatile("" ::: "memory"); }
    }
};
}
namespace nat {
typedef unsigned short bf16_t;
typedef short bf16x8 __attribute__((ext_vector_type(8)));
typedef short s16x4 __attribute__((ext_vector_type(4)));
typedef float f32x4 __attribute__((ext_vector_type(4)));
typedef unsigned u32x4 __attribute__((ext_vector_type(4)));
typedef unsigned u32x2 __attribute__((ext_vector_type(2)));
#define NAT_LAS __attribute__((address_space(3)))
constexpr int SLOTB = 8192, KIMG = 0, VIMG = 9 * SLOTB, BIAS_OFF = 18 * SLOTB;
__device__ __forceinline__ s16x4 vtr(unsigned addr) { return __builtin_bit_cast(s16x4, __builtin_amdgcn_ds_read_tr16_b64_v4i16((NAT_LAS s16x4*)addr)); }
__device__ __forceinline__ void glds16(const void* gsrc, unsigned lds_dst) { unsigned keep;
    asm volatile("s_mov_b32 %0, m0\n\ts_mov_b32 m0, %2\n\ts_nop 0\n\tglobal_load_lds_dwordx4 %1, off\n\ts_mov_b32 m0, %0" : "=&s"(keep) : "v"(gsrc), "s"(lds_dst) : "memory"); }
#define NAT_BAR() asm volatile("s_barrier" ::: "memory")
#define NAT_WAITV_BAR(N) asm volatile("s_waitcnt vmcnt(" #N ")\n\ts_barrier" ::: "memory")
__device__ __forceinline__ int clampi(int v, int lo, int hi) { return v < lo ? lo : (v > hi ? hi : v); }

__device__ __forceinline__ void attn_phase(NAT_LAS unsigned char* lds, const bf16_t* Q, const bf16_t* K, const bf16_t* V, const bf16_t* ZA, bf16_t* ACAT,
                                           const float* rel_bias, int rps  , int vcu, int G, const int tid) {
    const int lane = tid & 63, wid = __builtin_amdgcn_readfirstlane(tid >> 6), fr = lane & 15, fq = lane >> 4;
    const int rsel = wid >> 2, qb = wid & 3;
    const int c0 = 16 * qb, w0 = (qb == 0) ? 0 : (qb == 1) ? 8 : (qb == 2) ? 24 : 32;
    NAT_LAS float* biasL = (NAT_LAS float*)(lds + BIAS_OFF);
    const unsigned ldsbase = (unsigned)(size_t)lds;
    const int dcol = lane >> 3, dpos = lane & 7;
    int koff[2][2];
#pragma unroll
    for (int hf = 0; hf < 2; ++hf)
#pragma unroll
        for (int ks = 0; ks < 2; ++ks) { const int col = w0 + 16 * hf + fr; koff[hf][ks] = col * 128 + 16 * ((ks * 4 + fq) ^ ((col >> 1) & 7)); }
    const int vcol = w0 + 4 * fq + (fr >> 2), vx = (vcol >> 1) & 3, vlane = vcol * 128 + 16 * ((fr & 3) >> 1) + 8 * (fr & 1);
    bool selhi[4]; int dcs[4]; unsigned mlo[2], mhi[2];
    { const int cq = c0 + fr; int cs = cq - 8; cs = cs < 0 ? 0 : (cs > 48 ? 48 : cs);
#pragma unroll
      for (int j = 0; j < 4; ++j) { const int clo = w0 + 4 * fq + j; selhi[j] = clo < cs; const int ck = selhi[j] ? clo + 16 : clo; int dc = ck - cq + 15; dc = dc < 0 ? 0 : (dc > 30 ? 30 : dc); dcs[j] = dc; }
#pragma unroll
      for (int q = 0; q < 2; ++q) { mlo[q] = (selhi[2 * q] ? 0u : 0xffffu) | (selhi[2 * q + 1] ? 0u : 0xffff0000u); mhi[q] = ~mlo[q]; } }
    for (int bt = vcu; bt < 256; bt += G) {
        const int h = bt >> 4, rp0 = (bt & 15) * 8;
        const int seq = (2 * rp0) / rps, rl0 = 2 * rp0 - seq * rps, srow = seq * rps;
        const bf16_t* Kh = K + (size_t)srow * 64 * 1024 + h * 64; const bf16_t* Vh = V + (size_t)srow * 64 * 1024 + h * 64;
        {
            const int kr0 = clampi(rl0 - 4, 0, rps - 8), hi = clampi(rl0 - 3, 0, rps - 8) + 8, nr = hi - kr0;
            for (int j = wid; j < nr * 16; j += 8) { const int row = kr0 + (j >> 4), isv = (j >> 3) & 1, c8 = j & 7, col = c8 * 8 + dcol, slot = row % 9;
                const int gch = isv ? (dpos ^ (((col >> 1) & 3) << 1)) : (dpos ^ ((col >> 1) & 7));
                const bf16_t* src = (isv ? Vh : Kh) + (size_t)(row * 64 + col) * 1024 + gch * 8;
                glds16(src, (unsigned)__builtin_amdgcn_readfirstlane((int)(ldsbase + (isv ? VIMG : KIMG) + slot * SLOTB + c8 * 1024))); }
            if (tid < 465) biasL[tid] = rel_bias[h * 465 + tid] * 1.4426950408889634f;
        }
        bf16x8 qn[2];
        { const int qtok = (srow + rl0 + rsel) * 64 + c0 + fr;
#pragma unroll
          for (int ks = 0; ks < 2; ++ks) qn[ks] = *(const bf16x8*)(Q + (size_t)qtok * 1024 + h * 64 + ks * 32 + fq * 8); }
        asm volatile("" :: "v"(qn[0]), "v"(qn[1]));
        asm volatile("s_waitcnt vmcnt(0) lgkmcnt(0)\n\ts_barrier" ::: "memory");
#pragma nounroll
        for (int i = 0; i < 8; ++i) {
            const int rl = rl0 + 2 * i;
            const int kr0 = clampi(rl - 4, 0, rps - 8), kr1 = clampi(rl - 3, 0, rps - 8), hi = kr1 + 8;
            const int hin = clampi(rl - 1, 0, rps - 8) + 8;
            const int r = rl + rsel, krow0 = rsel ? kr1 : kr0;
            const int qtok = (srow + r) * 64 + c0 + fr;
            bf16x8 qf[2]; qf[0] = qn[0]; qf[1] = qn[1];
            u32x2 zw[4];
            { const bf16_t* zp = ZA + (size_t)qtok * 1024 + h * 64 + 4 * fq;
#pragma unroll
              for (int nt = 0; nt < 4; ++nt) zw[nt] = *(const u32x2*)(zp + 16 * nt);
              const int qtn = i < 7 ? qtok + 128 : qtok;
#pragma unroll
              for (int ks = 0; ks < 2; ++ks) qn[ks] = *(const bf16x8*)(Q + (size_t)qtn * 1024 + h * 64 + ks * 32 + fq * 8); }
            f32x4 acc[16];
            { int slot = krow0 % 9;
#pragma unroll
              for (int n2 = 0; n2 < 8; ++n2) { const NAT_LAS unsigned char* kp = lds + KIMG + slot * SLOTB;
#pragma unroll
                  for (int hf = 0; hf < 2; ++hf) { const int n = 2 * n2 + hf;
                      const bf16x8 k0 = *(const NAT_LAS bf16x8*)(kp + koff[hf][0]), k1 = *(const NAT_LAS bf16x8*)(kp + koff[hf][1]);
                      acc[n] = __builtin_amdgcn_mfma_f32_16x16x32_bf16(k0, qf[0], (f32x4){0.f, 0.f, 0.f, 0.f}, 0, 0, 0);
                      acc[n] = __builtin_amdgcn_mfma_f32_16x16x32_bf16(k1, qf[1], acc[n], 0, 0, 0); }
                  slot = slot == 8 ? 0 : slot + 1; } }
            asm volatile("s_waitcnt lgkmcnt(0)\n\ts_barrier" ::: "memory");
            if (i < 7) { int row = hi + rsel; row = row > hin - 1 ? hin - 1 : row; const int slot = row % 9;
#pragma unroll
                for (int e = 0; e < 2; ++e) { const int c8 = qb * 2 + e, col = c8 * 8 + dcol, gch = dpos ^ ((col >> 1) & 7);
                    glds16(Kh + (size_t)(row * 64 + col) * 1024 + gch * 8, (unsigned)__builtin_amdgcn_readfirstlane((int)(ldsbase + KIMG + slot * SLOTB + c8 * 1024))); } }
            float sc[8][4];
            { float bvv[8][4];
#pragma unroll
              for (int n2 = 0; n2 < 8; ++n2) { const NAT_LAS float* brow = biasL + (krow0 + n2 - r + 7) * 31;
#pragma unroll
                  for (int j = 0; j < 4; ++j) bvv[n2][j] = brow[dcs[j]]; }
              asm volatile("s_waitcnt lgkmcnt(0)" ::: "memory");
#pragma unroll
              for (int n2 = 0; n2 < 8; ++n2)
#pragma unroll
                  for (int j = 0; j < 4; ++j) sc[n2][j] = (selhi[j] ? acc[2 * n2 + 1][j] : acc[2 * n2][j]) + bvv[n2][j]; }
            float mx = sc[0][0];
#pragma unroll
            for (int n2 = 0; n2 < 8; ++n2)
#pragma unroll
                for (int j = 0; j < 4; ++j) mx = fmaxf(mx, sc[n2][j]);
            mx = fmaxf(mx, __shfl_xor(mx, 16)); mx = fmaxf(mx, __shfl_xor(mx, 32));
            float l0 = 0.f, l1 = 0.f;
#pragma unroll
            for (int n2 = 0; n2 < 8; ++n2) {
#pragma unroll
                for (int j = 0; j < 4; ++j) sc[n2][j] = __builtin_amdgcn_exp2f(sc[n2][j] - mx);
                l0 += sc[n2][0] + sc[n2][1]; l1 += sc[n2][2] + sc[n2][3]; }
            float l = l0 + l1;
            l += __shfl_xor(l, 16); l += __shfl_xor(l, 32);
            const float linv = __builtin_amdgcn_rcpf(l);
            bf16x8 pf[8];
#pragma unroll
            for (int s8 = 0; s8 < 8; ++s8) { const unsigned w0p = pg8::cvt_pk_bf16(sc[s8][0], sc[s8][1]), w1p = pg8::cvt_pk_bf16(sc[s8][2], sc[s8][3]);
                u32x4 w; w.x = w0p & mlo[0]; w.y = w1p & mlo[1]; w.z = w0p & mhi[0]; w.w = w1p & mhi[1]; pf[s8] = __builtin_bit_cast(bf16x8, w); }
            asm volatile("s_waitcnt vmcnt(2) lgkmcnt(0)\n\ts_barrier" ::: "memory");
            f32x4 o[4];
#pragma unroll
            for (int nt = 0; nt < 4; ++nt) o[nt] = (f32x4){0.f, 0.f, 0.f, 0.f};
            { int slot = krow0 % 9;
#pragma unroll
              for (int s8 = 0; s8 < 8; ++s8) { const unsigned vb = ldsbase + VIMG + slot * SLOTB + vlane;
#pragma unroll
                  for (int nt = 0; nt < 4; ++nt) {
                      const s16x4 lo = vtr(vb + (unsigned)(32 * (nt ^ vx)));
                      const s16x4 hi2 = vtr(vb + (unsigned)(2048 + 32 * (nt ^ vx)));
                      const bf16x8 vf = (bf16x8){lo[0], lo[1], lo[2], lo[3], hi2[0], hi2[1], hi2[2], hi2[3]};
                      o[nt] = __builtin_amdgcn_mfma_f32_16x16x32_bf16(vf, pf[s8], o[nt], 0, 0, 0); }
                  slot = slot == 8 ? 0 : slot + 1; } }
            asm volatile("" :: "v"(zw[0]), "v"(zw[1]), "v"(zw[2]), "v"(zw[3]), "v"(qn[0]), "v"(qn[1]));
            asm volatile("s_waitcnt vmcnt(0) lgkmcnt(0)\n\ts_barrier" ::: "memory");
            if (i < 7) { int row = hi + rsel; row = row > hin - 1 ? hin - 1 : row; const int slot = row % 9;
#pragma unroll
                for (int e = 0; e < 2; ++e) { const int c8 = qb * 2 + e, col = c8 * 8 + dcol, gch = dpos ^ (((col >> 1) & 3) << 1);
                    glds16(Vh + (size_t)(row * 64 + col) * 1024 + gch * 8, (unsigned)__builtin_amdgcn_readfirstlane((int)(ldsbase + VIMG + slot * SLOTB + c8 * 1024))); } }
            { bf16_t* op = ACAT + (size_t)qtok * 2048 + 1024 + h * 64 + 4 * fq;
#pragma unroll
              for (int nt = 0; nt < 4; ++nt) { u32x2 w; w.x = pg8::cvt_pk_bf16(o[nt][0] * linv * pg8::bf_lo(zw[nt].x), o[nt][1] * linv * pg8::bf_hi(zw[nt].x));
                  w.y = pg8::cvt_pk_bf16(o[nt][2] * linv * pg8::bf_lo(zw[nt].y), o[nt][3] * linv * pg8::bf_hi(zw[nt].y));
                  *(u32x2*)(op + 16 * nt) = w; } }
        }
        asm volatile("s_waitcnt vmcnt(0) lgkmcnt(0)\n\ts_barrier" ::: "memory");
    }
}
}
namespace misc {
typedef unsigned short bf16_t;
typedef float f32x4 __attribute__((ext_vector_type(4)));
typedef float f32x2 __attribute__((ext_vector_type(2)));
typedef unsigned u32x4 __attribute__((ext_vector_type(4)));
typedef unsigned u32x2 __attribute__((ext_vector_type(2)));
#define MISC_LAS __attribute__((address_space(3)))
#define LDS_WAIT() asm volatile("s_waitcnt lgkmcnt(0)" ::: "memory")
__device__ __forceinline__ unsigned f2bf(float f) { unsigned u = __builtin_bit_cast(unsigned, f); return (u + 0x7fffu + ((u >> 16) & 1u)) >> 16; }
__device__ __forceinline__ unsigned pk2(float lo, float hi) { return f2bf(lo) | (f2bf(hi) << 16); }
__device__ __forceinline__ float wave_sum(float v) {
#pragma unroll
    for (int o = 1; o < 64; o <<= 1) v += __shfl_xor(v, o);
    return v;
}
__device__ __forceinline__ void transpose_item(const float* W, int N, bf16_t* WT, int ldt, int koff, int drow, MISC_LAS float* scr, int k0, int n0, int lane) {
    float v[32];
#pragma unroll
    for (int i = 0; i < 32; ++i) { const int kk = 2 * i + (lane >> 5); v[i] = W[(size_t)(k0 + kk) * N + n0 + (lane & 31)]; }
#pragma unroll
    for (int i = 0; i < 32; ++i) { const int kk = 2 * i + (lane >> 5); scr[kk * 33 + (lane & 31)] = v[i]; }
    LDS_WAIT(); asm volatile("" ::: "memory");
    const int c = lane & 7;
#pragma unroll
    for (int j = 0; j < 4; ++j) { const int n = (lane >> 3) + 8 * j; const MISC_LAS float* s = scr + (8 * c) * 33 + n;
        u32x4 o; o.x = pk2(s[0 * 33], s[1 * 33]); o.y = pk2(s[2 * 33], s[3 * 33]); o.z = pk2(s[4 * 33], s[5 * 33]); o.w = pk2(s[6 * 33], s[7 * 33]);
        *(u32x4*)(WT + (size_t)(drow + n) * ldt + koff + k0 + 8 * c) = o; }
    LDS_WAIT(); asm volatile("" ::: "memory");
}
__device__ __forceinline__ void rms_rows(const float* x, const float* gam, bf16_t* o, int m0, int stride, int nrows, int lane) {
    const f32x4* gr = (const f32x4*)gam + lane; f32x4 gg[8];
#pragma unroll
    for (int j = 0; j < 8; ++j) gg[j] = gr[64 * j];
    if (m0 >= nrows) return;
    f32x4 v[2][8];
#pragma unroll
    for (int q = 0; q < 2; ++q) { const int mr = (m0 + q * stride < nrows) ? m0 + q * stride : m0; const f32x4* xr = (const f32x4*)(x + (size_t)mr * 2048) + lane;
#pragma unroll
        for (int j = 0; j < 8; ++j) v[q][j] = xr[64 * j]; }
    for (int m = m0; m < nrows; m += 2 * stride) {
        u32x2 w[2][8];
#pragma unroll
        for (int q = 0; q < 2; ++q) { float s = 0.f;
#pragma unroll
            for (int j = 0; j < 8; ++j) s += (v[q][j].x * v[q][j].x + v[q][j].y * v[q][j].y) + (v[q][j].z * v[q][j].z + v[q][j].w * v[q][j].w);
            const float rs = __builtin_amdgcn_rsqf(wave_sum(s) * (1.f / 2048.f) + 1e-6f);
#pragma unroll
            for (int j = 0; j < 8; ++j) { w[q][j].x = pk2(v[q][j].x * rs * gg[j].x, v[q][j].y * rs * gg[j].y); w[q][j].y = pk2(v[q][j].z * rs * gg[j].z, v[q][j].w * rs * gg[j].w); } }
        const int mn = m + 2 * stride;
        if (mn < nrows) {
#pragma unroll
            for (int q = 0; q < 2; ++q) { const int mr = (mn + q * stride < nrows) ? mn + q * stride : mn; const f32x4* xr = (const f32x4*)(x + (size_t)mr * 2048) + lane;
#pragma unroll
                for (int j = 0; j < 8; ++j) v[q][j] = xr[64 * j]; } }
#pragma unroll
        for (int q = 0; q < 2; ++q) { const int mr = (m + q * stride < nrows) ? m + q * stride : m; u32x2* o8 = (u32x2*)(o + (size_t)mr * 2048) + lane;
#pragma unroll
            for (int j = 0; j < 8; ++j) o8[64 * j] = w[q][j]; }
    }
}
__device__ __forceinline__ float exp_small(float x) {
    float t = 1.f, s = 1.f;
#pragma nounroll
    for (int k = 1; k <= 11; ++k) { t *= x * __builtin_amdgcn_rcpf((float)k); s += t; }
    return s;
}
__device__ __forceinline__ float exp_f(float x) {
    float r = exp_small(x * 0.0625f);
    r *= r; r *= r; r *= r; r *= r; return r;
}
__device__ __forceinline__ void sincos_f(float a, float& s, float& c) {
    const float k = __builtin_rintf(a * 0.15915494309189535f);
    float r = __builtin_fmaf(-k, 6.28318548202514648f, a); r = __builtin_fmaf(-k, -1.7484556000744883e-07f, r); r *= 0.25f;
    const float r2 = r * r; float ts = r, tc = 1.f, ss = r, cc = 1.f;
#pragma nounroll
    for (int i = 1; i <= 7; ++i) { const float e = (float)(2 * i); tc *= -r2 * __builtin_amdgcn_rcpf((e - 1.f) * e); ts *= -r2 * __builtin_amdgcn_rcpf(e * (e + 1.f)); cc += tc; ss += ts; }
#pragma nounroll
    for (int i = 0; i < 2; ++i) { const float c2 = cc * cc - ss * ss, s2 = 2.f * ss * cc; cc = c2; ss = s2; }
    s = ss; c = cc;
}
constexpr int SM_POW = 0;
constexpr int SM_FC = SM_POW + 2 * 33 * 65 * 2;
constexpr int SM_BRE = SM_FC + 256;
constexpr int SM_BIM = SM_BRE + 2048;
constexpr int SM_CC = SM_BIM + 2048;
constexpr int SM_TB = SM_CC + 2 * 16 * 65 * 2;
constexpr int TBS = 264;
constexpr int SM_END = SM_TB + 63 * TBS / 2;
static_assert(SM_END * 4 <= 140 * 1024, "SSM builder LDS");

__device__ __forceinline__ void ssm_build(MISC_LAS float* L, int g, const float* a_re, const float* a_im, const float* log_dt, const float* b_re, const float* b_im,
                                          const float* c_re, const float* c_im, const float* dsk, bf16_t* SSMY, bf16_t* SSME, float* AT, int tid, const int stop_at = 9) {
    MISC_LAS f32x2* POW = (MISC_LAS f32x2*)(L + SM_POW); MISC_LAS f32x2* FC = (MISC_LAS f32x2*)(L + SM_FC);
    MISC_LAS float* BRE = L + SM_BRE; MISC_LAS float* BIM = L + SM_BIM; MISC_LAS f32x2* CC = (MISC_LAS f32x2*)(L + SM_CC); MISC_LAS bf16_t* TB = (MISC_LAS bf16_t*)(L + SM_TB);
    if (tid < 128) { const int d = tid >> 6, p = tid & 63;
        float lre = a_re[(d * 64 + g) * 64 + p]; lre = lre < -1e-4f ? lre : -1e-4f; const float lim = a_im[(d * 64 + g) * 64 + p];
        const float dt = exp_f(log_dt[d * 64 + g]);
        const float mag = exp_f(lre * dt); float sn, cs; sincos_f(lim * dt, sn, cs);
        const float zr = mag * cs, zi = mag * sn, rden = 1.f / (lre * lre + lim * lim);
        FC[d * 64 + p] = (f32x2){((zr - 1.f) * lre + zi * lim) * rden, (zi * lre - (zr - 1.f) * lim) * rden};
        float pr = 1.f, pi = 0.f;
#pragma nounroll
        for (int j = 0; j <= 32; ++j) { POW[(d * 33 + j) * 65 + p] = (f32x2){pr, pi}; const float nr = pr * zr - pi * zi, ni = pr * zi + pi * zr; pr = nr; pi = ni; }
        const f32x2 a32 = POW[(d * 33 + 32) * 65 + p]; *(f32x2*)(AT + ((g * 2 + d) * 64 + p) * 2) = a32;
    }
    __syncthreads();
    if (stop_at == 1) return;
    { float brv[4], biv[4], crv[4], civ[4];
#pragma unroll
      for (int it = 0; it < 4; ++it) { const int idx = tid + 512 * it;
          { const int d = idx >> 10, p = (idx >> 4) & 63, h = idx & 15; const size_t gi = ((size_t)(d * 64 + g) * 64 + p) * 16 + h; brv[it] = b_re[gi]; biv[it] = b_im[gi]; }
          { const int d = idx >> 10, hp = (idx >> 6) & 15, p = idx & 63; const size_t gi = ((size_t)(d * 64 + g) * 16 + hp) * 64 + p; crv[it] = c_re[gi]; civ[it] = c_im[gi]; } }
#pragma unroll
      for (int it = 0; it < 4; ++it) { const int idx = tid + 512 * it;
          { const int d = idx >> 10, p = (idx >> 4) & 63; const f32x2 f = FC[d * 64 + p]; BRE[idx] = f.x * brv[it] - f.y * biv[it]; BIM[idx] = f.x * biv[it] + f.y * brv[it]; }
          { const int d = idx >> 10, hp = (idx >> 6) & 15, p = idx & 63; CC[(d * 16 + hp) * 65 + p] = (f32x2){crv[it], civ[it]}; } } }
    __syncthreads();
    { const int j = (tid >> 4) & 31, hp = tid & 15; float a[2][16];
#pragma unroll
      for (int d = 0; d < 2; ++d) {
#pragma unroll
        for (int h = 0; h < 16; ++h) a[d][h] = 0.f;
        for (int p = 0; p < 64; ++p) { const f32x2 c = CC[(d * 16 + hp) * 65 + p], w = POW[(d * 33 + j) * 65 + p]; const float cpr = c.x * w.x - c.y * w.y, cpi = c.x * w.y + c.y * w.x;
            const MISC_LAS f32x4* br = (const MISC_LAS f32x4*)(BRE + (d * 64 + p) * 16); const MISC_LAS f32x4* bi = (const MISC_LAS f32x4*)(BIM + (d * 64 + p) * 16);
#pragma unroll
            for (int q = 0; q < 4; ++q) { const f32x4 r4 = br[q], i4 = bi[q];
#pragma unroll
                for (int e = 0; e < 4; ++e) a[d][4 * q + e] += cpr * r4[e] - cpi * i4[e]; } } }
      if (j == 0) { const float dd = dsk[g * 16 + hp];
#pragma unroll
          for (int h = 0; h < 16; h += 2) *(MISC_LAS unsigned*)(TB + 31 * TBS + hp * 16 + h) = pk2(a[0][h] + a[1][h] + (h == hp ? dd : 0.f), a[0][h + 1] + a[1][h + 1] + (h + 1 == hp ? dd : 0.f));
      } else {
#pragma unroll
          for (int h = 0; h < 16; h += 2) { *(MISC_LAS unsigned*)(TB + (31 + j) * TBS + hp * 16 + h) = pk2(a[0][h], a[0][h + 1]); *(MISC_LAS unsigned*)(TB + (31 - j) * TBS + hp * 16 + h) = pk2(a[1][h], a[1][h + 1]); } }
    }
    __syncthreads();
    if (stop_at == 2) return;
    bf16_t* Yg = SSMY + (size_t)g * 512 * 768;
    for (int idx = tid; idx < 512 * 96; idx += 512) { const int n = idx / 96, kc = idx - n * 96, i = n >> 4, hp = n & 15; float v[8];
        if (kc < 64) { const int j = kc >> 1, h0 = (kc & 1) * 8;
            *(u32x4*)(Yg + (size_t)n * 768 + kc * 8) = *(const MISC_LAS u32x4*)(TB + (31 + i - j) * TBS + hp * 16 + h0); continue;
        } else { const int kk = (kc - 64) * 8, d = kk >> 7, ri = (kk >> 6) & 1, p0 = kk & 63, jj = d == 0 ? i + 1 : 32 - i;
#pragma unroll
            for (int e = 0; e < 8; ++e) { const f32x2 c = CC[(d * 16 + hp) * 65 + p0 + e], w = POW[(d * 33 + jj) * 65 + p0 + e]; v[e] = ri ? -(c.x * w.y + c.y * w.x) : (c.x * w.x - c.y * w.y); } }
        u32x4 o; o.x = pk2(v[0], v[1]); o.y = pk2(v[2], v[3]); o.z = pk2(v[4], v[5]); o.w = pk2(v[6], v[7]);
        *(u32x4*)(Yg + (size_t)n * 768 + kc * 8) = o; }
    bf16_t* Eg = SSME + (size_t)g * 256 * 512;
    for (int idx = tid; idx < 256 * 64; idx += 512) { const int n = idx >> 6, kc = idx & 63, d = n >> 7, ri = (n >> 6) & 1, p = n & 63, j = kc >> 1, h0 = (kc & 1) * 8, jj = d == 0 ? 31 - j : j;
        const f32x2 w = POW[(d * 33 + jj) * 65 + p]; float v[8];
#pragma unroll
        for (int e = 0; e < 8; ++e) { const float br = BRE[(d * 64 + p) * 16 + h0 + e], bi = BIM[(d * 64 + p) * 16 + h0 + e]; v[e] = ri ? (w.x * bi + w.y * br) : (w.x * br - w.y * bi); }
        u32x4 o; o.x = pk2(v[0], v[1]); o.y = pk2(v[2], v[3]); o.z = pk2(v[4], v[5]); o.w = pk2(v[6], v[7]);
        *(u32x4*)(Eg + (size_t)n * 512 + kc * 8) = o; }
    __syncthreads();
}
__device__ __forceinline__ void rec_one(const float* __restrict__ E, bf16_t* __restrict__ UEXT, const float* __restrict__ AT, int seq, int g, int d, int nc, int lane) {
    const f32x2 at = *(const f32x2*)(AT + ((g * 2 + d) * 64 + lane) * 2);
    float sr = 0.f, si = 0.f;
    const int cb = seq * nc;
#pragma unroll 8
    for (int q = 0; q < nc; ++q) { const int c = cb + (d == 0 ? q : nc - 1 - q);
        const float er = E[((size_t)(g * 512 + c)) * 256 + d * 128 + lane], ei = E[((size_t)(g * 512 + c)) * 256 + d * 128 + 64 + lane];
        bf16_t* up = UEXT + ((size_t)(g * 512 + c)) * 768 + 512 + d * 128 + lane;
        up[0] = (bf16_t)f2bf(sr); up[64] = (bf16_t)f2bf(si);
        const float nr = at.x * sr - at.y * si + er, ni = at.x * si + at.y * sr + ei; sr = nr; si = ni; }
}
__device__ __forceinline__ void rec_phase(const float* __restrict__ E, bf16_t* __restrict__ UEXT, const float* __restrict__ AT, int nseq, int nc, int gw, int NGW, int lane) {
    for (int task = gw; task < nseq * 128; task += NGW) rec_one(E, UEXT, AT, task >> 7, (task >> 1) & 63, task & 1, nc, lane);
}
}
#define XB_TMO      128
#define XB_XCNT(j)  (256  + 64 * (j))
#define XB_XSUB(j)  (1280 + 64 * (j))
#define XB_XGEN(j)  (2304 + 64 * (j))
#define XB_TOP      3328
#define XB_TOPGEN   3392
#define XCD_BAR_WORDS 3456
#define XB_SPIN_CAP (1u << 18)
#define XB_LAS __attribute__((address_space(3)))
__device__ __forceinline__ unsigned xb_ld(unsigned* p)              { return __hip_atomic_load(p, __ATOMIC_RELAXED, __HIP_MEMORY_SCOPE_AGENT); }
__device__ __forceinline__ unsigned xb_add(unsigned* p, unsigned v) { return __hip_atomic_fetch_add(p, v, __ATOMIC_RELAXED, __HIP_MEMORY_SCOPE_AGENT); }
__device__ __forceinline__ unsigned xb_xcc_id() { return (unsigned)__builtin_amdgcn_s_getreg((3 << 11) | 20) & 0xFu; }
#define XB_SPIN(cond, bar) do { unsigned _sp = 0; while (cond) { __builtin_amdgcn_s_sleep(1); \
    if ((++_sp & 255u) == 0u) { if (xb_ld(&(bar)[XB_TMO])) break; if (_sp > XB_SPIN_CAP) { atomicAdd(&(bar)[XB_TMO], 1u); break; } } } } while (0)
struct XcdBarrier { unsigned* bar; unsigned x; volatile XB_LAS unsigned* st; };
__device__ __forceinline__ XcdBarrier xcd_barrier_post(unsigned* bar, volatile XB_LAS unsigned* st) {
    XcdBarrier b; b.bar = bar; b.x = xb_xcc_id(); b.st = st;
    if (threadIdx.x == 0) (void)xb_add(&bar[XB_XCNT(b.x)], 1u);
    return b;
}
__device__ __forceinline__ void xcd_barrier_complete(unsigned* bar, unsigned x, unsigned& nloc, unsigned& nx) {
    const unsigned G = gridDim.x * gridDim.y * gridDim.z;
    unsigned sum, cnt, mine, sp = 0u;
    for (;;) {
        sum = 0u; cnt = 0u; mine = 0u;
#pragma unroll
        for (unsigned j = 0; j < 16; ++j) { const unsigned c = xb_ld(&bar[XB_XCNT(j)]); sum += c; cnt += (c > 0u) ? 1u : 0u; mine = (j == x) ? c : mine; }
        if (sum == G) break;
        __builtin_amdgcn_s_sleep(1);
        if ((++sp & 255u) == 0u) { if (xb_ld(&bar[XB_TMO])) break; if (sp > XB_SPIN_CAP) { atomicAdd(&bar[XB_TMO], 1u); break; } }
    }
    nloc = mine > 0u ? mine : 1u; nx = cnt > 0u ? cnt : 1u;
}
__device__ __forceinline__ void xcd_barrier(const XcdBarrier& b) {
    asm volatile("s_waitcnt vmcnt(0)" ::: "memory");
    __syncthreads();
    if (threadIdx.x == 0) {
        unsigned* bar = b.bar;
        __builtin_amdgcn_s_waitcnt(0);
        unsigned nloc = b.st[0], nx = b.st[1];
        if (nloc == 0u) { xcd_barrier_complete(bar, b.x, nloc, nx); b.st[0] = nloc; b.st[1] = nx; }
        const unsigned old = xb_add(&bar[XB_XSUB(b.x)], 1u);
        const unsigned gen = old / nloc;
        if (old + 1u == (gen + 1u) * nloc) {
            __builtin_amdgcn_fence(__ATOMIC_RELEASE, "agent");
            asm volatile("s_waitcnt vmcnt(0)" ::: "memory");
            const unsigned og = xb_add(&bar[XB_TOP], 1u);
            const unsigned tg = og / nx;
            if (og + 1u == (tg + 1u) * nx) xb_add(&bar[XB_TOPGEN], 1u);
            else XB_SPIN(xb_ld(&bar[XB_TOPGEN]) == tg, bar);
            __builtin_amdgcn_fence(__ATOMIC_ACQUIRE, "agent");
            xb_add(&bar[XB_XGEN(b.x)], 1u);
            asm volatile("s_waitcnt vmcnt(0)" ::: "memory");
        } else {
            XB_SPIN(xb_ld(&bar[XB_XGEN(b.x)]) == gen, bar);
            __builtin_amdgcn_fence(__ATOMIC_ACQUIRE, "agent");
            asm volatile("s_waitcnt vmcnt(0)" ::: "memory");
        }
    }
    __syncthreads();
}
#ifndef PH_MASK
#define PH_MASK 0xff
#endif
#define HAS(k) (((PH_MASK) >> (k)) & 1)
#ifndef SYNC_REPS
#define SYNC_REPS 1
#endif
#ifndef DUP_SKIP_SSM
#define DUP_SKIP_SSM 0
#endif
#ifndef G1_WGM
#define G1_WGM 8
#endif
#ifndef G1_ALIGN
#define G1_ALIGN true
#endif
#ifndef G1_SP2
#define G1_SP2 true
#endif
#ifndef DUP_MASK
#define DUP_MASK 0
#endif
#ifndef MK_MULTI
#define MK_MULTI 0
#endif
typedef unsigned short bf16;
constexpr size_t MiB = 1u << 20;
constexpr int MP = 16384;
constexpr size_t WS_WIN = 0, WS_WGLU = 40 * MiB, WS_WMRG = 42 * MiB, WS_WOUT = 50 * MiB, WS_SSMY = 58 * MiB, WS_SSME = 106 * MiB, WS_AT = 122 * MiB,
                 WS_H = 123 * MiB  , WS_UEXT = 187 * MiB  , WS_ZS = 235 * MiB, WS_Q = 267 * MiB, WS_K = 299 * MiB, WS_V = 331 * MiB,
                 WS_ZA = 363 * MiB, WS_Y = 395 * MiB, WS_E = 427 * MiB, WS_END = 459 * MiB;
constexpr int LDS_BYTES = 147456 + 2048 + 256;
constexpr size_t WS_BAR = WS_END, WS_BAR_BYTES = 16384;
constexpr int N_PHASES = 15;
extern "C" __device__ void __ockl_grid_sync(void);

constexpr int I_IN = 32 * 320, I_GLU = 16 * 32, I_BS = 16 * 64, I_OUT = 32 * 64, NITEMS = I_IN + I_GLU + 2 * I_BS + I_OUT;
__device__ __forceinline__ void weight_item(int r, const float* w_in, const float* w_glu, const float* w_bs, const float* w_ba, const float* w_out,
                                            unsigned short* WIN, unsigned short* WGLU, unsigned short* WMRG, unsigned short* WOUT, MISC_LAS float* scr, int lane) {
    if (r < I_IN) { const int kb = r / 320, nb = r % 320, n0 = nb * 32; int drow = n0;
        if (n0 >= 2048 && n0 < 4096) drow = (n0 & ~255) + 128 * ((n0 >> 5) & 1) + 32 * ((n0 >> 6) & 3);
        misc::transpose_item(w_in, 10240, WIN, 2048, 0, drow, scr, kb * 64, n0, lane); return; } r -= I_IN;
    if (r < I_GLU) { misc::transpose_item(w_glu, 1024, WGLU, 1024, 0, (r % 32) * 32, scr, (r / 32) * 64, (r % 32) * 32, lane); return; } r -= I_GLU;
    if (r < I_BS) { misc::transpose_item(w_bs, 2048, WMRG, 2048, 0, (r % 64) * 32, scr, (r / 64) * 64, (r % 64) * 32, lane); return; } r -= I_BS;
    if (r < I_BS) { misc::transpose_item(w_ba, 2048, WMRG, 2048, 1024, (r % 64) * 32, scr, (r / 64) * 64, (r % 64) * 32, lane); return; } r -= I_BS;
    misc::transpose_item(w_out, 2048, WOUT, 2048, 0, (r % 64) * 32, scr, (r / 64) * 64, (r % 64) * 32, lane);
}

struct Args { const float* in[20]; float* out; unsigned char* ws; int ph_lo, ph_hi; };

__global__ void __launch_bounds__(512, 2) hybrid_fwd(Args args) {
    extern __shared__ __attribute__((aligned(16))) unsigned char lds_raw[];
    PG8_LAS unsigned char* lds = (PG8_LAS unsigned char*)lds_raw;
#if !MK_MULTI
    { volatile XB_LAS unsigned* st0 = (volatile XB_LAS unsigned*)((PG8_LAS unsigned char*)lds_raw + (LDS_BYTES - 64)); if (threadIdx.x < 2) st0[threadIdx.x] = 0u; }
    __syncthreads();
    XcdBarrier xbar; xbar.bar = (unsigned*)(args.ws + WS_BAR); xbar.x = xb_xcc_id(); xbar.st = (volatile XB_LAS unsigned*)((PG8_LAS unsigned char*)lds_raw + (LDS_BYTES - 64));
    if (args.ph_lo == 0 && blockIdx.x == 0) { for (int w = threadIdx.x; w < XCD_BAR_WORDS; w += 512) xbar.bar[w] = 0u; }
#endif
    const int G = gridDim.x, bx = blockIdx.x, vcu = (G % 8 == 0) ? (bx % 8) * (G / 8) + bx / 8 : bx;
    bool rep = false, posted = false;
#pragma nounroll
    for (int ph = args.ph_lo; ph < args.ph_hi; ) {
    if (!MK_MULTI && G == 256 && ph != 0 && ((ph - 1) % 7) == 2) { ++ph; continue; }
    int tid = threadIdx.x; asm volatile("" : "+v"(tid));
    size_t zoff = 0; asm volatile("" : "+s"(zoff));
    unsigned char* ws = args.ws + zoff; float* outb = args.out + zoff;
    const int lane = tid & 63, wave = __builtin_amdgcn_readfirstlane(tid >> 6);
    bf16* WIN = (bf16*)(ws + WS_WIN); bf16* WGLU = (bf16*)(ws + WS_WGLU); bf16* WMRG = (bf16*)(ws + WS_WMRG); bf16* WOUT = (bf16*)(ws + WS_WOUT);
    bf16* SSMY = (bf16*)(ws + WS_SSMY); bf16* SSME = (bf16*)(ws + WS_SSME); float* AT = (float*)(ws + WS_AT);
    bf16* HB = (bf16*)(ws + WS_H); bf16* ACAT = HB; bf16* UEXT = (bf16*)(ws + WS_UEXT); bf16* MBUF = UEXT; bf16* ZS = (bf16*)(ws + WS_ZS);
    bf16* QB = (bf16*)(ws + WS_Q); bf16* KB = (bf16*)(ws + WS_K); bf16* VB = (bf16*)(ws + WS_V); bf16* ZA = (bf16*)(ws + WS_ZA); bf16* YB = (bf16*)(ws + WS_Y);
    float* EB = (float*)(ws + WS_E);
        if (ph == 0) { if (HAS(0)) {
            const int nssm = G > 64 ? 64 : 0;
            if (bx < nssm) {
                for (int g = bx; g < 64 && !(DUP_SKIP_SSM == 1 && rep); g += nssm)
                    misc::ssm_build((MISC_LAS float*)lds, g, args.in[4], args.in[5], args.in[6], args.in[7], args.in[8], args.in[9], args.in[10], args.in[11], SSMY, SSME, AT, tid, (DUP_SKIP_SSM > 1 && rep) ? DUP_SKIP_SSM - 1 : 9);
            } else {
                MISC_LAS float* scr = (MISC_LAS float*)(lds + wave * 16384);
                const int gw = (bx - nssm) * 8 + wave, NGW = (G - nssm) * 8;
                const int nearly = (G == 256) ? I_IN : NITEMS;
                for (int it = gw; it < nearly; it += NGW) weight_item(it, args.in[3], args.in[12], args.in[17], args.in[18], args.in[19], WIN, WGLU, WMRG, WOUT, scr, lane);
                misc::rms_rows(args.in[0], args.in[2], HB, gw, NGW, MP, lane);
                { bf16* HB1 = (bf16*)((unsigned char*)outb + 192 * MiB);
                  misc::rms_rows(args.in[1], args.in[2], HB1, gw, NGW, MP, lane); }
            }
            }
            __syncthreads();
        } else {
            const int p = (ph - 1) / 7, s = (ph - 1) % 7;
            const float* xp = args.in[p]; float* outp = outb + (size_t)p * MP * 2048;
            unsigned char* GS = (unsigned char*)outp; unsigned char* GA = GS + (size_t)MP * 2048;
            if (s == 0) { if (HAS(1)) {
                pg8::Gemm g{p == 0 ? HB : (bf16*)((unsigned char*)outb + 192 * MiB), WIN, 2048, 2048, 2048}; pg8::StaticOrder S; S.init(MP, 10240, G, bx, G1_WGM);
                pg8::EpiProj E{UEXT, ZS, QB, KB, VB, ZA, GS, GA, args.in[14], args.in[15]};
                pg8::gemm_phase<pg8::EpiProj, pg8::StaticOrder, G1_ALIGN, G1_SP2>(lds, g, S, E, tid);
            } } else if (s == 1) { if (HAS(2)) {
                nat::attn_phase(lds, QB, KB, VB, ZA, ACAT, args.in[16], p == 0 ? 32 : 128, vcu, G, tid);
                pg8::Gemm g{UEXT, SSME, 768, 512, 512}; pg8::GroupOrder S; S.init(64, 2, 1, G, bx);
                pg8::EpiE E{EB};
                pg8::gemm_phase<pg8::EpiE, pg8::GroupOrder, true, true>(lds, g, S, E, tid);
                if (G == 256 && bx >= 128 && p == 0) {
                    MISC_LAS float* scr = (MISC_LAS float*)(lds + wave * 16384);
                    for (int it = I_IN + (bx - 128) * 8 + wave; it < NITEMS; it += 1024) weight_item(it, args.in[3], args.in[12], args.in[17], args.in[18], args.in[19], WIN, WGLU, WMRG, WOUT, scr, lane);
                }
                if (G == 256 && bx < 128) {
                    asm volatile("s_waitcnt vmcnt(0)" ::: "memory"); __syncthreads();
                    const int nc = p == 0 ? 64 : 256, nloc = 256 / nc;
                    if (wave < 2 * nloc) misc::rec_one(EB, UEXT, AT, (bx & 1) * nloc + (wave >> 1), bx >> 1, wave & 1, nc, lane);
                }
            } } else if (s == 2) { if (HAS(3)) {
                misc::rec_phase(EB, UEXT, AT, p == 0 ? 8 : 2, p == 0 ? 64 : 256, vcu * 8 + wave, G * 8, lane);
            } } else if (s == 3) { if (HAS(4)) {
                pg8::Gemm g{UEXT, SSMY, 768, 768, 768}; pg8::GroupOrder S; S.init(64, 2, 2, G, bx);
                pg8::EpiY E{YB};
                pg8::gemm_phase<pg8::EpiY, pg8::GroupOrder, true, true>(lds, g, S, E, tid);
            } } else if (s == 4) { if (HAS(5)) {
                pg8::Gemm g{YB, WGLU, 1024, 1024, 1024}; pg8::StaticOrder S; S.init(MP, 1024, G, bx);
                pg8::EpiGlu E{YB, ZS, args.in[13], ACAT};
                pg8::gemm_phase<pg8::EpiGlu, pg8::StaticOrder, true, true>(lds, g, S, E, tid);
            } } else if (s == 5) { if (HAS(6)) {
                pg8::Gemm g{ACAT, WMRG, 2048, 2048, 2048}; pg8::StaticOrder S; S.init(MP, 2048, G, bx);
                pg8::EpiMerge E{GS, GA, MBUF};
                pg8::gemm_phase<pg8::EpiMerge, pg8::StaticOrder, true, true>(lds, g, S, E, tid);
            } } else { if (HAS(7)) {
                pg8::Gemm g{MBUF, WOUT, 2048, 2048, 2048}; pg8::StaticOrder S; S.init(MP, 2048, G, bx);
                pg8::EpiOut E{xp, outp};
                pg8::gemm_phase<pg8::EpiOut, pg8::StaticOrder, true, true>(lds, g, S, E, tid);
            } }
            __syncthreads();
        }
        { const int kbit = ph == 0 ? 0 : ((ph - 1) % 7) + 1; const bool again = ((DUP_MASK >> kbit) & 1) && !rep;
          if (again) rep = true; else { rep = false; ++ph; }
#if !MK_MULTI
          if (ph < args.ph_hi) { if (!posted) { __ockl_grid_sync(); if (threadIdx.x == 0) (void)xb_add(&xbar.bar[XB_XCNT(xbar.x)], 1u); posted = true; } else xcd_barrier(xbar); }
#endif
        }
    }
}

#ifdef STOP_PH
__global__ void dump_k(const unsigned short* src, float* out, size_t n) {
    for (size_t i = (size_t)blockIdx.x * blockDim.x + threadIdx.x; i < n; i += (size_t)gridDim.x * blockDim.x) { float acc = 0.f;
        for (int w = 0; w < 4; ++w) { unsigned v = src[(size_t)w * n + i]; if ((v & 0x7f80u) == 0x7f80u) v = 0; acc += __uint_as_float(v << 16); }
        out[i] = acc; }
}
#endif
extern "C" void kernel_launch(void* const* d_in, const int* in_sizes, int n_in, void* d_out, int out_size, void* d_ws, size_t ws_size, hipStream_t stream) {
    static int grid = 0;
    if (grid == 0) {
        if (n_in != 20 || in_sizes[0] != MP * 2048 || in_sizes[1] != MP * 2048 || out_size != 2 * MP * 2048 || ws_size < WS_END + WS_BAR_BYTES) {
            fprintf(stderr, "kernel_launch: unexpected shapes / workspace (n_in %d, ws %zu)\n", n_in, ws_size); grid = -1; return; }
        int dev = 0, cus = 0, per_cu = 0;
        if (hipGetDevice(&dev) != hipSuccess || hipDeviceGetAttribute(&cus, hipDeviceAttributeMultiprocessorCount, dev) != hipSuccess) { grid = -1; return; }
        if (hipFuncSetAttribute((const void*)hybrid_fwd, hipFuncAttributeMaxDynamicSharedMemorySize, LDS_BYTES) != hipSuccess) { fprintf(stderr, "kernel_launch: hipFuncSetAttribute failed\n"); grid = -1; return; }
        if (hipOccupancyMaxActiveBlocksPerMultiprocessor(&per_cu, (const void*)hybrid_fwd, 512, LDS_BYTES) != hipSuccess || per_cu < 1) per_cu = 1;
        (void)hipGetLastError();
        grid = cus * per_cu;
        fprintf(stderr, "kernel_launch: grid %d (cus %d x %d), ws %zu\n", grid, cus, per_cu, ws_size);
    }
    if (grid < 0) return;
#ifdef MK_MEMSET
#if MK_MEMSET == 1
    (void)hipMemsetAsync(d_ws, 0xAA, WS_END, stream);
    (void)hipMemsetAsync(d_out, 0xAA, (size_t)out_size * 4, stream);
#elif MK_MEMSET == 2
    (void)hipMemsetAsync((char*)d_ws + WS_END, 0xAA, 64, stream);
#elif MK_MEMSET == 3
    (void)hipMemsetAsync(d_ws, 0xAA, WS_END, stream);
#elif MK_MEMSET == 4
    (void)hipMemsetAsync(d_out, 0xAA, (size_t)out_size * 4, stream);
#endif
#endif
    Args a{};
    for (int i = 0; i < 20; ++i) a.in[i] = (const float*)d_in[i];
    a.out = (float*)d_out; a.ws = (unsigned char*)d_ws;
#if MK_MULTI
#ifdef STOP_PH
    for (int ph = 0; ph <= STOP_PH; ++ph) { a.ph_lo = ph; a.ph_hi = ph + 1; hipLaunchKernelGGL(hybrid_fwd, dim3(grid), dim3(512), LDS_BYTES, stream, a); }
    hipLaunchKernelGGL(dump_k, dim3(2048), dim3(256), 0, stream, (const unsigned short*)d_ws, (float*)d_out, (size_t)out_size);
#else
    for (int ph = 0; ph < N_PHASES; ++ph) { a.ph_lo = ph; a.ph_hi = ph + 1; hipLaunchKernelGGL(hybrid_fwd, dim3(grid), dim3(512), LDS_BYTES, stream, a); }
#endif
#else
    a.ph_lo = 0; a.ph_hi = N_PHASES;
    void* kargs[] = {&a};
    const hipError_t e = hipLaunchCooperativeKernel((const void*)hybrid_fwd, dim3(grid), dim3(512), kargs, LDS_BYTES, stream);
    if (e != hipSuccess) fprintf(stderr, "kernel_launch: cooperative launch failed: %s (grid %d)\n", hipGetErrorString(e), grid);
#endif
}
```
